# Optimizing an MI355X kernel written in HIP

```python
import math
import jax, jax.numpy as jnp
from jax import lax
import numpy as np

D_MODEL = 2048
BATCH = 1
SEQ = 8192
DEPTH = 4

GRID_W = 64
CTX_LEN = 256
EPS = 1e-6
ROPE_BASE = 10000.0

D_A = 512
N_BLK_A = 8
BLK_A = D_A // N_BLK_A
CONV_A = 4
LRU_C = 8.0

N_HEADS_B = 4
HEAD_DIM_B = 128
D_B = N_HEADS_B * HEAD_DIM_B
CONV_B = 4
CHUNK_B = 64

N_Q_HEADS_C = 8
N_KV_HEADS_C = 2
HEAD_DIM_C = 128
D_Q_C = N_Q_HEADS_C * HEAD_DIM_C
D_KV_C = N_KV_HEADS_C * HEAD_DIM_C
Q_BLOCK = 128

D_MIX = D_A + D_B + D_Q_C
IN_SIZES = (D_A, D_A, 3 * D_B, D_B, 2 * N_HEADS_B, 2 * N_HEADS_B, D_Q_C, D_KV_C, D_KV_C, D_Q_C)
D_IN = sum(IN_SIZES)

kernel_name = 'hybrid_rglru_gdn_gqa_prefix_trunk'


def rms_norm(x, g):
    xf = x.astype(jnp.float32)
    y = xf * lax.rsqrt(jnp.mean(xf * xf, axis=-1, keepdims=True) + EPS)
    return (y * g.astype(jnp.float32)).astype(x.dtype)


def l2_normalize(x):
    return x * lax.rsqrt(jnp.sum(x * x, axis=-1, keepdims=True) + EPS)


def flip_time(z, axis, rev):
    return jnp.flip(z, axis=axis) if rev else z


def dwconv_centred(x, w):
    k = w.shape[0]
    return lax.conv_general_dilated(
        x, w.astype(x.dtype)[:, None, :], window_strides=(1,),
        padding=[(k // 2, k - 1 - k // 2)],
        dimension_numbers=('NWC', 'WIO', 'NWC'), feature_group_count=x.shape[-1])


def split_cols(z):
    idx = np.cumsum(IN_SIZES)[:-1].tolist()
    return jnp.split(z, idx, axis=-1)


def axial_rope(row, col):
    n_freq = HEAD_DIM_C // 4
    inv_freq = ROPE_BASE ** (-jnp.arange(n_freq, dtype=jnp.float32) / n_freq)
    ang = jnp.concatenate([row.astype(jnp.float32)[:, None] * inv_freq,
                           col.astype(jnp.float32)[:, None] * inv_freq], axis=-1)
    return jnp.cos(ang), jnp.sin(ang)


def apply_rope(x, cos, sin):
    xf = x.astype(jnp.float32)
    half = xf.shape[-1] // 2
    x1, x2 = xf[..., :half], xf[..., half:]
    cs, sn = cos[None, :, None, :], sin[None, :, None, :]
    return jnp.concatenate([x1 * cs - x2 * sn, x2 * cs + x1 * sn], axis=-1).astype(x.dtype)


def _linrec_combine(left, right):
    a_l, b_l = left
    a_r, b_r = right
    return a_l * a_r, a_r * b_l + b_r


def rglru_scan(u, h0, w_r, b_r, w_i, b_i, lam):
    bsz, t_len, _ = u.shape
    ub = u.reshape(bsz, t_len, N_BLK_A, BLK_A)
    gate_r = jax.nn.sigmoid(jnp.einsum('btni,nij->btnj', ub, w_r.astype(jnp.float32)).reshape(bsz, t_len, D_A) + b_r)
    gate_i = jax.nn.sigmoid(jnp.einsum('btni,nij->btnj', ub, w_i.astype(jnp.float32)).reshape(bsz, t_len, D_A) + b_i)
    log_a = -LRU_C * gate_r * jax.nn.softplus(-lam.astype(jnp.float32))
    a = jnp.exp(log_a)
    b = jnp.sqrt(-jnp.expm1(2.0 * log_a)) * (gate_i * u)
    a_cum, h = lax.associative_scan(_linrec_combine, (a, b), axis=1)
    h = h + a_cum * h0[:, None, :]
    return h, h[:, -1]


def rglru_branch(xa_lat, xa_ctx, conv_w, conv_b, w_r, b_r, w_i, b_i, lam):
    u_lat = (dwconv_centred(xa_lat, conv_w) + conv_b).astype(jnp.float32)
    u_ctx = (dwconv_centred(xa_ctx, conv_w) + conv_b).astype(jnp.float32)
    h0 = jnp.zeros((u_ctx.shape[0], D_A), jnp.float32)
    ys_lat, ys_ctx = [], []
    for d in range(2):
        rev = d == 1
        y_c, h_c = rglru_scan(flip_time(u_ctx, 1, rev), h0, w_r[d], b_r[d], w_i[d], b_i[d], lam[d])
        y_l, _ = rglru_scan(flip_time(u_lat, 1, rev), h_c, w_r[d], b_r[d], w_i[d], b_i[d], lam[d])
        ys_ctx.append(flip_time(y_c, 1, rev))
        ys_lat.append(flip_time(y_l, 1, rev))
    return ys_lat[0] + ys_lat[1], ys_ctx[0] + ys_ctx[1]


def gdn_chunked(q, k, v, g, beta, s0):
    bsz, nh, t_len, dk = q.shape
    dv = v.shape[-1]
    cs = CHUNK_B
    n = t_len // cs
    q = (q * dk ** -0.5).reshape(bsz, nh, n, cs, dk)
    k = k.reshape(bsz, nh, n, cs, dk)
    v = v.reshape(bsz, nh, n, cs, dv)
    beta = beta.reshape(bsz, nh, n, cs)
    g = jnp.cumsum(g.reshape(bsz, nh, n, cs), axis=-1)
    causal = jnp.tril(jnp.ones((cs, cs), bool))
    decay = jnp.exp(jnp.where(causal, g[..., :, None] - g[..., None, :], -jnp.inf))
    kb = k * beta[..., None]
    strict = jnp.tril(jnp.einsum('bhnid,bhnjd->bhnij', kb, k) * decay, -1)
    eye = jnp.eye(cs, dtype=jnp.float32)
    t_mat = lax.linalg.triangular_solve(eye + strict, jnp.broadcast_to(eye, strict.shape),
                                        left_side=True, lower=True, unit_diagonal=True)
    u = t_mat @ (v * beta[..., None])
    w = t_mat @ (kb * jnp.exp(g)[..., None])
    qk = jnp.einsum('bhnid,bhnjd->bhnij', q, k) * decay
    g_last = g[..., -1]
    k_tail = k * jnp.exp(g_last[..., None] - g)[..., None]
    q_head = q * jnp.exp(g)[..., None]

    def step(s, inp):
        q_i, k_i, u_i, w_i, qk_i, gl_i = inp
        v_new = u_i - w_i @ s
        o = q_i @ s + qk_i @ v_new
        s = s * jnp.exp(gl_i)[..., None, None] + jnp.swapaxes(k_i, -1, -2) @ v_new
        return s, o

    xs = tuple(jnp.moveaxis(z, 2, 0) for z in (q_head, k_tail, u, w, qk, g_last))
    s_last, o = lax.scan(step, s0, xs)
    o = jnp.moveaxis(o, 0, 2).reshape(bsz, nh, t_len, dv)
    return o, s_last


def _gdn_prep(qkv, conv_w):
    bsz, t_len, _ = qkv.shape
    u = jax.nn.silu(dwconv_centred(qkv, conv_w).astype(jnp.float32))
    q, k, v = jnp.split(u, 3, axis=-1)
    heads = lambda z: z.reshape(bsz, t_len, N_HEADS_B, HEAD_DIM_B).transpose(0, 2, 1, 3)
    return l2_normalize(heads(q)), l2_normalize(heads(k)), heads(v)


def _gdn_gates(beta_raw, alpha_raw, a_log, dt_bias, d):
    sl = slice(d * N_HEADS_B, (d + 1) * N_HEADS_B)
    beta = jax.nn.sigmoid(beta_raw[..., sl].astype(jnp.float32)).transpose(0, 2, 1)
    g = -jnp.exp(a_log[d].astype(jnp.float32)) * jax.nn.softplus(alpha_raw[..., sl].astype(jnp.float32) + dt_bias[d])
    return beta, g.transpose(0, 2, 1)


def gdn_branch(qkv_lat, qkv_ctx, beta_lat, beta_ctx, alpha_lat, alpha_ctx, conv_w, a_log, dt_bias, onorm):
    ql, kl, vl = _gdn_prep(qkv_lat, conv_w)
    qx, kx, vx = _gdn_prep(qkv_ctx, conv_w)
    bsz = ql.shape[0]
    s0 = jnp.zeros((bsz, N_HEADS_B, HEAD_DIM_B, HEAD_DIM_B), jnp.float32)
    os_lat, os_ctx = [], []
    for d in range(2):
        rev = d == 1
        b_l, g_l = _gdn_gates(beta_lat, alpha_lat, a_log, dt_bias, d)
        b_x, g_x = _gdn_gates(beta_ctx, alpha_ctx, a_log, dt_bias, d)
        fl = lambda z: flip_time(z, 2, rev)
        o_x, s_x = gdn_chunked(fl(qx), fl(kx), fl(vx), fl(g_x), fl(b_x), s0)
        o_l, _ = gdn_chunked(fl(ql), fl(kl), fl(vl), fl(g_l), fl(b_l), s_x)
        os_ctx.append(fl(o_x))
        os_lat.append(fl(o_l))

    def finish(o):
        o = rms_norm(o.transpose(0, 2, 1, 3), onorm)
        return o.reshape(o.shape[0], o.shape[1], D_B)

    return finish(os_lat[0] + os_lat[1]), finish(os_ctx[0] + os_ctx[1])


def _attend(q, k, v):
    s = jnp.einsum('bqkgd,bskd->bkgqs', q, k).astype(jnp.float32) * (HEAD_DIM_C ** -0.5)
    p = jax.nn.softmax(s, axis=-1).astype(v.dtype)
    return jnp.einsum('bkgqs,bskd->bqkgd', p, v)


def gqa_branch(q_lat, k_lat, v_lat, q_ctx, k_ctx, v_ctx, qn, kn, cos, sin, need_ctx_out):
    bsz, t_len, _ = q_lat.shape
    grp = N_Q_HEADS_C // N_KV_HEADS_C

    def heads(q, k, v):
        n_tok = q.shape[1]
        q = rms_norm(q.reshape(bsz, n_tok, N_KV_HEADS_C, grp, HEAD_DIM_C), qn)
        k = rms_norm(k.reshape(bsz, n_tok, N_KV_HEADS_C, HEAD_DIM_C), kn)
        return q, k, v.reshape(bsz, n_tok, N_KV_HEADS_C, HEAD_DIM_C)

    ql, kl, vl = heads(q_lat, k_lat, v_lat)
    qx, kx, vx = heads(q_ctx, k_ctx, v_ctx)
    ql = apply_rope(ql.reshape(bsz, t_len, N_Q_HEADS_C, HEAD_DIM_C), cos, sin).reshape(ql.shape)
    kl = apply_rope(kl, cos, sin)
    keys = jnp.concatenate([kl, kx], axis=1)
    vals = jnp.concatenate([vl, vx], axis=1)
    n_blk = t_len // Q_BLOCK
    qb = ql.reshape(bsz, n_blk, Q_BLOCK, N_KV_HEADS_C, grp, HEAD_DIM_C).transpose(1, 0, 2, 3, 4, 5)
    ob = lax.map(lambda qi: _attend(qi, keys, vals), qb)
    o_lat = ob.transpose(1, 0, 2, 3, 4, 5).reshape(bsz, t_len, D_Q_C)
    o_ctx = None
    if need_ctx_out:
        o_ctx = _attend(qx, kx, vx).reshape(bsz, qx.shape[1], D_Q_C)
    return o_lat, o_ctx


def hybrid_layer(h_lat, h_ctx, c, c_ctx, norm_g, w_mod, b_mod, w_in, conv_a_w, conv_a_b, w_ra, b_ra,
                 w_ia, b_ia, lam_a, conv_b_w, a_log_b, dt_bias_b, onorm_b, qn_c, kn_c, w_out, cos, sin, last):
    shift, scale, gate = jnp.split(jax.nn.silu(c) @ w_mod + b_mod, 3, axis=-1)
    shift_x, scale_x, gate_x = jnp.split(jax.nn.silu(c_ctx) @ w_mod + b_mod, 3, axis=-1)
    z_lat = (rms_norm(h_lat, norm_g) * (1.0 + scale[:, None]) + shift[:, None]) @ w_in
    z_ctx = (rms_norm(h_ctx, norm_g) * (1.0 + scale_x) + shift_x) @ w_in
    xa_l, ga_l, qkvb_l, gb_l, beta_l, alpha_l, qc_l, kc_l, vc_l, gc_l = split_cols(z_lat)
    xa_x, ga_x, qkvb_x, gb_x, beta_x, alpha_x, qc_x, kc_x, vc_x, gc_x = split_cols(z_ctx)

    ya_l, ya_x = rglru_branch(xa_l, xa_x, conv_a_w, conv_a_b, w_ra, b_ra, w_ia, b_ia, lam_a)
    yb_l, yb_x = gdn_branch(qkvb_l, qkvb_x, beta_l, beta_x, alpha_l, alpha_x, conv_b_w, a_log_b, dt_bias_b, onorm_b)
    yc_l, yc_x = gqa_branch(qc_l, kc_l, vc_l, qc_x, kc_x, vc_x, qn_c, kn_c, cos, sin, not last)

    mix_lat = jnp.concatenate([ya_l * jax.nn.silu(ga_l), yb_l * jax.nn.silu(gb_l),
                               yc_l * jax.nn.silu(gc_l)], axis=-1) @ w_out
    h_lat = h_lat + (gate[:, None] * mix_lat).astype(h_lat.dtype)
    if not last:
        mix_ctx = jnp.concatenate([ya_x * jax.nn.silu(ga_x), yb_x * jax.nn.silu(gb_x),
                                   yc_x * jax.nn.silu(gc_x)], axis=-1) @ w_out
        h_ctx = h_ctx + (gate_x * mix_ctx).astype(h_ctx.dtype)
    return h_lat, h_ctx


def setup_inputs(seed: int = 0) -> dict:
    key = jax.random.key(seed)
    ks = jax.random.split(key, 24)
    f32 = jnp.float32
    L, D = DEPTH, D_MODEL

    def nrm(k, shape, s):
        return jax.random.normal(k, shape, f32) * s

    def gain(k, shape):
        return 1.0 + 0.02 * jax.random.normal(k, shape, f32)

    u = jax.random.uniform(ks[14], (L, 2, D_A), f32, 0.9, 0.999)
    s = u ** (1.0 / LRU_C)
    lam_a = jnp.log(s) - jnp.log1p(-s)
    a_log_b = jnp.log(jax.random.uniform(ks[16], (L, 2, N_HEADS_B), f32, 1.0, 16.0))
    dt = jnp.exp(jax.random.uniform(ks[17], (L, 2, N_HEADS_B), f32, math.log(1e-3), math.log(1e-1)))
    dt_bias_b = dt + jnp.log(-jnp.expm1(-dt))
    return {
        'x': nrm(ks[0], (BATCH, SEQ, D), 1.0),
        'c': nrm(ks[1], (BATCH, D), 1.0),
        'ctx': nrm(ks[2], (BATCH, CTX_LEN, D), 1.0),
        'c_ctx': nrm(ks[3], (D,), 1.0),
        'norm_g': gain(ks[4], (L, D)),
        'w_mod': nrm(ks[5], (L, D, 3 * D), 0.5 * D ** -0.5),
        'b_mod': nrm(ks[6], (L, 3 * D), 0.02),
        'w_in': nrm(ks[7], (L, D, D_IN), D ** -0.5),
        'conv_a_w': nrm(ks[8], (L, CONV_A, D_A), CONV_A ** -0.5),
        'conv_a_b': nrm(ks[9], (L, D_A), 0.02),
        'w_ra': nrm(ks[10], (L, 2, N_BLK_A, BLK_A, BLK_A), BLK_A ** -0.5),
        'b_ra': nrm(ks[11], (L, 2, D_A), 0.02),
        'w_ia': nrm(ks[12], (L, 2, N_BLK_A, BLK_A, BLK_A), BLK_A ** -0.5),
        'b_ia': nrm(ks[13], (L, 2, D_A), 0.02),
        'lam_a': lam_a,
        'conv_b_w': nrm(ks[15], (L, CONV_B, 3 * D_B), CONV_B ** -0.5),
        'a_log_b': a_log_b,
        'dt_bias_b': dt_bias_b,
        'onorm_b': gain(ks[18], (L, HEAD_DIM_B)),
        'qn_c': gain(ks[19], (L, HEAD_DIM_C)),
        'kn_c': gain(ks[20], (L, HEAD_DIM_C)),
        'w_out': nrm(ks[21], (L, D_MIX, D), D_MIX ** -0.5),
        'final_g': gain(ks[22], (D,)),
    }


def reference(x, c, ctx, c_ctx, norm_g, w_mod, b_mod, w_in, conv_a_w, conv_a_b, w_ra, b_ra, w_ia, b_ia,
              lam_a, conv_b_w, a_log_b, dt_bias_b, onorm_b, qn_c, kn_c, w_out, final_g):
    n_tok = x.shape[1]
    rows = n_tok // GRID_W
    row = jnp.repeat(jnp.arange(rows, dtype=jnp.int32), GRID_W)
    col = jnp.tile(jnp.arange(GRID_W, dtype=jnp.int32), rows)
    cos, sin = axial_rope(row, col)
    h_lat, h_ctx = x, ctx
    for l in range(DEPTH):
        h_lat, h_ctx = hybrid_layer(
            h_lat, h_ctx, c, c_ctx, norm_g[l], w_mod[l], b_mod[l], w_in[l], conv_a_w[l], conv_a_b[l],
            w_ra[l], b_ra[l], w_ia[l], b_ia[l], lam_a[l], conv_b_w[l], a_log_b[l], dt_bias_b[l],
            onorm_b[l], qn_c[l], kn_c[l], w_out[l], cos, sin, l == DEPTH - 1)
    return rms_norm(h_lat, final_g)
```

```cpp
#define MK_MULTI 1
#include <hip/hip_runtime.h>
#include <hip/hip_cooperative_groups.h>
#include <cstdio>
namespace cg = cooperative_groups;

typedef unsigned short bf16_t;
typedef short bf16x8_t __attribute__((ext_vector_type(8)));
typedef float f32x4_t __attribute__((ext_vector_type(4)));
typedef unsigned u32x4_t __attribute__((ext_vector_type(4)));
typedef unsigned u32x2_t __attribute__((ext_vector_type(2)));

constexpr int DM = 2048, TL = 8192, TC = 256, TA = 8448, NL = 4;
constexpr int DIN = 5648, ZLD = 5888, NCH = 132;
constexpr int ZC_XA = 0, ZC_GA = 512, ZC_QKVB = 1024, ZC_GB = 2560, ZC_QC = 3072, ZC_KC = 4096, ZC_VC = 4352, ZC_GC = 4608, ZC_BETA = 5632, ZC_ALPHA = 5640;
constexpr int LDS_BYTES = 147456;

constexpr size_t al256(size_t x) { return (x + 255) / 256 * 256; }
constexpr size_t WS_H    = 0;
constexpr size_t WS_XN   = WS_H    + al256((size_t)TA * DM * 4);
constexpr size_t WS_Z    = WS_XN   + al256((size_t)TA * DM * 2);
constexpr size_t WS_MIX  = WS_Z    + al256((size_t)TA * ZLD * 2);
constexpr size_t WS_QB   = WS_MIX  + al256((size_t)TA * DM * 2);
constexpr size_t WS_KB   = WS_QB   + al256((size_t)TA * 1024 * 2);
constexpr size_t WS_VB   = WS_KB   + al256((size_t)TA * 256 * 2);
constexpr size_t WS_WIN  = WS_VB   + al256((size_t)TA * 256 * 2);
constexpr size_t WS_WOUT = WS_WIN  + al256((size_t)NL * ZLD * DM * 2);
constexpr size_t WS_MOD  = WS_WOUT + al256((size_t)NL * DM * DM * 2);
constexpr size_t WS_WG   = WS_MOD  + al256((size_t)NL * 2 * 6144 * 4);
constexpr size_t WS_LA   = WS_WG   + al256((size_t)NL * 2 * 2 * 8 * 4096 * 2);
constexpr size_t WS_LB   = WS_LA   + al256((size_t)2 * TA * 512 * 4);
constexpr size_t WS_LSEG = WS_LB   + al256((size_t)2 * TA * 512 * 4);
constexpr size_t WS_LCAR = WS_LSEG + al256((size_t)2 * NCH * 512 * 2 * 4);
constexpr size_t WS_GW   = WS_LCAR + al256((size_t)2 * NCH * 512 * 4);
constexpr size_t WS_GQH  = WS_GW   + al256((size_t)8 * NCH * 8192 * 2);
constexpr size_t WS_GKT  = WS_GQH  + al256((size_t)8 * NCH * 8192 * 2);
constexpr size_t WS_GQK  = WS_GKT  + al256((size_t)8 * NCH * 8192 * 2);
constexpr size_t WS_GU   = WS_GQK  + al256((size_t)8 * NCH * 4096 * 2);
constexpr size_t WS_GGL  = WS_GU   + al256((size_t)8 * NCH * 8192 * 4);
constexpr size_t WS_GO   = WS_GGL  + al256((size_t)8 * NCH * 4);
constexpr size_t WS_END  = WS_GO   + al256((size_t)2 * TA * 512 * 4);

struct Params {
  const float *x, *c, *ctx, *c_ctx, *norm_g, *w_mod, *b_mod, *w_in, *conv_a_w, *conv_a_b, *w_ra, *b_ra, *w_ia, *b_ia, *lam_a,
              *conv_b_w, *a_log_b, *dt_bias_b, *onorm_b, *qn_c, *kn_c, *w_out, *final_g;
  float* out; unsigned char* ws;
};

__device__ __forceinline__ unsigned cvtpk2(float lo, float hi) { unsigned r; asm volatile("v_cvt_pk_bf16_f32 %0, %1, %2" : "=v"(r) : "v"(lo), "v"(hi)); return r; }
__device__ __forceinline__ bf16_t f2bf(float x) { return (bf16_t)(cvtpk2(x, 0.f) & 0xffffu); }
__device__ __forceinline__ float bf2f(bf16_t b) { return __uint_as_float(((unsigned)b) << 16); }
__device__ __forceinline__ float sigmoidf_(float x) { return 1.f / (1.f + expf(-x)); }
__device__ __forceinline__ float siluf_(float x) { return x / (1.f + expf(-x)); }
__device__ __forceinline__ float softplusf_(float x) { return fmaxf(x, 0.f) + log1pf(expf(-fabsf(x))); }
__device__ __forceinline__ float wave_sum(float v) {
#pragma unroll
  for (int o = 32; o >= 1; o >>= 1) v += __shfl_xor(v, o);
  return v;
}
__device__ __forceinline__ bf16x8_t pack8(f32x4_t a, f32x4_t b) {
  u32x4_t w = {cvtpk2(a[0], a[1]), cvtpk2(a[2], a[3]), cvtpk2(b[0], b[1]), cvtpk2(b[2], b[3])};
  return *reinterpret_cast<bf16x8_t*>(&w);
}
namespace pg8 {
#define PG8_LAS __attribute__((address_space(3)))
typedef unsigned short bf16_t;
typedef short bf16x8 __attribute__((ext_vector_type(8)));
typedef float f32x4 __attribute__((ext_vector_type(4)));
typedef unsigned u32x4 __attribute__((ext_vector_type(4)));
constexpr int BM = 256, BK = 64, HALF = 128, HTB = HALF * BK * 2  , STAGE_BYTES = 8 * HTB, NXCD = 8, WGM = 8;

__host__ __device__ __forceinline__ int lds_byte(int r, int c) { const int st = (r >> 4) * 2 + (c >> 5), rr = r & 15, cc = c & 31, ob = rr * 64 + cc * 2; return st * 1024 + (ob ^ (((ob >> 9) & 1) << 5)); }
__host__ __device__ __forceinline__ void stage_rc(int b, int& R, int& C) { const int st = b / 1024, sb = b % 1024, swz = sb ^ (((sb >> 9) & 1) << 5); R = (st >> 1) * 16 + swz / 64; C = (st & 1) * 32 + (swz % 64) / 2; }
__host__ __device__ __forceinline__ int perm32(int rho) { const int n = rho >> 4, i = rho & 15; return 8 * (i >> 2) + 4 * n + (i & 3); }

struct Unit { int pm, pn; };
struct Gemm { const bf16_t* A; const bf16_t* Bt; int M, N, K; };

struct StaticOrder {
    int nM, nN, nwg, G, c;
    __host__ __device__ void init(int M, int N, int G_, int c_) { nM = M / BM; nN = N / BM; nwg = nM * nN; G = G_; c = c_; }
    __host__ __device__ bool next(int i, Unit& u) const {
        const long L = (long)i * G + c; if (L >= nwg) return false;
        int wgid = (int)L; { const int q = nwg / NXCD, r = nwg % NXCD, xcd = wgid % NXCD, off = wgid / NXCD; wgid = (xcd < r ? xcd * (q + 1) : r * (q + 1) + (xcd - r) * q) + off; }
        const int nig = WGM * nN, gid = wgid / nig, fm = gid * WGM, gsz = (nM - fm) < WGM ? (nM - fm) : WGM;
        u.pm = fm + ((wgid % nig) % gsz); u.pn = (wgid % nig) / gsz; return true;
    }
    __device__ __forceinline__ void a_ready(const Unit&) const {}
    __device__ __forceinline__ void done(const Unit&) const {}
};
__device__ __forceinline__ unsigned cvt_pk_bf16(float lo, float hi) { unsigned r; asm volatile("v_cvt_pk_bf16_f32 %0, %1, %2" : "=v"(r) : "v"(lo), "v"(hi)); return r; }
template <class Epi, class Sched, bool STAMP = false>
__device__ __forceinline__ void gemm_phase(PG8_LAS unsigned char* lds, const Gemm g, const Sched& S, const Epi& E, unsigned long long* stamps) {
    const int tid = threadIdx.x, wid = __builtin_amdgcn_readfirstlane(tid >> 6), lane = tid & 63, wr = wid >> 2, wc = wid & 3, fr = lane & 15, fq = lane >> 4;
    const int K = g.K, nt = K / BK;
    int ts_lo = 0, ts_hi = 0, nts = 0; const unsigned long long rt_entry = STAMP ? (unsigned long long)wall_clock64() : 0ull;
#define PG8_STAMP() do { if (STAMP && wid == 0 && nts < 64) { const unsigned long long _c = (unsigned long long)clock64(); \
        ts_lo = (lane == nts) ? (int)(unsigned)_c : ts_lo; ts_hi = (lane == nts) ? (int)(unsigned)(_c >> 32) : ts_hi; ++nts; } } while (0)
    PG8_STAMP();
    unsigned voffA[2], voffB[2];
#pragma unroll
    for (int i = 0; i < 2; ++i) { int R, C; stage_rc(tid * 16 + i * 8192, R, C); const int Rb = Epi::PERM ? ((R & ~31) + perm32(R & 31)) : R;
        voffA[i] = (unsigned)(R * K + C) * 2u; voffB[i] = (unsigned)(Rb * K + C) * 2u; }
    const size_t kstep = (size_t)(BK * 2);
    const size_t hstep = (size_t)HALF * K * 2;
    const size_t tstep = 2 * hstep;
    const unsigned ldsw = (unsigned)wid * 1024u;
    const int aoff = lds_byte(wr * 64 + fr, fq * 8), boff = lds_byte(wc * 32 + fr, fq * 8);
#define PG8_SA(b, h) (((b) * 2 + (h)) * HTB)
#define PG8_SB(b, h) ((4 + (b) * 2 + (h)) * HTB)
#define PG8_STAGE(bufoff, gbase, voff) do { _Pragma("unroll") for (int _i = 0; _i < 2; ++_i) \
        __builtin_amdgcn_global_load_lds((const unsigned*)((const char*)(gbase) + (voff)[_i]), (PG8_LAS unsigned*)(lds + (bufoff) + ldsw + _i * 8192), 16, 0, 0); } while (0)
#define PG8_LDA(dst, b, h) do { _Pragma("unroll") for (int m = 0; m < 4; ++m) _Pragma("unroll") for (int k = 0; k < 2; ++k) dst[m][k] = *(const PG8_LAS bf16x8*)(lds + PG8_SA(b, h) + aoff + m * 2048 + k * 1024); } while (0)
#define PG8_LDB(dst, b, h) do { _Pragma("unroll") for (int n = 0; n < 2; ++n) _Pragma("unroll") for (int k = 0; k < 2; ++k) dst[n][k] = *(const PG8_LAS bf16x8*)(lds + PG8_SB(b, h) + boff + n * 2048 + k * 1024); } while (0)
#define PG8_MMA(ai, bj, At, Bt) do { __builtin_amdgcn_s_setprio(1); _Pragma("unroll") for (int m = 0; m < 4; ++m) _Pragma("unroll") for (int n = 0; n < 2; ++n) _Pragma("unroll") for (int k = 0; k < 2; ++k) \
        acc[ai][bj][m][n] = __builtin_amdgcn_mfma_f32_16x16x32_bf16(Bt[n][k], At[m][k], acc[ai][bj][m][n], 0, 0, 0); __builtin_amdgcn_s_setprio(0); } while (0)
#define PG8_WAIT_V(n) asm volatile("s_waitcnt vmcnt(" #n ")" ::: "memory")
#define PG8_WAIT_L(n) asm volatile("s_waitcnt lgkmcnt(" #n ")" ::: "memory")
#define PG8_BAR __builtin_amdgcn_s_barrier()
#define PG8_SCHED __builtin_amdgcn_sched_barrier(0)
    Unit cur, nxt; int ui = 0;
    if (!S.next(0, cur)) return;
    f32x4 acc[2][2][4][2];
#pragma unroll
    for (int a = 0; a < 2; ++a)
#pragma unroll
        for (int b = 0; b < 2; ++b)
#pragma unroll
            for (int m = 0; m < 4; ++m)
#pragma unroll
                for (int n = 0; n < 2; ++n) acc[a][b][m][n] = (f32x4){0.f, 0.f, 0.f, 0.f};
    bf16x8 At[4][2], B0[2][2], B1[2][2];
    const char* cA = (const char*)g.A + (size_t)cur.pm * tstep; const char* cB = (const char*)g.Bt + (size_t)cur.pn * tstep;
    S.a_ready(cur);
    PG8_STAGE(PG8_SB(0, 0), cB, voffB); PG8_STAGE(PG8_SA(0, 0), cA, voffA); PG8_STAGE(PG8_SB(0, 1), cB + hstep, voffB); PG8_STAGE(PG8_SA(0, 1), cA + hstep, voffA);
    if (wr == 1) PG8_BAR;
    PG8_WAIT_V(4); PG8_BAR;
    PG8_STAGE(PG8_SB(1, 0), cB + kstep, voffB); PG8_STAGE(PG8_SA(1, 0), cA + kstep, voffA); PG8_STAGE(PG8_SB(1, 1), cB + hstep + kstep, voffB);
    PG8_WAIT_V(6); PG8_BAR;
    PG8_STAMP();
    for (;;) {
        const bool has_next = S.next(ui + 1, nxt);
        const char* nA = has_next ? (const char*)g.A + (size_t)nxt.pm * tstep : cA; const char* nB = has_next ? (const char*)g.Bt + (size_t)nxt.pn * tstep : cB;
        for (int t = 0; t < nt; t += 2) {
            const bool last = (t == nt - 2);
            const char* a1 = cA + (size_t)(t + 1) * kstep;
            const char* a2 = last ? nA : cA + (size_t)(t + 2) * kstep; const char* b2 = last ? nB : cB + (size_t)(t + 2) * kstep;
            const char* a3 = a2 + kstep; const char* b3 = b2 + kstep;
            if (last && has_next) S.a_ready(nxt);
            PG8_LDB(B0, 0, 0); PG8_SCHED; PG8_LDA(At, 0, 0); PG8_STAGE(PG8_SA(1, 1), a1 + hstep, voffA);
            PG8_WAIT_L(8); PG8_BAR; PG8_WAIT_L(0); PG8_MMA(0, 0, At, B0); PG8_BAR; PG8_SCHED;
            PG8_LDB(B1, 0, 1); PG8_STAGE(PG8_SB(0, 0), b2, voffB);
            PG8_BAR; PG8_WAIT_L(0); PG8_MMA(0, 1, At, B1); PG8_BAR;
            PG8_LDA(At, 0, 1); PG8_STAGE(PG8_SA(0, 0), a2, voffA);
            PG8_BAR; PG8_WAIT_L(0); PG8_MMA(1, 0, At, B0); PG8_BAR; PG8_SCHED;
            PG8_STAGE(PG8_SB(0, 1), b2 + hstep, voffB);
            PG8_WAIT_V(6); PG8_BAR; PG8_MMA(1, 1, At, B1); PG8_BAR;
            PG8_LDB(B0, 1, 0); PG8_SCHED; PG8_LDA(At, 1, 0); PG8_STAGE(PG8_SA(0, 1), a2 + hstep, voffA);
            PG8_WAIT_L(8); PG8_BAR; PG8_WAIT_L(0); PG8_MMA(0, 0, At, B0); PG8_BAR; PG8_SCHED;
            PG8_LDB(B1, 1, 1); PG8_STAGE(PG8_SB(1, 0), b3, voffB);
            PG8_BAR; PG8_WAIT_L(0); PG8_MMA(0, 1, At, B1); PG8_BAR;
            PG8_LDA(At, 1, 1); PG8_STAGE(PG8_SA(1, 0), a3, voffA);
            PG8_BAR; PG8_WAIT_L(0); PG8_MMA(1, 0, At, B0); PG8_BAR; PG8_SCHED;
            PG8_STAGE(PG8_SB(1, 1), b3 + hstep, voffB);
            PG8_WAIT_V(6); PG8_BAR; PG8_MMA(1, 1, At, B1); PG8_BAR;
        }
        PG8_STAMP();
        if constexpr (!Epi::AFTER_DRAIN) { E(acc, cur, wr, wc, fr, fq); S.done(cur); }
        PG8_STAMP();
        if (!has_next) break;
#pragma unroll
        for (int a = 0; a < 2; ++a)
#pragma unroll
            for (int b = 0; b < 2; ++b)
#pragma unroll
                for (int m = 0; m < 4; ++m)
#pragma unroll
                    for (int n = 0; n < 2; ++n) acc[a][b][m][n] = (f32x4){0.f, 0.f, 0.f, 0.f};
        cur = nxt; cA = nA; cB = nB; ++ui;
    }
    PG8_WAIT_V(0);
    if (wr == 0) PG8_BAR;
    PG8_BAR;
    if constexpr (Epi::AFTER_DRAIN) { E.fused(acc, cur, wr, wc, fr, fq, lds, wid, lane); S.done(cur); }
    PG8_STAMP();
    if (STAMP && wid == 0) { stamps[lane] = lane < nts ? (((unsigned long long)(unsigned)ts_hi << 32) | (unsigned)ts_lo) : 0ull;
        if (lane == 62) stamps[62] = rt_entry; if (lane == 63) stamps[63] = (unsigned long long)wall_clock64(); }
#undef PG8_STAMP
#undef PG8_SA
#undef PG8_SB
#undef PG8_STAGE
#undef PG8_LDA
#undef PG8_LDB
#undef PG8_MMA
#undef PG8_WAIT_V
#undef PG8_WAIT_L
#undef PG8_BAR
#undef PG8_SCHED
}
}
namespace pg8 {
struct EpiZ {
    static constexpr bool PERM = true, AFTER_DRAIN = false;
    bf16_t* O; int ldc;
    __device__ __forceinline__ void operator()(const f32x4 (&acc)[2][2][4][2], const Unit& u, int wr, int wc, int fr, int fq) const {
        const int row0 = u.pm * BM + wr * 64 + fr, col0 = u.pn * BM + wc * 32 + 8 * fq;
#pragma unroll
        for (int ai = 0; ai < 2; ++ai)
#pragma unroll
            for (int m = 0; m < 4; ++m) { bf16_t* rowp = O + (size_t)(row0 + ai * HALF + m * 16) * ldc + col0;
#pragma unroll
                for (int bj = 0; bj < 2; ++bj) { const f32x4 v0 = acc[ai][bj][m][0], v1 = acc[ai][bj][m][1];
                    u32x4 w; w.x = cvt_pk_bf16(v0[0], v0[1]); w.y = cvt_pk_bf16(v0[2], v0[3]); w.z = cvt_pk_bf16(v1[0], v1[1]); w.w = cvt_pk_bf16(v1[2], v1[3]);
                    *(u32x4*)(rowp + bj * HALF) = w; } }
    }
};
struct EpiRes {
    static constexpr bool PERM = false, AFTER_DRAIN = false;
    float* H; const float* gate_ctx; const float* gate_lat; int row_off;
    __device__ __forceinline__ void operator()(const f32x4 (&acc)[2][2][4][2], const Unit& u, int wr, int wc, int fr, int fq) const {
        const int row0 = row_off + u.pm * BM + wr * 64 + fr, col0 = u.pn * BM + wc * 32 + 4 * fq;
        const float* gt = (row_off + u.pm * BM) < 256 ? gate_ctx : gate_lat;
        f32x4 gv[2][2];
#pragma unroll
        for (int bj = 0; bj < 2; ++bj)
#pragma unroll
            for (int n = 0; n < 2; ++n) gv[bj][n] = *(const f32x4*)(gt + col0 + bj * HALF + n * 16);
#pragma unroll
        for (int ai = 0; ai < 2; ++ai)
#pragma unroll
            for (int m = 0; m < 4; ++m) { float* rowp = H + (size_t)(row0 + ai * HALF + m * 16) * 2048 + col0;
#pragma unroll
                for (int bj = 0; bj < 2; ++bj)
#pragma unroll
                    for (int n = 0; n < 2; ++n) { f32x4* q = (f32x4*)(rowp + bj * HALF + n * 16); *q = *q + gv[bj][n] * acc[ai][bj][m][n]; } }
    }
};
}

namespace att {
using bf16 = unsigned short;
constexpr int   D = 128, NW = 8, QBLK = 32, KVBLK = 64;
constexpr float SCALE = 0.088388347648318440f;
constexpr float THR = 8.f;
constexpr int SDEPTH = 2;
constexpr int LDQ = 1024, LDK = 256, LDV = 5888, LDG = 5888, LDO = 2048;
constexpr size_t SHM_V = KVBLK * D * 2, SHM_K = KVBLK * D * 2, SHM_ATTN = 2 * SHM_V + 2 * SHM_K + NW * 64 * 4;
using bf16x8 = __attribute__((ext_vector_type(8))) short;
using s16x4  = __attribute__((ext_vector_type(4))) short;
using f32x16 = __attribute__((ext_vector_type(16))) float;
using f32x8  = __attribute__((ext_vector_type(8))) float;
using u32x4  = __attribute__((ext_vector_type(4))) unsigned;
#define KSWZ(row, colB) ((row) * 256 + ((colB) ^ (((row) & 7) << 4)))
#define SBAR() __builtin_amdgcn_sched_barrier(0)
__device__ __forceinline__ int crow(int r, int hi) { return (r & 3) + 8 * (r >> 2) + 4 * hi; }
__device__ __forceinline__ unsigned cvtpk(float lo, float hi) {
  unsigned r; asm volatile("v_cvt_pk_bf16_f32 %0, %1, %2" : "=v"(r) : "v"(lo), "v"(hi)); return r;
}
template <typename TIn> struct Stage;
template <> struct Stage<bf16>  { using T = bf16x8;
  __device__ static __forceinline__ T ld8(const bf16* p) { return *reinterpret_cast<const bf16x8*>(p); }
  __device__ static __forceinline__ bf16x8 tobf(T x) { return x; } };
template <> struct Stage<float> { using T = f32x8;
  __device__ static __forceinline__ T ld8(const float* p) { return *reinterpret_cast<const f32x8*>(p); }
  __device__ static __forceinline__ bf16x8 tobf(T x) {
    u32x4 w = {cvtpk(x[0], x[1]), cvtpk(x[2], x[3]), cvtpk(x[4], x[5]), cvtpk(x[6], x[7])}; return *reinterpret_cast<bf16x8*>(&w); } };

__device__ __forceinline__ void partialSM(f32x16& p0, f32x16& p1, float& m_reg, float& mn, float& alpha) {
  constexpr float C = SCALE * 1.4426950408889634f;
  float pmax = p0[0]; for (int r = 1; r < 16; ++r) pmax = fmaxf(pmax, p0[r]); for (int r = 0; r < 16; ++r) pmax = fmaxf(pmax, p1[r]);
  { auto rr = __builtin_amdgcn_permlane32_swap(__float_as_uint(pmax), __float_as_uint(pmax), false, false);
    pmax = fmaxf(__uint_as_float(rr[0]), __uint_as_float(rr[1])); }
  if (__builtin_expect(__all(pmax - m_reg <= THR / SCALE), 1)) { mn = m_reg; alpha = 1.f; }
  else { mn = fmaxf(m_reg, pmax); alpha = __builtin_amdgcn_exp2f((m_reg - mn) * C); m_reg = mn; }
  float mnC = -mn * C;
  for (int r = 0; r < 16; ++r) p0[r] = fmaf(p0[r], C, mnC); for (int r = 0; r < 16; ++r) p1[r] = fmaf(p1[r], C, mnC);
  for (int r = 0; r < 16; ++r) p0[r] = __builtin_amdgcn_exp2f(p0[r]);
}
__device__ __forceinline__ void finishSM(f32x16& p0, f32x16& p1, float alpha, float& l_reg, bf16x8& pa0, bf16x8& pa1, bf16x8& pa2, bf16x8& pa3) {
  for (int r = 0; r < 16; ++r) p1[r] = __builtin_amdgcn_exp2f(p1[r]);
  float ps = 0; for (int r = 0; r < 16; ++r) ps += p0[r]; for (int r = 0; r < 16; ++r) ps += p1[r];
  { auto rr = __builtin_amdgcn_permlane32_swap(__float_as_uint(ps), __float_as_uint(ps), false, false);
    ps = __uint_as_float(rr[0]) + __uint_as_float(rr[1]); }
  l_reg = l_reg * alpha + ps;
#define PK4(P, BASE, OUT) do { unsigned a0 = cvtpk(P[BASE + 0], P[BASE + 1]), a1 = cvtpk(P[BASE + 2], P[BASE + 3]);   \
    unsigned b0 = cvtpk(P[BASE + 4], P[BASE + 5]), b1 = cvtpk(P[BASE + 6], P[BASE + 7]);                              \
    auto r0 = __builtin_amdgcn_permlane32_swap(a0, b0, false, false); auto r1 = __builtin_amdgcn_permlane32_swap(a1, b1, false, false); \
    u32x4 w = {r0[0], r1[0], r0[1], r1[1]}; OUT = *reinterpret_cast<bf16x8*>(&w); } while (0)
  PK4(p0, 0, pa0); PK4(p0, 8, pa1); PK4(p1, 0, pa2); PK4(p1, 8, pa3);
#undef PK4
}
__device__ __forceinline__ void qkt(f32x16& p0, f32x16& p1, const bf16* Ks, const bf16x8* qr, int r32, int hi) {
  p0 = f32x16{}; p1 = f32x16{};
  for (int d0 = 0; d0 < 8; ++d0) { int cb = (d0 * 16 + hi * 8) * 2;
    bf16x8 b0 = *reinterpret_cast<const bf16x8*>((const char*)Ks + KSWZ(r32, cb));
    bf16x8 b1 = *reinterpret_cast<const bf16x8*>((const char*)Ks + KSWZ(32 + r32, cb));
    p0 = __builtin_amdgcn_mfma_f32_32x32x16_bf16(b0, qr[d0], p0, 0, 0, 0);
    p1 = __builtin_amdgcn_mfma_f32_32x32x16_bf16(b1, qr[d0], p1, 0, 0, 0); }
}
__device__ __forceinline__ int v_st(int k, int c) { const int kk = (k & ~0xC) | ((k & 4) << 1) | ((k & 8) >> 1); return ((kk >> 3) * 4 + (c >> 5)) * 512 + ((kk & 7) * 32 + (c & 31)) * 2; }
__device__ __forceinline__ int v_rd_base(int lane) { return ((lane & 3) << 3) | (((lane >> 2) & 3) << 6) | (((lane >> 4) & 1) << 5) | (((lane >> 5) & 1) << 8); }
constexpr int v_rd_off(int d0, int ks, int half) { return d0 * 512 + ks * 4096 + half * 2048; }
template <int OFF> __device__ __forceinline__ s16x4 tr_read(int vb) {
  s16x4 r; asm volatile("ds_read_b64_tr_b16 %0, %1 offset:%2" : "=&v"(r) : "v"(vb), "i"(OFF) : "memory"); return r;
}
template <int D0> __device__ __forceinline__ void pv_one(f32x16& od, int vb, bf16x8 pa0, bf16x8 pa1, bf16x8 pa2, bf16x8 pa3) {
  const s16x4 l0 = tr_read<v_rd_off(D0, 0, 0)>(vb), h0 = tr_read<v_rd_off(D0, 0, 1)>(vb), l1 = tr_read<v_rd_off(D0, 1, 0)>(vb), h1 = tr_read<v_rd_off(D0, 1, 1)>(vb);
  const s16x4 l2 = tr_read<v_rd_off(D0, 2, 0)>(vb), h2 = tr_read<v_rd_off(D0, 2, 1)>(vb), l3 = tr_read<v_rd_off(D0, 3, 0)>(vb), h3 = tr_read<v_rd_off(D0, 3, 1)>(vb);
  asm volatile("s_waitcnt lgkmcnt(0)" ::: "memory"); SBAR();
#define PK(L, H) (bf16x8){L[0], L[1], L[2], L[3], H[0], H[1], H[2], H[3]}
  od = __builtin_amdgcn_mfma_f32_32x32x16_bf16(pa0, PK(l0, h0), od, 0, 0, 0);
  od = __builtin_amdgcn_mfma_f32_32x32x16_bf16(pa1, PK(l1, h1), od, 0, 0, 0);
  od = __builtin_amdgcn_mfma_f32_32x32x16_bf16(pa2, PK(l2, h2), od, 0, 0, 0);
  od = __builtin_amdgcn_mfma_f32_32x32x16_bf16(pa3, PK(l3, h3), od, 0, 0, 0);
#undef PK
}
__device__ __forceinline__ void pv_d0(f32x16* o, int vb, bf16x8 pa0, bf16x8 pa1, bf16x8 pa2, bf16x8 pa3) {
  pv_one<0>(o[0], vb, pa0, pa1, pa2, pa3); pv_one<1>(o[1], vb, pa0, pa1, pa2, pa3); pv_one<2>(o[2], vb, pa0, pa1, pa2, pa3); pv_one<3>(o[3], vb, pa0, pa1, pa2, pa3);
}
__device__ __forceinline__ void attn_dense_body(const bf16* __restrict__ Qb, const bf16* __restrict__ Kh, const bf16* __restrict__ Vh,
                                                const bf16* __restrict__ Gz, bf16* __restrict__ Mx, int seq, char* lds) {
  using TQ = bf16;
  using St = Stage<bf16>; using SQ = Stage<TQ>;
  const int tid = threadIdx.x, wid = tid >> 6, lane = tid & 63, r32 = lane & 31, hi = lane >> 5;
  bf16* V_lds = (bf16*)lds; bf16* K_lds = (bf16*)(lds + 2 * SHM_V);
  float* ws = (float*)(lds + 2 * SHM_V + 2 * SHM_K) + wid * 64; float* li_l = ws; float* al_l = ws + 32;
  float m_reg = -1e30f, l_reg = 0; f32x16 o[4] = {}; bf16x8 qr[8];
  const TQ* Qw = Qb + (long)(wid * QBLK + r32) * LDQ + hi * 8;
#pragma unroll
  for (int d0 = 0; d0 < 8; ++d0) qr[d0] = SQ::tobf(SQ::ld8(Qw + d0 * 16));
  const int sr = tid >> 4, sc = (tid & 15) * 8, vst0 = v_st(sr, sc), vst1 = v_st(32 + sr, sc);
  const int vb0 = (int)(uintptr_t)V_lds + v_rd_base(lane);
  struct { typename St::T vs0, vs1, ks0, ks1; } sr_[SDEPTH];
#define SLOAD(i, k0) do { sr_[i].vs0 = St::ld8(&Vh[(long)((k0) + sr) * LDK + sc]); sr_[i].vs1 = St::ld8(&Vh[(long)((k0) + 32 + sr) * LDK + sc]); \
    sr_[i].ks0 = St::ld8(&Kh[(long)((k0) + sr) * LDK + sc]); sr_[i].ks1 = St::ld8(&Kh[(long)((k0) + 32 + sr) * LDK + sc]); } while (0)
#define SWRITE(b, i) do { *(bf16x8*)((char*)V_lds + (b) * SHM_V + vst0) = St::tobf(sr_[i].vs0);          \
    *(bf16x8*)((char*)V_lds + (b) * SHM_V + vst1) = St::tobf(sr_[i].vs1); int kc = sc * 2;               \
    *(bf16x8*)((char*)K_lds + (b) * SHM_K + KSWZ(sr, kc)) = St::tobf(sr_[i].ks0);                       \
    *(bf16x8*)((char*)K_lds + (b) * SHM_K + KSWZ(32 + sr, kc)) = St::tobf(sr_[i].ks1); } while (0)
#define SWAIT() do { if constexpr (SDEPTH == 2) asm volatile("s_waitcnt vmcnt(4)" ::: "memory"); else asm volatile("s_waitcnt vmcnt(0)" ::: "memory"); } while (0)
#define RESC(a) do { if (__any((a) < 1.f)) { if (hi == 0) al_l[r32] = (a); asm volatile("s_waitcnt lgkmcnt(0)" ::: "memory"); \
    for (int d = 0; d < 4; ++d) for (int r = 0; r < 16; ++r) o[d][r] *= al_l[crow(r, hi)]; } } while (0)
  f32x16 pA0, pA1, pB0, pB1; float mnA, mnB, alA, alB; bf16x8 pa0, pa1, pa2, pa3; const int NT = seq / KVBLK;
  constexpr int SE = 0, SO = SDEPTH - 1;
  SLOAD(SE, 0); asm volatile("s_waitcnt vmcnt(0)" ::: "memory"); SWRITE(0, SE); __syncthreads();
  qkt(pA0, pA1, K_lds, qr, r32, hi); partialSM(pA0, pA1, m_reg, mnA, alA);
  SLOAD(SO, KVBLK); if constexpr (SDEPTH == 2) { if (2 < NT) SLOAD(SE, 2 * KVBLK); }
  SWAIT(); SWRITE(1, SO); __syncthreads();
  for (int j = 1; j + 1 < NT; j += 2) {
    SBAR(); qkt(pB0, pB1, (bf16*)((char*)K_lds + SHM_K), qr, r32, hi);
    finishSM(pA0, pA1, alA, l_reg, pa0, pa1, pa2, pa3); SBAR();
    SLOAD(SO, (j + SDEPTH) * KVBLK); SBAR();
    pv_d0(o, vb0, pa0, pa1, pa2, pa3); partialSM(pB0, pB1, m_reg, mnB, alB);
    __syncthreads(); SWAIT(); SWRITE(0, SE);
    RESC(alB); __syncthreads();
    SBAR(); qkt(pA0, pA1, K_lds, qr, r32, hi);
    finishSM(pB0, pB1, alB, l_reg, pa0, pa1, pa2, pa3); SBAR();
    if (SDEPTH == 1 || j + 3 < NT) SLOAD(SE, (j + 1 + SDEPTH) * KVBLK); SBAR();
    pv_d0(o, vb0 + (int)SHM_V, pa0, pa1, pa2, pa3); partialSM(pA0, pA1, m_reg, mnA, alA);
    __syncthreads(); SWAIT(); SWRITE(1, SO);
    RESC(alA); __syncthreads();
  }
  SBAR(); qkt(pB0, pB1, (bf16*)((char*)K_lds + SHM_K), qr, r32, hi);
  finishSM(pA0, pA1, alA, l_reg, pa0, pa1, pa2, pa3); SBAR();
  pv_d0(o, vb0, pa0, pa1, pa2, pa3); partialSM(pB0, pB1, m_reg, mnB, alB);
  __syncthreads(); RESC(alB);
  finishSM(pB0, pB1, alB, l_reg, pa0, pa1, pa2, pa3); SBAR();
  pv_d0(o, vb0 + (int)SHM_V, pa0, pa1, pa2, pa3);
  if (hi == 0) li_l[r32] = l_reg; asm volatile("s_waitcnt lgkmcnt(0)" ::: "memory");
  float rli[16];
#pragma unroll
  for (int r = 0; r < 16; ++r) rli[r] = __builtin_amdgcn_rcpf(li_l[crow(r, hi)]);
  bf16* Mw = Mx + (long)(wid * QBLK) * LDO;
#pragma unroll
  for (int r = 0; r < 16; ++r) { int orow = crow(r, hi);
#pragma unroll
    for (int d0 = 0; d0 < 4; ++d0) Mw[(long)orow * LDO + d0 * 32 + r32] = f2bf(o[d0][r] * rli[r]); }
#undef SLOAD
#undef SWRITE
#undef SWAIT
#undef RESC
}
}

__device__ void phase_prep0(const Params& p, unsigned char* smem) {
  const int tid = threadIdx.x, nb = gridDim.x, bid = blockIdx.x;
  {
    float4* h4 = (float4*)(p.ws + WS_H);
    const float4* c4 = (const float4*)p.ctx; const float4* x4 = (const float4*)p.x;
    const long nctx = (long)TC * DM / 4, ntot = (long)TA * DM / 4;
    for (long i = (long)bid * 512 + tid; i < ntot; i += (long)nb * 512) h4[i] = i < nctx ? c4[i] : x4[i - nctx];
  }
  {
    float* tile = (float*)smem;
    constexpr int NT_IN = 32 * 92, NT_OUT = 32 * 32, PER_L = NT_IN + NT_OUT;
    for (int it = bid; it < NL * PER_L; it += nb) {
      const int l = it / PER_L; int r = it % PER_L;
      const bool isin = r < NT_IN;
      const float* src; bf16_t* dst; int kt, nt, ldsrc;
      if (isin) { kt = r / 92; nt = r % 92; src = p.w_in + (size_t)l * DM * DIN; ldsrc = DIN; dst = (bf16_t*)(p.ws + WS_WIN) + (size_t)l * ZLD * DM; }
      else { r -= NT_IN; kt = r / 32; nt = r % 32; src = p.w_out + (size_t)l * DM * DM; ldsrc = DM; dst = (bf16_t*)(p.ws + WS_WOUT) + (size_t)l * DM * DM; }
      __syncthreads();
      for (int e = tid; e < 4096; e += 512) {
        const int kk = e >> 6, nn = e & 63, n = nt * 64 + nn;
        const int oc = isin ? (n < 3072 ? n : (n < 5632 ? n + 16 : (n < 5648 ? n - 2560 : -1))) : n;
        tile[kk * 65 + nn] = oc >= 0 ? src[(size_t)(kt * 64 + kk) * ldsrc + oc] : 0.f;
      }
      __syncthreads();
      {
        const int nn = tid >> 3, k8 = tid & 7; float v[8];
#pragma unroll
        for (int i = 0; i < 8; ++i) v[i] = tile[(k8 * 8 + i) * 65 + nn];
        u32x4_t w = {cvtpk2(v[0], v[1]), cvtpk2(v[2], v[3]), cvtpk2(v[4], v[5]), cvtpk2(v[6], v[7])};
        *(u32x4_t*)(dst + (size_t)(nt * 64 + nn) * DM + kt * 64 + k8 * 8) = w;
      }
    }
  }
  {
    bf16_t* wg = (bf16_t*)(p.ws + WS_WG);
    const int total = NL * 2 * 2 * 8 * 4096;
    for (int e = bid * 512 + tid; e < total; e += nb * 512) {
      const int i = e & 63, j = (e >> 6) & 63, n = (e >> 12) & 7, g = (e >> 15) & 1, d = (e >> 16) & 1, l = e >> 17;
      const float* src = g ? p.w_ia : p.w_ra;
      wg[e] = f2bf(src[((((size_t)l * 2 + d) * 8 + n) * 64 + i) * 64 + j]);
    }
  }
  {
    __syncthreads();
    float* sc = (float*)smem;
    float* red = (float*)smem + 4096;
    for (int k = tid; k < 2048; k += 512) { sc[k] = siluf_(p.c[k]); sc[2048 + k] = siluf_(p.c_ctx[k]); }
    __syncthreads();
    float* mod = (float*)(p.ws + WS_MOD);
    const int cq = tid & 15, kg = tid >> 4;
    for (int it = bid; it < NL * 96; it += nb) {
      const int l = it / 96, j0 = (it % 96) * 64;
      const float* wp = p.w_mod + ((size_t)l * DM + kg * 64) * 6144 + j0 + cq * 4;
      float4 a0 = {0.f, 0.f, 0.f, 0.f}, a1 = {0.f, 0.f, 0.f, 0.f};
#pragma unroll 8
      for (int k = 0; k < 64; ++k) {
        const float4 w = *(const float4*)(wp + (size_t)k * 6144);
        const float s0 = sc[kg * 64 + k], s1 = sc[2048 + kg * 64 + k];
        a0.x += s0 * w.x; a0.y += s0 * w.y; a0.z += s0 * w.z; a0.w += s0 * w.w;
        a1.x += s1 * w.x; a1.y += s1 * w.y; a1.z += s1 * w.z; a1.w += s1 * w.w;
      }
      __syncthreads();
      *(float4*)(red + (kg * 2 + 0) * 64 + cq * 4) = a0;
      *(float4*)(red + (kg * 2 + 1) * 64 + cq * 4) = a1;
      __syncthreads();
      if (tid < 128) {
        const int s = tid >> 6, j = tid & 63; float acc = 0.f;
#pragma unroll 8
        for (int g = 0; g < 32; ++g) acc += red[(g * 2 + s) * 64 + j];
        mod[((size_t)l * 2 + s) * 6144 + j0 + j] = acc + p.b_mod[(size_t)l * 6144 + j0 + j];
      }
    }
    __syncthreads();
  }
}

__device__ void phase_norm(const Params& p, int l) {
  const int tid = threadIdx.x, lane = tid & 63, wid = tid >> 6;
  const float* H = (const float*)(p.ws + WS_H);
  bf16_t* XN = (bf16_t*)(p.ws + WS_XN);
  const float* g = p.norm_g + (size_t)l * DM;
  const float* mod = (const float*)(p.ws + WS_MOD) + (size_t)l * 2 * 6144;
  for (int r = blockIdx.x * 8 + wid; r < TA; r += gridDim.x * 8) {
    const float* hr = H + (size_t)r * DM;
    const float* md = mod + (r < TC ? 6144 : 0);
    float4 v[8]; float ss = 0.f;
#pragma unroll
    for (int i = 0; i < 8; ++i) { v[i] = *(const float4*)(hr + i * 256 + lane * 4); ss += v[i].x * v[i].x + v[i].y * v[i].y + v[i].z * v[i].z + v[i].w * v[i].w; }
    ss = wave_sum(ss);
    const float rstd = rsqrtf(ss * (1.f / DM) + 1e-6f);
#pragma unroll
    for (int i = 0; i < 8; ++i) {
      const int c = i * 256 + lane * 4;
      const float4 gg = *(const float4*)(g + c), sh = *(const float4*)(md + c), scl = *(const float4*)(md + 2048 + c);
      const float o0 = v[i].x * rstd * gg.x * (1.f + scl.x) + sh.x, o1 = v[i].y * rstd * gg.y * (1.f + scl.y) + sh.y;
      const float o2 = v[i].z * rstd * gg.z * (1.f + scl.z) + sh.z, o3 = v[i].w * rstd * gg.w * (1.f + scl.w) + sh.w;
      u32x2_t w = {cvtpk2(o0, o1), cvtpk2(o2, o3)};
      *(u32x2_t*)(XN + (size_t)r * DM + c) = w;
    }
  }
}

__device__ void phase_final(const Params& p) {
  const int tid = threadIdx.x, lane = tid & 63, wid = tid >> 6;
  const float* H = (const float*)(p.ws + WS_H);
  for (int t = blockIdx.x * 8 + wid; t < TL; t += gridDim.x * 8) {
    const float* hr = H + (size_t)(TC + t) * DM;
    float4 v[8]; float ss = 0.f;
#pragma unroll
    for (int i = 0; i < 8; ++i) { v[i] = *(const float4*)(hr + i * 256 + lane * 4); ss += v[i].x * v[i].x + v[i].y * v[i].y + v[i].z * v[i].z + v[i].w * v[i].w; }
    ss = wave_sum(ss);
    const float rstd = rsqrtf(ss * (1.f / DM) + 1e-6f);
#pragma unroll
    for (int i = 0; i < 8; ++i) {
      const int c = i * 256 + lane * 4;
      const float4 gg = *(const float4*)(p.final_g + c);
      float4 o = {v[i].x * rstd * gg.x, v[i].y * rstd * gg.y, v[i].z * rstd * gg.z, v[i].w * rstd * gg.w};
      *(float4*)(p.out + (size_t)t * DM + c) = o;
    }
  }
}

__device__ void phase_qkprep(const Params& p, int l) {
  const int tid = threadIdx.x, lane = tid & 63, wid = tid >> 6;
  const bf16_t* Z = (const bf16_t*)(p.ws + WS_Z);
  bf16_t* QB = (bf16_t*)(p.ws + WS_QB); bf16_t* KB = (bf16_t*)(p.ws + WS_KB); bf16_t* VB = (bf16_t*)(p.ws + WS_VB);
  const float gq1 = p.qn_c[l * 128 + lane], gq2 = p.qn_c[l * 128 + 64 + lane];
  const float gk1 = p.kn_c[l * 128 + lane], gk2 = p.kn_c[l * 128 + 64 + lane];
  const float inv_freq = exp2f(-(float)(lane & 31) * (13.287712379549449f / 32.f));
  for (int r = blockIdx.x * 8 + wid; r < TA; r += gridDim.x * 8) {
    float cs = 1.f, sn = 0.f;
    if (r >= TC) {
      const int t = r - TC; const float pos = (float)(lane < 32 ? (t >> 6) : (t & 63));
      const float ang = pos * inv_freq;
      const float k = rintf(ang * 0.15915494309189535f);
      float rr = fmaf(-k, 6.2831854820251465f, ang); rr = fmaf(-k, -1.7484555e-7f, rr);
      cs = cosf(rr); sn = sinf(rr);
    }
    const bf16_t* zr = Z + (size_t)r * ZLD;
#pragma unroll
    for (int hh = 0; hh < 10; ++hh) {
      const int zc = hh < 8 ? ZC_QC + hh * 128 : ZC_KC + (hh - 8) * 128;
      const float x1 = bf2f(zr[zc + lane]), x2 = bf2f(zr[zc + 64 + lane]);
      const float ss = wave_sum(x1 * x1 + x2 * x2);
      const float rstd = rsqrtf(ss * (1.f / 128.f) + 1e-6f);
      const float y1 = x1 * rstd * (hh < 8 ? gq1 : gk1), y2 = x2 * rstd * (hh < 8 ? gq2 : gk2);
      const float o1 = y1 * cs - y2 * sn, o2 = y2 * cs + y1 * sn;
      bf16_t* dst = hh < 8 ? QB + (size_t)r * 1024 + hh * 128 : KB + (size_t)r * 256 + (hh - 8) * 128;
      dst[lane] = f2bf(o1); dst[64 + lane] = f2bf(o2);
    }
    *(u32x2_t*)(VB + (size_t)r * 256 + lane * 4) = *(const u32x2_t*)(zr + ZC_VC + lane * 4);
  }
}

__device__ void phase_lru_ab(const Params& p, int l, unsigned char* smem) {
  const int tid = threadIdx.x, lane = tid & 63, wid = tid >> 6, fr = lane & 15, fq = lane >> 4;
  const bf16_t* Z = (const bf16_t*)(p.ws + WS_Z);
  float* uS = (float*)smem;
  bf16_t* uB = (bf16_t*)(smem + 16640);
  float* aS = (float*)(smem + 16640 + 9216);
  float* bS = aS + 2 * 64 * 64;
  float* LA = (float*)(p.ws + WS_LA); float* LB = (float*)(p.ws + WS_LB);
  float* LSEG = (float*)(p.ws + WS_LSEG);
  const bf16_t* WG = (const bf16_t*)(p.ws + WS_WG) + (size_t)l * 2 * 2 * 8 * 4096;
  for (int it = blockIdx.x; it < NCH * 8; it += gridDim.x) {
    const int rs = it >> 3, n = it & 7, r0 = rs * 64;
    const int seg_lo = r0 < TC ? 0 : TC, seg_hi = r0 < TC ? TC : TA;
    __syncthreads();
    {
      const int tk = tid >> 3, c8 = (tid & 7) * 8, ch0 = n * 64 + c8;
      float acc[8];
#pragma unroll
      for (int i = 0; i < 8; ++i) acc[i] = p.conv_a_b[l * 512 + ch0 + i];
#pragma unroll
      for (int kk = 0; kk < 4; ++kk) {
        const int rr = r0 + tk + kk - 2;
        if (rr >= seg_lo && rr < seg_hi) {
          const bf16x8_t xv = *(const bf16x8_t*)(Z + (size_t)rr * ZLD + ZC_XA + ch0);
          const float* cw = p.conv_a_w + ((size_t)l * 4 + kk) * 512 + ch0;
#pragma unroll
          for (int i = 0; i < 8; ++i) acc[i] += cw[i] * bf2f((bf16_t)xv[i]);
        }
      }
#pragma unroll
      for (int i = 0; i < 8; ++i) { uS[tk * 65 + c8 + i] = acc[i]; uB[tk * 72 + c8 + i] = f2bf(acc[i]); }
    }
    __syncthreads();
    {
      const int d = wid & 1, ct = wid >> 1;
      f32x4_t ar[4], ai[4];
#pragma unroll
      for (int m = 0; m < 4; ++m) { ar[m] = (f32x4_t){0.f, 0.f, 0.f, 0.f}; ai[m] = (f32x4_t){0.f, 0.f, 0.f, 0.f}; }
      const bf16_t* wr_ = WG + ((size_t)(d * 2 + 0) * 8 + n) * 4096 + (ct * 16 + fr) * 64;
      const bf16_t* wi_ = WG + ((size_t)(d * 2 + 1) * 8 + n) * 4096 + (ct * 16 + fr) * 64;
#pragma unroll
      for (int ks = 0; ks < 2; ++ks) {
        const bf16x8_t br = *(const bf16x8_t*)(wr_ + ks * 32 + fq * 8);
        const bf16x8_t bi = *(const bf16x8_t*)(wi_ + ks * 32 + fq * 8);
#pragma unroll
        for (int m = 0; m < 4; ++m) {
          const bf16x8_t a = *(const bf16x8_t*)(uB + (m * 16 + fr) * 72 + ks * 32 + fq * 8);
          ar[m] = __builtin_amdgcn_mfma_f32_16x16x32_bf16(a, br, ar[m], 0, 0, 0);
          ai[m] = __builtin_amdgcn_mfma_f32_16x16x32_bf16(a, bi, ai[m], 0, 0, 0);
        }
      }
      const int cl = ct * 16 + fr, ch = n * 64 + cl;
      const float bra = p.b_ra[(l * 2 + d) * 512 + ch], bia = p.b_ia[(l * 2 + d) * 512 + ch];
      const float spl = softplusf_(-p.lam_a[(l * 2 + d) * 512 + ch]);
#pragma unroll
      for (int m = 0; m < 4; ++m)
#pragma unroll
        for (int j = 0; j < 4; ++j) {
          const int tk = m * 16 + fq * 4 + j;
          const float gr = sigmoidf_(ar[m][j] + bra), gi = sigmoidf_(ai[m][j] + bia);
          const float la = -8.f * gr * spl;
          const float a = expf(la), b = sqrtf(-expm1f(2.f * la)) * gi * uS[tk * 65 + cl];
          aS[(d * 64 + tk) * 64 + cl] = a; bS[(d * 64 + tk) * 64 + cl] = b;
          LA[((size_t)d * TA + r0 + tk) * 512 + ch] = a; LB[((size_t)d * TA + r0 + tk) * 512 + ch] = b;
        }
    }
    __syncthreads();
    if (tid < 128) {
      const int d = tid >> 6, cl = tid & 63;
      float A = 1.f, B = 0.f;
      for (int s = 0; s < 64; ++s) { const int tk = d ? 63 - s : s; const float a = aS[(d * 64 + tk) * 64 + cl], b = bS[(d * 64 + tk) * 64 + cl]; A *= a; B = a * B + b; }
      const int ps = d == 0 ? rs : (rs < 4 ? 3 - rs : 135 - rs);
      float* o = LSEG + (((size_t)d * NCH + ps) * 512 + n * 64 + cl) * 2;
      o[0] = A; o[1] = B;
    }
  }
}

__device__ void lru_carry(const Params& p, int blk  ) {
  const int d = blk, ch = threadIdx.x;
  const float* LSEG = (const float*)(p.ws + WS_LSEG) + (size_t)d * NCH * 512 * 2;
  float* LCAR = (float*)(p.ws + WS_LCAR) + (size_t)d * NCH * 512;
  float h = 0.f;
#pragma unroll 4
  for (int ps = 0; ps < NCH; ++ps) {
    const float2 ab = *(const float2*)(LSEG + ((size_t)ps * 512 + ch) * 2);
    LCAR[ps * 512 + ch] = h; h = ab.x * h + ab.y;
  }
}

__device__ void phase_lru_fin(const Params& p, int l) {
  const int ch = threadIdx.x;
  const float* LA = (const float*)(p.ws + WS_LA); const float* LB = (const float*)(p.ws + WS_LB);
  const float* LCAR = (const float*)(p.ws + WS_LCAR);
  const bf16_t* Z = (const bf16_t*)(p.ws + WS_Z); bf16_t* MIX = (bf16_t*)(p.ws + WS_MIX);
  for (int rs = blockIdx.x; rs < NCH; rs += gridDim.x) {
    if (l == NL - 1 && rs < 4) continue;
    const int r0 = rs * 64, ps1 = rs < 4 ? 3 - rs : 135 - rs;
    float hb[64];
    float h = LCAR[((size_t)1 * NCH + ps1) * 512 + ch];
#pragma unroll
    for (int s = 0; s < 64; ++s) { const int tk = 63 - s; const size_t o = ((size_t)1 * TA + r0 + tk) * 512 + ch; h = LA[o] * h + LB[o]; hb[tk] = h; }
    h = LCAR[((size_t)0 * NCH + rs) * 512 + ch];
#pragma unroll
    for (int tk = 0; tk < 64; ++tk) {
      const size_t o = ((size_t)0 * TA + r0 + tk) * 512 + ch; h = LA[o] * h + LB[o];
      const float ga = bf2f(Z[(size_t)(r0 + tk) * ZLD + ZC_GA + ch]);
      MIX[(size_t)(r0 + tk) * DM + ch] = f2bf((h + hb[tk]) * siluf_(ga));
    }
  }
}

constexpr int GD_QN = 0, GD_KN = 17408, GD_KT = 34816, GD_VT = 53248, GD_KK = 71680, GD_QK = 88320, GD_MS = 104960, GD_SC = 141824;
__device__ void phase_gdn_local(const Params& p, int l, unsigned char* smem) {
  const int tid = threadIdx.x, lane = tid & 63, wid = tid >> 6, fr = lane & 15, fq = lane >> 4;
  const bf16_t* Z = (const bf16_t*)(p.ws + WS_Z);
  bf16_t* qN = (bf16_t*)(smem + GD_QN); bf16_t* kN = (bf16_t*)(smem + GD_KN);
  bf16_t* kT = (bf16_t*)(smem + GD_KT); bf16_t* vT = (bf16_t*)(smem + GD_VT);
  float* KKs = (float*)(smem + GD_KK); float* QKs = (float*)(smem + GD_QK);
  float* Ms = (float*)(smem + GD_MS);
  float* SC = (float*)(smem + GD_SC);
  bf16_t* GW = (bf16_t*)(p.ws + WS_GW); bf16_t* GQH = (bf16_t*)(p.ws + WS_GQH); bf16_t* GKT = (bf16_t*)(p.ws + WS_GKT);
  bf16_t* GQK = (bf16_t*)(p.ws + WS_GQK); float* GU = (float*)(p.ws + WS_GU); float* GGL = (float*)(p.ws + WS_GGL);
  for (int it = blockIdx.x; it < NCH * 4; it += gridDim.x) {
    const int rc = it >> 2, h = it & 3, r0 = rc * 64;
    const int seg_lo = r0 < TC ? 0 : TC, seg_hi = r0 < TC ? TC : TA;
    __syncthreads();
#pragma unroll 1
    for (int i = 0; i < 6; ++i) {
      const int u = i * 512 + tid, tk = u / 48, part = (u % 48) >> 4, c8 = (u & 15) * 8;
      const int chq = part * 512 + h * 128 + c8;
      float acc[8];
#pragma unroll
      for (int e = 0; e < 8; ++e) acc[e] = 0.f;
#pragma unroll
      for (int kk = 0; kk < 4; ++kk) {
        const int rr = r0 + tk + kk - 2;
        if (rr >= seg_lo && rr < seg_hi) {
          const bf16x8_t xv = *(const bf16x8_t*)(Z + (size_t)rr * ZLD + ZC_QKVB + chq);
          const float* cw = p.conv_b_w + ((size_t)l * 4 + kk) * 1536 + chq;
#pragma unroll
          for (int e = 0; e < 8; ++e) acc[e] += cw[e] * bf2f((bf16_t)xv[e]);
        }
      }
      float ss = 0.f;
#pragma unroll
      for (int e = 0; e < 8; ++e) { acc[e] = siluf_(acc[e]); ss += acc[e] * acc[e]; }
      ss += __shfl_xor(ss, 1); ss += __shfl_xor(ss, 2); ss += __shfl_xor(ss, 4); ss += __shfl_xor(ss, 8);
      float scl = 1.f;
      if (part == 0) scl = rsqrtf(ss + 1e-6f) * 0.088388347648318440f;
      else if (part == 1) scl = rsqrtf(ss + 1e-6f);
#pragma unroll
      for (int e = 0; e < 8; ++e) {
        const bf16_t b = f2bf(acc[e] * scl);
        if (part == 0) qN[tk * 136 + c8 + e] = b;
        else if (part == 1) { kN[tk * 136 + c8 + e] = b; kT[(c8 + e) * 72 + tk] = b; }
        else vT[(c8 + e) * 72 + tk] = b;
      }
    }
    if (wid < 2) {
      const int d = wid, tk = d ? 63 - lane : lane;
      const bf16_t* zr = Z + (size_t)(r0 + tk) * ZLD;
      const float beta = sigmoidf_(bf2f(zr[ZC_BETA + d * 4 + h]));
      const float g = -expf(p.a_log_b[(l * 2 + d) * 4 + h]) * softplusf_(bf2f(zr[ZC_ALPHA + d * 4 + h]) + p.dt_bias_b[(l * 2 + d) * 4 + h]);
      float gc = g;
#pragma unroll
      for (int o = 1; o < 64; o <<= 1) { const float t = __shfl_up(gc, o); if (lane >= o) gc += t; }
      const float gl = __shfl(gc, 63);
      float* s = SC + d * 256;
      s[lane] = beta; s[64 + lane] = gc; s[128 + lane] = expf(gc); s[192 + lane] = expf(gl - gc);
      if (lane == 0) { const int pc = d == 0 ? rc : (rc < 4 ? 3 - rc : 135 - rc); GGL[(size_t)(d * 4 + h) * NCH + pc] = expf(gl); }
    }
    __syncthreads();
    {
      const int which = wid >> 2, mt = wid & 3;
      const bf16_t* Asrc = which ? qN : kN;
      f32x4_t acc[4];
#pragma unroll
      for (int ct = 0; ct < 4; ++ct) acc[ct] = (f32x4_t){0.f, 0.f, 0.f, 0.f};
#pragma unroll
      for (int ks = 0; ks < 4; ++ks) {
        const bf16x8_t a = *(const bf16x8_t*)(Asrc + (mt * 16 + fr) * 136 + ks * 32 + fq * 8);
#pragma unroll
        for (int ct = 0; ct < 4; ++ct) {
          const bf16x8_t b = *(const bf16x8_t*)(kN + (ct * 16 + fr) * 136 + ks * 32 + fq * 8);
          acc[ct] = __builtin_amdgcn_mfma_f32_16x16x32_bf16(a, b, acc[ct], 0, 0, 0);
        }
      }
      float* dst = which ? QKs : KKs;
#pragma unroll
      for (int ct = 0; ct < 4; ++ct)
#pragma unroll
        for (int j = 0; j < 4; ++j) dst[(mt * 16 + fq * 4 + j) * 65 + ct * 16 + fr] = acc[ct][j];
    }
    __syncthreads();
#pragma unroll 1
    for (int i = 0; i < 16; ++i) {
      const int e = i * 512 + tid, d = e >> 12, pi = (e >> 6) & 63, pj = e & 63;
      const int ti = d ? 63 - pi : pi, tj = d ? 63 - pj : pj;
      const float* s = SC + d * 256;
      const float dec = pi >= pj ? expf(s[64 + pi] - s[64 + pj]) : 0.f;
      Ms[(d * 64 + pi) * 72 + pj] = pi > pj ? s[pi] * KKs[ti * 65 + tj] * dec : 0.f;
      const int pc = d == 0 ? rc : (rc < 4 ? 3 - rc : 135 - rc);
      GQK[((size_t)(d * 4 + h) * NCH + pc) * 4096 + pi * 64 + pj] = f2bf(QKs[ti * 65 + tj] * dec);
    }
    __syncthreads();
    if (wid < 2) {
      const int d = wid, c = lane;
      const float* Md = Ms + d * 64 * 72;
      float T[64];
#pragma unroll
      for (int i = 0; i < 64; ++i) T[i] = 0.f;
#pragma unroll
      for (int i = 0; i < 64; ++i) {
        float a0 = (i == c) ? 1.f : 0.f, a1 = 0.f;
#pragma unroll
        for (int jb = 0; jb < i; jb += 4) {
          const float4 m = *(const float4*)(Md + i * 72 + jb);
          a0 -= m.x * T[jb]; a1 -= m.y * T[jb + 1]; a0 -= m.z * T[jb + 2]; a1 -= m.w * T[jb + 3];
        }
        T[i] = a0 + a1;
      }
      const float* s = SC + d * 256;
      const float bc = s[c], bce = s[c] * s[128 + c];
      const int tc = d ? 63 - c : c;
      bf16_t* Tu = (bf16_t*)(Ms + d * 64 * 72); bf16_t* Tw = Tu + 64 * 72;
      asm volatile("s_waitcnt lgkmcnt(0)" ::: "memory");
#pragma unroll
      for (int i = 0; i < 64; ++i) { Tu[i * 72 + tc] = f2bf(T[i] * bc); Tw[i * 72 + tc] = f2bf(T[i] * bce); }
    }
    __syncthreads();
    {
      const int d = wid >> 2, which = (wid >> 1) & 1, half = wid & 1;
      const int pc = d == 0 ? rc : (rc < 4 ? 3 - rc : 135 - rc);
      const size_t cbase = (size_t)(d * 4 + h) * NCH + pc;
      const bf16_t* Tm = (const bf16_t*)(Ms + d * 64 * 72) + which * 64 * 72;
      const bf16_t* Bs = which ? kT : vT;
#pragma unroll 1
      for (int cti = 0; cti < 4; ++cti) {
        const int ct = half * 4 + cti;
        f32x4_t acc[4];
#pragma unroll
        for (int m = 0; m < 4; ++m) acc[m] = (f32x4_t){0.f, 0.f, 0.f, 0.f};
#pragma unroll
        for (int ks = 0; ks < 2; ++ks) {
          const bf16x8_t b = *(const bf16x8_t*)(Bs + (ct * 16 + fr) * 72 + ks * 32 + fq * 8);
#pragma unroll
          for (int m = 0; m < 4; ++m) {
            const bf16x8_t a = *(const bf16x8_t*)(Tm + (m * 16 + fr) * 72 + ks * 32 + fq * 8);
            acc[m] = __builtin_amdgcn_mfma_f32_16x16x32_bf16(a, b, acc[m], 0, 0, 0);
          }
        }
#pragma unroll
        for (int m = 0; m < 4; ++m)
#pragma unroll
          for (int j = 0; j < 4; ++j) {
            const int pi = m * 16 + fq * 4 + j, chn = ct * 16 + fr;
            if (which) GW[cbase * 8192 + pi * 128 + chn] = f2bf(acc[m][j]);
            else GU[cbase * 8192 + pi * 128 + chn] = acc[m][j];
          }
      }
    }
    {
#pragma unroll 1
      for (int i = 0; i < 4; ++i) {
        const int e = i * 512 + tid, d = e >> 10, pi = (e >> 4) & 63, c8 = (e & 15) * 8;
        const int ti = d ? 63 - pi : pi; const float sc = SC[d * 256 + 128 + pi];
        const int pc = d == 0 ? rc : (rc < 4 ? 3 - rc : 135 - rc);
        const bf16x8_t qv = *(const bf16x8_t*)(qN + ti * 136 + c8);
        float f[8];
#pragma unroll
        for (int k = 0; k < 8; ++k) f[k] = bf2f((bf16_t)qv[k]) * sc;
        u32x4_t w = {cvtpk2(f[0], f[1]), cvtpk2(f[2], f[3]), cvtpk2(f[4], f[5]), cvtpk2(f[6], f[7])};
        *(u32x4_t*)(GQH + ((size_t)(d * 4 + h) * NCH + pc) * 8192 + pi * 128 + c8) = w;
      }
#pragma unroll 1
      for (int i = 0; i < 4; ++i) {
        const int e = i * 512 + tid, d = e >> 10, chn = (e >> 3) & 127, p8 = (e & 7) * 8;
        const int pc = d == 0 ? rc : (rc < 4 ? 3 - rc : 135 - rc);
        float f[8];
#pragma unroll
        for (int k = 0; k < 8; ++k) { const int pi = p8 + k, ti = d ? 63 - pi : pi; f[k] = bf2f(kT[chn * 72 + ti]) * SC[d * 256 + 192 + pi]; }
        u32x4_t w = {cvtpk2(f[0], f[1]), cvtpk2(f[2], f[3]), cvtpk2(f[4], f[5]), cvtpk2(f[6], f[7])};
        *(u32x4_t*)(GKT + ((size_t)(d * 4 + h) * NCH + pc) * 8192 + chn * 64 + p8) = w;
      }
    }
  }
}

constexpr int GS_W = 0, GS_QH = 17408, GS_QK = 34816, GS_KT = 44032, GS_BUF = 62464;
template <int NWS>
__device__ void gdn_scan(const Params& p, unsigned char* smem, int sq, int sg) {
  const int tid = threadIdx.x, lane = tid & 63, wid = tid >> 6, fr = lane & 15, fq = lane >> 4;
  const int d = sq >> 2, h = sq & 3;
  const u32x4_t* GW = (const u32x4_t*)(p.ws + WS_GW) + (size_t)sq * NCH * 1024;
  const u32x4_t* GQH = (const u32x4_t*)(p.ws + WS_GQH) + (size_t)sq * NCH * 1024;
  const u32x4_t* GKT = (const u32x4_t*)(p.ws + WS_GKT) + (size_t)sq * NCH * 1024;
  const u32x4_t* GQK = (const u32x4_t*)(p.ws + WS_GQK) + (size_t)sq * NCH * 512;
  const float* GU = (const float*)(p.ws + WS_GU) + (size_t)sq * NCH * 8192;
  const float* GGL = (const float*)(p.ws + WS_GGL) + (size_t)sq * NCH;
  float* GO = (float*)(p.ws + WS_GO) + (size_t)d * TA * 512;
  const int n0 = (sg * NWS + wid) * 16;
  u32x4_t R[7];
  const int o01 = GS_W + (tid >> 4) * 272 + (tid & 15) * 16;
  const int o4 = GS_QK + (tid >> 3) * 144 + (tid & 7) * 16;
  const int o56 = GS_KT + (tid >> 3) * 144 + (tid & 7) * 16;
#define GS_LOAD(pc) do { R[0] = GW[(size_t)(pc) * 1024 + tid]; R[1] = GW[(size_t)(pc) * 1024 + 512 + tid]; R[2] = GQH[(size_t)(pc) * 1024 + tid]; \
    R[3] = GQH[(size_t)(pc) * 1024 + 512 + tid]; R[4] = GQK[(size_t)(pc) * 512 + tid]; R[5] = GKT[(size_t)(pc) * 1024 + tid]; R[6] = GKT[(size_t)(pc) * 1024 + 512 + tid]; } while (0)
#define GS_WRITE(b) do { unsigned char* B_ = smem + (b) * GS_BUF; *(u32x4_t*)(B_ + o01) = R[0]; *(u32x4_t*)(B_ + o01 + 32 * 272) = R[1]; \
    *(u32x4_t*)(B_ + o01 + (GS_QH - GS_W)) = R[2]; *(u32x4_t*)(B_ + o01 + (GS_QH - GS_W) + 32 * 272) = R[3]; *(u32x4_t*)(B_ + o4) = R[4]; \
    *(u32x4_t*)(B_ + o56) = R[5]; *(u32x4_t*)(B_ + o56 + 64 * 144) = R[6]; } while (0)
  f32x4_t S[8];
#pragma unroll
  for (int t = 0; t < 8; ++t) S[t] = (f32x4_t){0.f, 0.f, 0.f, 0.f};
  __syncthreads();
  GS_LOAD(0); GS_WRITE(0);
  __syncthreads();
#pragma unroll 1
  for (int pc = 0; pc < NCH; ++pc) {
    if (pc + 1 < NCH) GS_LOAD(pc + 1);
    if (wid < NWS) {
      const unsigned char* B_ = smem + (pc & 1) * GS_BUF;
      const float gam = GGL[pc];
      f32x4_t U[4];
#pragma unroll
      for (int m = 0; m < 4; ++m)
#pragma unroll
        for (int j = 0; j < 4; ++j) U[m][j] = GU[(size_t)pc * 8192 + (m * 16 + fq * 4 + j) * 128 + n0 + fr];
      bf16x8_t Sb[4];
#pragma unroll
      for (int ks = 0; ks < 4; ++ks) Sb[ks] = pack8(S[2 * ks], S[2 * ks + 1]);
      f32x4_t P[4], O[4];
#pragma unroll
      for (int m = 0; m < 4; ++m) { P[m] = (f32x4_t){0.f, 0.f, 0.f, 0.f}; O[m] = (f32x4_t){0.f, 0.f, 0.f, 0.f}; }
#define GS_AFRAG(base, stride, row, ks) ({ const unsigned char* a_ = B_ + (base) + (row) * (stride) + (ks) * 64 + fq * 8; \
      u32x2_t lo_ = *(const u32x2_t*)a_; u32x2_t hi_ = *(const u32x2_t*)(a_ + 32); u32x4_t w_ = {lo_.x, lo_.y, hi_.x, hi_.y}; *reinterpret_cast<bf16x8_t*>(&w_); })
#pragma unroll
      for (int ks = 0; ks < 4; ++ks)
#pragma unroll
        for (int m = 0; m < 4; ++m) {
          const bf16x8_t aw = GS_AFRAG(GS_W, 272, m * 16 + fr, ks);
          const bf16x8_t aq = GS_AFRAG(GS_QH, 272, m * 16 + fr, ks);
          P[m] = __builtin_amdgcn_mfma_f32_16x16x32_bf16(aw, Sb[ks], P[m], 0, 0, 0);
          O[m] = __builtin_amdgcn_mfma_f32_16x16x32_bf16(aq, Sb[ks], O[m], 0, 0, 0);
        }
      f32x4_t Vn[4];
#pragma unroll
      for (int m = 0; m < 4; ++m) Vn[m] = U[m] - P[m];
      bf16x8_t Vb[2];
      Vb[0] = pack8(Vn[0], Vn[1]); Vb[1] = pack8(Vn[2], Vn[3]);
#pragma unroll
      for (int ks = 0; ks < 2; ++ks)
#pragma unroll
        for (int m = 0; m < 4; ++m) {
          const bf16x8_t a = GS_AFRAG(GS_QK, 144, m * 16 + fr, ks);
          O[m] = __builtin_amdgcn_mfma_f32_16x16x32_bf16(a, Vb[ks], O[m], 0, 0, 0);
        }
#pragma unroll
      for (int t = 0; t < 8; ++t) {
        S[t] = S[t] * gam;
#pragma unroll
        for (int ks = 0; ks < 2; ++ks) {
          const bf16x8_t a = GS_AFRAG(GS_KT, 144, t * 16 + fr, ks);
          S[t] = __builtin_amdgcn_mfma_f32_16x16x32_bf16(a, Vb[ks], S[t], 0, 0, 0);
        }
      }
      const int rcn = d == 0 ? pc : (pc < 4 ? 3 - pc : 135 - pc);
#pragma unroll
      for (int m = 0; m < 4; ++m)
#pragma unroll
        for (int j = 0; j < 4; ++j) {
          const int pi = m * 16 + fq * 4 + j, tk = d ? 63 - pi : pi;
          GO[(size_t)(rcn * 64 + tk) * 512 + h * 128 + n0 + fr] = O[m][j];
        }
    }
    if (pc + 1 < NCH) GS_WRITE((pc + 1) & 1);
    __syncthreads();
  }
#undef GS_LOAD
#undef GS_WRITE
#undef GS_AFRAG
}

__device__ void phase_gdn_fin(const Params& p, int l) {
  const int tid = threadIdx.x, lane = tid & 63, wid = tid >> 6;
  const float* GO = (const float*)(p.ws + WS_GO);
  const bf16_t* Z = (const bf16_t*)(p.ws + WS_Z); bf16_t* MIX = (bf16_t*)(p.ws + WS_MIX);
  const int c0 = lane * 8;
  float on[8];
#pragma unroll
  for (int e = 0; e < 8; ++e) on[e] = p.onorm_b[l * 128 + (c0 & 127) + e];
  for (int r = blockIdx.x * 8 + wid; r < TA; r += gridDim.x * 8) {
    if (l == NL - 1 && r < TC) continue;
    const float4 a0 = *(const float4*)(GO + (size_t)r * 512 + c0), a1 = *(const float4*)(GO + (size_t)r * 512 + c0 + 4);
    const float4 b0 = *(const float4*)(GO + ((size_t)TA + r) * 512 + c0), b1 = *(const float4*)(GO + ((size_t)TA + r) * 512 + c0 + 4);
    float v[8] = {a0.x + b0.x, a0.y + b0.y, a0.z + b0.z, a0.w + b0.w, a1.x + b1.x, a1.y + b1.y, a1.z + b1.z, a1.w + b1.w};
    float ss = 0.f;
#pragma unroll
    for (int e = 0; e < 8; ++e) ss += v[e] * v[e];
    ss += __shfl_xor(ss, 1); ss += __shfl_xor(ss, 2); ss += __shfl_xor(ss, 4); ss += __shfl_xor(ss, 8);
    const float rstd = rsqrtf(ss * (1.f / 128.f) + 1e-6f);
    const bf16x8_t gv = *(const bf16x8_t*)(Z + (size_t)r * ZLD + ZC_GB + c0);
    float f[8];
#pragma unroll
    for (int e = 0; e < 8; ++e) f[e] = v[e] * rstd * on[e] * siluf_(bf2f((bf16_t)gv[e]));
    u32x4_t w = {cvtpk2(f[0], f[1]), cvtpk2(f[2], f[3]), cvtpk2(f[4], f[5]), cvtpk2(f[6], f[7])};
    *(u32x4_t*)(MIX + (size_t)r * DM + 512 + c0) = w;
  }
}

__device__ void phase_attn(const Params& p, int l, unsigned char* smem) {
  const bf16_t* Z = (const bf16_t*)(p.ws + WS_Z);
  const bf16_t* QB = (const bf16_t*)(p.ws + WS_QB); const bf16_t* KB = (const bf16_t*)(p.ws + WS_KB); const bf16_t* VB = (const bf16_t*)(p.ws + WS_VB);
  bf16_t* MIX = (bf16_t*)(p.ws + WS_MIX);
  const int nitems = (l == NL - 1) ? 256 : 264;
  for (int it = blockIdx.x; it < nitems; it += gridDim.x) {
    int head, r0, seq;
    if (it < 256) { head = it >> 5; r0 = TC + (it & 31) * 256; seq = TA; }
    else { head = it - 256; r0 = 0; seq = TC; }
    const int kvh = head >> 2;
    __syncthreads();
    att::attn_dense_body(QB + (size_t)r0 * 1024 + head * 128, KB + kvh * 128, VB + kvh * 128,
                         Z + (size_t)r0 * ZLD + ZC_GC + head * 128, MIX + (size_t)r0 * DM + 1024 + head * 128, seq, (char*)smem);
  }
}

__device__ void phase_attn_gate(const Params& p, int l) {
  const int tid = threadIdx.x, lane = tid & 63, wid = tid >> 6;
  const bf16_t* Z = (const bf16_t*)(p.ws + WS_Z); bf16_t* MIX = (bf16_t*)(p.ws + WS_MIX);
  for (int r = blockIdx.x * 8 + wid; r < TA; r += gridDim.x * 8) {
    if (l == NL - 1 && r < TC) continue;
#pragma unroll
    for (int hlf = 0; hlf < 2; ++hlf) {
      const int c0 = hlf * 512 + lane * 8;
      const bf16x8_t ov = *(const bf16x8_t*)(MIX + (size_t)r * DM + 1024 + c0);
      const bf16x8_t gv = *(const bf16x8_t*)(Z + (size_t)r * ZLD + ZC_GC + c0);
      float f[8];
#pragma unroll
      for (int e = 0; e < 8; ++e) f[e] = bf2f((bf16_t)ov[e]) * siluf_(bf2f((bf16_t)gv[e]));
      u32x4_t w = {cvtpk2(f[0], f[1]), cvtpk2(f[2], f[3]), cvtpk2(f[4], f[5]), cvtpk2(f[6], f[7])};
      *(u32x4_t*)(MIX + (size_t)r * DM + 1024 + c0) = w;
    }
  }
}

template <int S>
__device__ __forceinline__ void run_phase(const Params& p, int l, unsigned char* smem) {
  const int bid = blockIdx.x;
  if constexpr (S == 0) phase_prep0(p, smem);
  else if constexpr (S == 1) phase_norm(p, l);
  else if constexpr (S == 2) {
    pg8::Gemm g; g.A = (const bf16_t*)(p.ws + WS_XN); g.Bt = (const bf16_t*)(p.ws + WS_WIN) + (size_t)l * ZLD * DM; g.M = TA; g.N = ZLD; g.K = DM;
    pg8::StaticOrder So; So.init(g.M, g.N, (int)gridDim.x, bid);
    pg8::EpiZ E; E.O = (bf16_t*)(p.ws + WS_Z); E.ldc = ZLD;
    pg8::gemm_phase<pg8::EpiZ, pg8::StaticOrder, false>((PG8_LAS unsigned char*)smem, g, So, E, nullptr);
  } else if constexpr (S == 3) { phase_qkprep(p, l); phase_lru_ab(p, l, smem); phase_gdn_local(p, l, smem); }
  else if constexpr (S == 4) { if (bid < 8) gdn_scan<8>(p, smem, bid, 0); else if (bid < 10) lru_carry(p, bid - 8); }
  else if constexpr (S == 5) phase_attn(p, l, smem);
  else if constexpr (S == 6) { phase_lru_fin(p, l); phase_gdn_fin(p, l); phase_attn_gate(p, l); }
  else if constexpr (S == 7) {
    const bool last = (l == NL - 1);
    const float* mod = (const float*)(p.ws + WS_MOD) + (size_t)l * 2 * 6144;
    pg8::Gemm g; g.A = (const bf16_t*)(p.ws + WS_MIX) + (last ? (size_t)TC * DM : 0); g.Bt = (const bf16_t*)(p.ws + WS_WOUT) + (size_t)l * DM * DM;
    g.M = last ? TL : TA; g.N = DM; g.K = DM;
    pg8::StaticOrder So; So.init(g.M, g.N, (int)gridDim.x, bid);
    pg8::EpiRes E; E.H = (float*)(p.ws + WS_H); E.gate_lat = mod + 4096; E.gate_ctx = mod + 6144 + 4096; E.row_off = last ? TC : 0;
    pg8::gemm_phase<pg8::EpiRes, pg8::StaticOrder, false>((PG8_LAS unsigned char*)smem, g, So, E, nullptr);
  } else phase_final(p);
}

#ifdef MK_MULTI
template <int S>
__global__ __launch_bounds__(512, 2) void k_phase(Params p, int l) {
  extern __shared__ __attribute__((aligned(16))) unsigned char smem[];
  run_phase<S>(p, l, smem);
}
#else
__global__ __launch_bounds__(512, 2) void hybrid_fwd(Params p) {
  extern __shared__ __attribute__((aligned(16))) unsigned char smem[];
  cg::grid_group grid = cg::this_grid();
  run_phase<0>(p, 0, smem); grid.sync();
#pragma unroll 1
  for (int l = 0; l < NL; ++l) {
    run_phase<1>(p, l, smem); grid.sync();
    run_phase<2>(p, l, smem); grid.sync();
    run_phase<3>(p, l, smem); grid.sync();
    run_phase<4>(p, l, smem); grid.sync();
    run_phase<5>(p, l, smem); grid.sync();
    run_phase<6>(p, l, smem); grid.sync();
    run_phase<7>(p, l, smem); grid.sync();
  }
  run_phase<8>(p, 0, smem);
}
#endif

template <class K> static bool set_lds(K k) { return hipFuncSetAttribute((const void*)k, hipFuncAttributeMaxDynamicSharedMemorySize, LDS_BYTES) == hipSuccess; }

extern "C" void kernel_launch(void* const* d_in, const int* in_sizes, int n_in, void* d_out, int out_size, void* d_ws, size_t ws_size, hipStream_t stream) {
  static int grid = 0;
  if (grid == 0) {
    if (n_in != 23 || out_size != TL * DM || ws_size < WS_END) { fprintf(stderr, "kernel_launch: unexpected shapes (n_in %d out %d ws %zu need %zu)\n", n_in, out_size, ws_size, (size_t)WS_END); grid = -1; return; }
    int dev = 0, cus = 0;
    (void)hipGetDevice(&dev); (void)hipDeviceGetAttribute(&cus, hipDeviceAttributeMultiprocessorCount, dev);
    bool ok = true;
#ifdef MK_MULTI
    ok = ok && set_lds(k_phase<0>) && set_lds(k_phase<1>) && set_lds(k_phase<2>) && set_lds(k_phase<3>) && set_lds(k_phase<4>) && set_lds(k_phase<5>) && set_lds(k_phase<6>) && set_lds(k_phase<7>) && set_lds(k_phase<8>);
#else
    ok = ok && set_lds(hybrid_fwd);
    int per_cu = 0; (void)hipOccupancyMaxActiveBlocksPerMultiprocessor(&per_cu, (const void*)hybrid_fwd, 512, LDS_BYTES); (void)hipGetLastError();
    if (per_cu < 1) fprintf(stderr, "kernel_launch: occupancy query says %d blocks per CU\n", per_cu);
#endif
    if (!ok) { fprintf(stderr, "kernel_launch: hipFuncSetAttribute failed\n"); grid = -1; return; }
    grid = cus > 0 ? cus : 256;
  }
  if (grid < 0) return;
  Params p{};
  const float** pp = (const float**)&p;
  for (int i = 0; i < 23; ++i) pp[i] = (const float*)d_in[i];
  p.out = (float*)d_out; p.ws = (unsigned char*)d_ws;
#ifdef MK_MULTI
#define LAUNCH(S, l) hipLaunchKernelGGL(k_phase<S>, dim3(grid), dim3(512), LDS_BYTES, stream, p, l)
  LAUNCH(0, 0);
  for (int l = 0; l < NL; ++l) { LAUNCH(1, l); LAUNCH(2, l); LAUNCH(3, l); LAUNCH(4, l); LAUNCH(5, l); LAUNCH(6, l); LAUNCH(7, l); }
  LAUNCH(8, 0);
#else
  void* args[] = {&p};
  hipError_t e = hipLaunchCooperativeKernel((const void*)hybrid_fwd, dim3(grid), dim3(512), args, LDS_BYTES, stream);
  if (e != hipSuccess) fprintf(stderr, "cooperative launch failed: %s (grid %d)\n", hipGetErrorString(e), grid);
#endif
}
```

```cpp
#include <hip/hip_runtime.h>
#include <hip/hip_cooperative_groups.h>
#include <cstdio>
namespace cg = cooperative_groups;

typedef unsigned short bf16_t;
typedef short bf16x8_t __attribute__((ext_vector_type(8)));
typedef float f32x4_t __attribute__((ext_vector_type(4)));
typedef unsigned u32x4_t __attribute__((ext_vector_type(4)));
typedef unsigned u32x2_t __attribute__((ext_vector_type(2)));

constexpr int DM = 2048, TL = 8192, TC = 256, TA = 8448, NL = 4;
constexpr int DIN = 5648, ZLD = 5888, NCH = 132;
constexpr int ZC_XA = 0, ZC_GA = 512, ZC_QKVB = 1024, ZC_GB = 2560, ZC_QC = 3072, ZC_KC = 4096, ZC_VC = 4352, ZC_GC = 4608, ZC_BETA = 5632, ZC_ALPHA = 5640;
constexpr int LDS_BYTES = 147456;

constexpr size_t al256(size_t x) { return (x + 255) / 256 * 256; }
constexpr size_t WS_H    = 0;
constexpr size_t WS_XN   = WS_H    + al256((size_t)TA * DM * 4);
constexpr size_t WS_Z    = WS_XN   + al256((size_t)TA * DM * 2);
constexpr size_t WS_MIX  = WS_Z    + al256((size_t)TA * ZLD * 2);
constexpr size_t WS_QB   = WS_MIX  + al256((size_t)TA * DM * 2);
constexpr size_t WS_KB   = WS_QB   + al256((size_t)TA * 1024 * 2);
constexpr size_t WS_VB   = WS_KB   + al256((size_t)TA * 256 * 2);
constexpr size_t WS_WIN  = WS_VB   + al256((size_t)TA * 256 * 2);
constexpr size_t WS_WOUT = WS_WIN  + al256((size_t)NL * ZLD * DM * 2);
constexpr size_t WS_MOD  = WS_WOUT + al256((size_t)NL * DM * DM * 2);
constexpr size_t WS_WG   = WS_MOD  + al256((size_t)NL * 2 * 6144 * 4);
constexpr size_t WS_LA   = WS_WG   + al256((size_t)NL * 2 * 2 * 8 * 4096 * 2);
constexpr size_t WS_LB   = WS_LA   + al256((size_t)2 * TA * 512 * 4);
constexpr size_t WS_LSEG = WS_LB   + al256((size_t)2 * TA * 512 * 4);
constexpr size_t WS_LCAR = WS_LSEG + al256((size_t)2 * NCH * 512 * 2 * 4);
constexpr size_t GREC_BYTES = 57344;
constexpr size_t WS_GREC = WS_LCAR + al256((size_t)2 * NCH * 512 * 4);
constexpr size_t WS_GU   = WS_GREC + al256((size_t)8 * NCH * GREC_BYTES);
constexpr size_t WS_GGL  = WS_GU   + al256((size_t)8 * NCH * 8192 * 4);
constexpr size_t WS_GO   = WS_GGL  + al256((size_t)8 * NCH * 4);
constexpr int NSPLIT = 6, SPLIT_KEYS = TA / NSPLIT;
constexpr size_t WS_PO   = WS_GO   + al256((size_t)2 * TA * 512 * 4);
constexpr size_t WS_ML   = WS_PO   + al256((size_t)NSPLIT * TA * 1024 * 2);
constexpr size_t WS_CTR  = WS_ML   + al256((size_t)NSPLIT * TA * 16 * 4);
constexpr size_t WS_BAR  = WS_CTR  + 256;
constexpr size_t WS_END  = WS_BAR  + 16384;

struct Params {
  const float *x, *c, *ctx, *c_ctx, *norm_g, *w_mod, *b_mod, *w_in, *conv_a_w, *conv_a_b, *w_ra, *b_ra, *w_ia, *b_ia, *lam_a,
              *conv_b_w, *a_log_b, *dt_bias_b, *onorm_b, *qn_c, *kn_c, *w_out, *final_g;
  float* out; unsigned char* ws;
};

__device__ __forceinline__ unsigned cvtpk2(float lo, float hi) { unsigned r; asm volatile("v_cvt_pk_bf16_f32 %0, %1, %2" : "=v"(r) : "v"(lo), "v"(hi)); return r; }
__device__ __forceinline__ bf16_t f2bf(float x) { return (bf16_t)(cvtpk2(x, 0.f) & 0xffffu); }
__device__ __forceinline__ float bf2f(bf16_t b) { return __uint_as_float(((unsigned)b) << 16); }
__device__ __forceinline__ float fexp_(float x) { return __builtin_amdgcn_exp2f(x * 1.4426950408889634f); }
__device__ __forceinline__ float sigmoidf_(float x) { return __builtin_amdgcn_rcpf(1.f + fexp_(-x)); }
__device__ __forceinline__ float siluf_(float x) { return x * __builtin_amdgcn_rcpf(1.f + fexp_(-x)); }
__device__ __forceinline__ float softplusf_(float x) { return fmaxf(x, 0.f) + log1pf(expf(-fabsf(x))); }
__device__ __forceinline__ float wave_sum(float v) {
#pragma unroll
  for (int o = 32; o >= 1; o >>= 1) v += __shfl_xor(v, o);
  return v;
}
__device__ __forceinline__ bf16x8_t pack8(f32x4_t a, f32x4_t b) {
  u32x4_t w = {cvtpk2(a[0], a[1]), cvtpk2(a[2], a[3]), cvtpk2(b[0], b[1]), cvtpk2(b[2], b[3])};
  return *reinterpret_cast<bf16x8_t*>(&w);
}

__device__ __forceinline__ int tidx() { int t = (int)__builtin_amdgcn_workitem_id_x(); asm volatile("" : "+v"(t)); return t; }
__device__ __forceinline__ int bidx() { int b = (int)__builtin_amdgcn_workgroup_id_x(); asm volatile("" : "+s"(b)); return b; }
namespace pg8 {
#define PG8_LAS __attribute__((address_space(3)))
typedef unsigned short bf16_t;
typedef short bf16x8 __attribute__((ext_vector_type(8)));
typedef float f32x4 __attribute__((ext_vector_type(4)));
typedef unsigned u32x4 __attribute__((ext_vector_type(4)));
constexpr int BM = 256, BK = 64, HALF = 128, HTB = HALF * BK * 2  , STAGE_BYTES = 8 * HTB, NXCD = 8, WGM = 8;

__host__ __device__ __forceinline__ int lds_byte(int r, int c) { const int st = (r >> 4) * 2 + (c >> 5), rr = r & 15, cc = c & 31, ob = rr * 64 + cc * 2; return st * 1024 + (ob ^ (((ob >> 9) & 1) << 5)); }
__host__ __device__ __forceinline__ void stage_rc(int b, int& R, int& C) { const int st = b / 1024, sb = b % 1024, swz = sb ^ (((sb >> 9) & 1) << 5); R = (st >> 1) * 16 + swz / 64; C = (st & 1) * 32 + (swz % 64) / 2; }
__host__ __device__ __forceinline__ int perm32(int rho) { const int n = rho >> 4, i = rho & 15; return 8 * (i >> 2) + 4 * n + (i & 3); }

struct Unit { int pm, pn; };
struct Gemm { const bf16_t* A; const bf16_t* Bt; int M, N, K, ld; };

struct StaticOrder {
    int nM, nN, nwg, G, c;
    __host__ __device__ void init(int M, int N, int G_, int c_) { nM = M / BM; nN = N / BM; nwg = nM * nN; G = G_; c = c_; }
    __host__ __device__ bool next(int i, Unit& u) const {
        const long L = (long)i * G + c; if (L >= nwg) return false;
        int wgid = (int)L; { const int q = nwg / NXCD, r = nwg % NXCD, xcd = wgid % NXCD, off = wgid / NXCD; wgid = (xcd < r ? xcd * (q + 1) : r * (q + 1) + (xcd - r) * q) + off; }
        const int nig = WGM * nN, gid = wgid / nig, fm = gid * WGM, gsz = (nM - fm) < WGM ? (nM - fm) : WGM;
        u.pm = fm + ((wgid % nig) % gsz); u.pn = (wgid % nig) / gsz; return true;
    }
    __device__ __forceinline__ void a_ready(const Unit&) const {}
    __device__ __forceinline__ void done(const Unit&) const {}
};
__device__ __forceinline__ unsigned cvt_pk_bf16(float lo, float hi) { unsigned r; asm volatile("v_cvt_pk_bf16_f32 %0, %1, %2" : "=v"(r) : "v"(lo), "v"(hi)); return r; }
template <class Epi, class Sched, bool STAMP = false>
__device__ __forceinline__ void gemm_phase(PG8_LAS unsigned char* lds, const Gemm g, const Sched& S, const Epi& E, unsigned long long* stamps) {
    const int tid = tidx(), wid = __builtin_amdgcn_readfirstlane(tid >> 6), lane = tid & 63, wr = wid >> 2, wc = wid & 3, fr = lane & 15, fq = lane >> 4;
    const int K = g.K, nt = K / BK;
    int ts_lo = 0, ts_hi = 0, nts = 0; const unsigned long long rt_entry = STAMP ? (unsigned long long)wall_clock64() : 0ull;
#define PG8_STAMP() do { if (STAMP && wid == 0 && nts < 64) { const unsigned long long _c = (unsigned long long)clock64(); \
        ts_lo = (lane == nts) ? (int)(unsigned)_c : ts_lo; ts_hi = (lane == nts) ? (int)(unsigned)(_c >> 32) : ts_hi; ++nts; } } while (0)
    PG8_STAMP();
    unsigned voffA[2], voffB[2];
#pragma unroll
    for (int i = 0; i < 2; ++i) { int R, C; stage_rc(tid * 16 + i * 8192, R, C); const int Rb = Epi::PERM ? ((R & ~31) + perm32(R & 31)) : R;
        voffA[i] = (unsigned)(R * g.ld + C) * 2u; voffB[i] = (unsigned)(Rb * g.ld + C) * 2u; }
    const size_t kstep = (size_t)(BK * 2);
    const size_t hstep = (size_t)HALF * g.ld * 2;
    const size_t tstep = 2 * hstep;
    const unsigned ldsw = (unsigned)wid * 1024u;
    const int aoff = lds_byte(wr * 64 + fr, fq * 8), boff = lds_byte(wc * 32 + fr, fq * 8);
#define PG8_SA(b, h) (((b) * 2 + (h)) * HTB)
#define PG8_SB(b, h) ((4 + (b) * 2 + (h)) * HTB)
#define PG8_STAGE(bufoff, gbase, voff) do { _Pragma("unroll") for (int _i = 0; _i < 2; ++_i) \
        __builtin_amdgcn_global_load_lds((const unsigned*)((const char*)(gbase) + (voff)[_i]), (PG8_LAS unsigned*)(lds + (bufoff) + ldsw + _i * 8192), 16, 0, 0); } while (0)
#define PG8_LDA(dst, b, h) do { _Pragma("unroll") for (int m = 0; m < 4; ++m) _Pragma("unroll") for (int k = 0; k < 2; ++k) dst[m][k] = *(const PG8_LAS bf16x8*)(lds + PG8_SA(b, h) + aoff + m * 2048 + k * 1024); } while (0)
#define PG8_LDB(dst, b, h) do { _Pragma("unroll") for (int n = 0; n < 2; ++n) _Pragma("unroll") for (int k = 0; k < 2; ++k) dst[n][k] = *(const PG8_LAS bf16x8*)(lds + PG8_SB(b, h) + boff + n * 2048 + k * 1024); } while (0)
#define PG8_MMA(ai, bj, At, Bt) do { __builtin_amdgcn_s_setprio(1); _Pragma("unroll") for (int m = 0; m < 4; ++m) _Pragma("unroll") for (int n = 0; n < 2; ++n) _Pragma("unroll") for (int k = 0; k < 2; ++k) \
        acc[ai][bj][m][n] = __builtin_amdgcn_mfma_f32_16x16x32_bf16(Bt[n][k], At[m][k], acc[ai][bj][m][n], 0, 0, 0); __builtin_amdgcn_s_setprio(0); } while (0)
#define PG8_WAIT_V(n) asm volatile("s_waitcnt vmcnt(" #n ")" ::: "memory")
#define PG8_WAIT_L(n) asm volatile("s_waitcnt lgkmcnt(" #n ")" ::: "memory")
#define PG8_BAR __builtin_amdgcn_s_barrier()
#define PG8_SCHED __builtin_amdgcn_sched_barrier(0)
    Unit cur, nxt; int ui = 0;
    if (!S.next(0, cur)) return;
    f32x4 acc[2][2][4][2];
#pragma unroll
    for (int a = 0; a < 2; ++a)
#pragma unroll
        for (int b = 0; b < 2; ++b)
#pragma unroll
            for (int m = 0; m < 4; ++m)
#pragma unroll
                for (int n = 0; n < 2; ++n) acc[a][b][m][n] = (f32x4){0.f, 0.f, 0.f, 0.f};
    bf16x8 At[4][2], B0[2][2], B1[2][2];
    const char* cA = (const char*)g.A + (size_t)cur.pm * tstep; const char* cB = (const char*)g.Bt + (size_t)cur.pn * tstep;
    S.a_ready(cur);
    PG8_STAGE(PG8_SB(0, 0), cB, voffB); PG8_STAGE(PG8_SA(0, 0), cA, voffA); PG8_STAGE(PG8_SB(0, 1), cB + hstep, voffB); PG8_STAGE(PG8_SA(0, 1), cA + hstep, voffA);
    if (wr == 1) PG8_BAR;
    PG8_WAIT_V(4); PG8_BAR;
    PG8_STAGE(PG8_SB(1, 0), cB + kstep, voffB); PG8_STAGE(PG8_SA(1, 0), cA + kstep, voffA); PG8_STAGE(PG8_SB(1, 1), cB + hstep + kstep, voffB);
    PG8_WAIT_V(6); PG8_BAR;
    PG8_STAMP();
    for (;;) {
        const bool has_next = S.next(ui + 1, nxt);
        const char* nA = has_next ? (const char*)g.A + (size_t)nxt.pm * tstep : cA; const char* nB = has_next ? (const char*)g.Bt + (size_t)nxt.pn * tstep : cB;
        for (int t = 0; t < nt; t += 2) {
            const bool last = (t == nt - 2);
            const char* a1 = cA + (size_t)(t + 1) * kstep;
            const char* a2 = last ? nA : cA + (size_t)(t + 2) * kstep; const char* b2 = last ? nB : cB + (size_t)(t + 2) * kstep;
            const char* a3 = a2 + kstep; const char* b3 = b2 + kstep;
            if (last && has_next) S.a_ready(nxt);
            PG8_LDB(B0, 0, 0); PG8_SCHED; PG8_LDA(At, 0, 0); PG8_STAGE(PG8_SA(1, 1), a1 + hstep, voffA);
            PG8_WAIT_L(8); PG8_BAR; PG8_WAIT_L(0); PG8_MMA(0, 0, At, B0); PG8_BAR; PG8_SCHED;
            PG8_LDB(B1, 0, 1); PG8_STAGE(PG8_SB(0, 0), b2, voffB);
            PG8_BAR; PG8_WAIT_L(0); PG8_MMA(0, 1, At, B1); PG8_BAR;
            PG8_LDA(At, 0, 1); PG8_STAGE(PG8_SA(0, 0), a2, voffA);
            PG8_BAR; PG8_WAIT_L(0); PG8_MMA(1, 0, At, B0); PG8_BAR; PG8_SCHED;
            PG8_STAGE(PG8_SB(0, 1), b2 + hstep, voffB);
            PG8_WAIT_V(6); PG8_BAR; PG8_MMA(1, 1, At, B1); PG8_BAR;
            PG8_LDB(B0, 1, 0); PG8_SCHED; PG8_LDA(At, 1, 0); PG8_STAGE(PG8_SA(0, 1), a2 + hstep, voffA);
            PG8_WAIT_L(8); PG8_BAR; PG8_WAIT_L(0); PG8_MMA(0, 0, At, B0); PG8_BAR; PG8_SCHED;
            PG8_LDB(B1, 1, 1); PG8_STAGE(PG8_SB(1, 0), b3, voffB);
            PG8_BAR; PG8_WAIT_L(0); PG8_MMA(0, 1, At, B1); PG8_BAR;
            PG8_LDA(At, 1, 1); PG8_STAGE(PG8_SA(1, 0), a3, voffA);
            PG8_BAR; PG8_WAIT_L(0); PG8_MMA(1, 0, At, B0); PG8_BAR; PG8_SCHED;
            PG8_STAGE(PG8_SB(1, 1), b3 + hstep, voffB);
            PG8_WAIT_V(6); PG8_BAR; PG8_MMA(1, 1, At, B1); PG8_BAR;
        }
        PG8_STAMP();
        if constexpr (!Epi::AFTER_DRAIN) { E(acc, cur, wr, wc, fr, fq); S.done(cur); }
        PG8_STAMP();
        if (!has_next) break;
#pragma unroll
        for (int a = 0; a < 2; ++a)
#pragma unroll
            for (int b = 0; b < 2; ++b)
#pragma unroll
                for (int m = 0; m < 4; ++m)
#pragma unroll
                    for (int n = 0; n < 2; ++n) acc[a][b][m][n] = (f32x4){0.f, 0.f, 0.f, 0.f};
        cur = nxt; cA = nA; cB = nB; ++ui;
    }
    PG8_WAIT_V(0);
    if (wr == 0) PG8_BAR;
    PG8_BAR;
    if constexpr (Epi::AFTER_DRAIN) { E.fused(acc, cur, wr, wc, fr, fq, lds, wid, lane); S.done(cur); }
    PG8_STAMP();
    if (STAMP && wid == 0) { stamps[lane] = lane < nts ? (((unsigned long long)(unsigned)ts_hi << 32) | (unsigned)ts_lo) : 0ull;
        if (lane == 62) stamps[62] = rt_entry; if (lane == 63) stamps[63] = (unsigned long long)wall_clock64(); }
#undef PG8_STAMP
#undef PG8_SA
#undef PG8_SB
#undef PG8_STAGE
#undef PG8_LDA
#undef PG8_LDB
#undef PG8_MMA
#undef PG8_WAIT_V
#undef PG8_WAIT_L
#undef PG8_BAR
#undef PG8_SCHED
}
}
#define XB_TMO      128
#define XB_XCNT(j)  (256  + 64 * (j))
#define XB_XSUB(j)  (1280 + 64 * (j))
#define XB_XGEN(j)  (2304 + 64 * (j))
#define XB_TOP      3328
#define XB_TOPGEN   3392
#define XCD_BAR_WORDS 3456
#define XB_SPIN_CAP (1u << 18)
#define LAS __attribute__((address_space(3)))

__device__ __forceinline__ unsigned xb_ld(unsigned* p)              { return __hip_atomic_load(p, __ATOMIC_RELAXED, __HIP_MEMORY_SCOPE_AGENT); }
__device__ __forceinline__ unsigned xb_add(unsigned* p, unsigned v) { return __hip_atomic_fetch_add(p, v, __ATOMIC_RELAXED, __HIP_MEMORY_SCOPE_AGENT); }
__device__ __forceinline__ unsigned xb_xcc_id() { return (unsigned)__builtin_amdgcn_s_getreg((3 << 11) | 20) & 0xFu; }
#define XB_SPIN(cond, bar) do { unsigned _sp = 0; while (cond) { __builtin_amdgcn_s_sleep(1); \
    if ((++_sp & 255u) == 0u) { if (xb_ld(&(bar)[XB_TMO])) break; if (_sp > XB_SPIN_CAP) { atomicAdd(&(bar)[XB_TMO], 1u); break; } } } } while (0)

struct XcdBarrier {
    unsigned* bar; unsigned x;
    volatile LAS unsigned* st;
};

__device__ __forceinline__ XcdBarrier xcd_barrier_post(unsigned* bar, volatile LAS unsigned* st) {
    XcdBarrier b; b.bar = bar; b.x = xb_xcc_id(); b.st = st;
    if (threadIdx.x == 0) (void)xb_add(&bar[XB_XCNT(b.x)], 1u);
    return b;
}
__device__ __forceinline__ void xcd_barrier_complete(unsigned* bar, unsigned x, unsigned& nloc, unsigned& nx) {
    const unsigned G = gridDim.x * gridDim.y * gridDim.z;
    unsigned sum, cnt, mine, sp = 0u;
    for (;;) {
        sum = 0u; cnt = 0u; mine = 0u;
#pragma unroll
        for (unsigned j = 0; j < 16; ++j) { const unsigned c = xb_ld(&bar[XB_XCNT(j)]); sum += c; cnt += (c > 0u) ? 1u : 0u; mine = (j == x) ? c : mine; }
        if (sum == G) break;
        __builtin_amdgcn_s_sleep(1);
        if ((++sp & 255u) == 0u) { if (xb_ld(&bar[XB_TMO])) break; if (sp > XB_SPIN_CAP) { atomicAdd(&bar[XB_TMO], 1u); break; } }
    }
    nloc = mine > 0u ? mine : 1u; nx = cnt > 0u ? cnt : 1u;
}

__device__ __forceinline__ void xcd_barrier(const XcdBarrier& b) {
    asm volatile("s_waitcnt vmcnt(0)" ::: "memory");
    __syncthreads();
    if (threadIdx.x == 0) {
        unsigned* bar = b.bar;
        __builtin_amdgcn_s_waitcnt(0);
        unsigned nloc = b.st[0], nx = b.st[1];
        if (nloc == 0u) { xcd_barrier_complete(bar, b.x, nloc, nx); b.st[0] = nloc; b.st[1] = nx; }
        const unsigned old = xb_add(&bar[XB_XSUB(b.x)], 1u);
        const unsigned gen = old / nloc;
        if (old + 1u == (gen + 1u) * nloc) {
            __builtin_amdgcn_fence(__ATOMIC_RELEASE, "agent");
            asm volatile("s_waitcnt vmcnt(0)" ::: "memory");
            const unsigned og = xb_add(&bar[XB_TOP], 1u);
            const unsigned tg = og / nx;
            if (og + 1u == (tg + 1u) * nx) xb_add(&bar[XB_TOPGEN], 1u);
            else XB_SPIN(xb_ld(&bar[XB_TOPGEN]) == tg, bar);
            __builtin_amdgcn_fence(__ATOMIC_ACQUIRE, "agent");
            xb_add(&bar[XB_XGEN(b.x)], 1u);
            asm volatile("s_waitcnt vmcnt(0)" ::: "memory");
        } else {
            XB_SPIN(xb_ld(&bar[XB_XGEN(b.x)]) == gen, bar);
            __builtin_amdgcn_fence(__ATOMIC_ACQUIRE, "agent");
            asm volatile("s_waitcnt vmcnt(0)" ::: "memory");
        }
    }
    __syncthreads();
}
namespace pg8 {
struct EpiZ {
    static constexpr bool PERM = true, AFTER_DRAIN = false;
    bf16_t* O; int ldc;
    __device__ __forceinline__ void operator()(const f32x4 (&acc)[2][2][4][2], const Unit& u, int wr, int wc, int fr, int fq) const {
        const int row0 = u.pm * BM + wr * 64 + fr, col0 = u.pn * BM + wc * 32 + 8 * fq;
#pragma unroll
        for (int ai = 0; ai < 2; ++ai)
#pragma unroll
            for (int m = 0; m < 4; ++m) { bf16_t* rowp = O + (size_t)(row0 + ai * HALF + m * 16) * ldc + col0;
#pragma unroll
                for (int bj = 0; bj < 2; ++bj) { const f32x4 v0 = acc[ai][bj][m][0], v1 = acc[ai][bj][m][1];
                    u32x4 w; w.x = cvt_pk_bf16(v0[0], v0[1]); w.y = cvt_pk_bf16(v0[2], v0[3]); w.z = cvt_pk_bf16(v1[0], v1[1]); w.w = cvt_pk_bf16(v1[2], v1[3]);
                    *(u32x4*)(rowp + bj * HALF) = w; } }
    }
};
struct EpiRes {
    static constexpr bool PERM = false, AFTER_DRAIN = false;
    float* H; const float* gate_ctx; const float* gate_lat; int row_off;
    __device__ __forceinline__ void operator()(const f32x4 (&acc)[2][2][4][2], const Unit& u, int wr, int wc, int fr, int fq) const {
        const int row0 = row_off + u.pm * BM + wr * 64 + fr, col0 = u.pn * BM + wc * 32 + 4 * fq;
        const float* gt = (row_off + u.pm * BM) < 256 ? gate_ctx : gate_lat;
        f32x4 gv[2][2];
#pragma unroll
        for (int bj = 0; bj < 2; ++bj)
#pragma unroll
            for (int n = 0; n < 2; ++n) gv[bj][n] = *(const f32x4*)(gt + col0 + bj * HALF + n * 16);
#pragma unroll
        for (int ai = 0; ai < 2; ++ai)
#pragma unroll
            for (int m = 0; m < 4; ++m) { float* rowp = H + (size_t)(row0 + ai * HALF + m * 16) * 2048 + col0;
#pragma unroll
                for (int bj = 0; bj < 2; ++bj)
#pragma unroll
                    for (int n = 0; n < 2; ++n) { f32x4* q = (f32x4*)(rowp + bj * HALF + n * 16); *q = *q + gv[bj][n] * acc[ai][bj][m][n]; } }
    }
};
struct EpiResAtomic {
    static constexpr bool PERM = false, AFTER_DRAIN = false;
    float* H; const float* gate;
    __device__ __forceinline__ void operator()(const f32x4 (&acc)[2][2][4][2], const Unit& u, int wr, int wc, int fr, int fq) const {
        const int row0 = u.pm * BM + wr * 64 + fr, col0 = u.pn * BM + wc * 32 + 4 * fq;
#pragma unroll
        for (int bj = 0; bj < 2; ++bj)
#pragma unroll
            for (int n = 0; n < 2; ++n) { const f32x4 gv = *(const f32x4*)(gate + col0 + bj * HALF + n * 16);
#pragma unroll
                for (int ai = 0; ai < 2; ++ai)
#pragma unroll
                    for (int m = 0; m < 4; ++m) { float* q = H + (size_t)(row0 + ai * HALF + m * 16) * 2048 + col0 + bj * HALF + n * 16;
#pragma unroll
                        for (int j = 0; j < 4; ++j) atomicAdd(q + j, gv[j] * acc[ai][bj][m][n][j]); } }
    }
};
}

namespace att {
using bf16 = unsigned short;
constexpr int   D = 128, NW = 8, QBLK = 32, KVBLK = 64;
constexpr float SCALE = 0.088388347648318440f;
constexpr float THR = 8.f;
constexpr int SDEPTH = 2;
constexpr int LDQ = 1024, LDK = 256, LDV = 5888, LDG = 5888, LDO = 1024;
constexpr size_t SHM_V = KVBLK * D * 2, SHM_K = KVBLK * D * 2, SHM_ATTN = 2 * SHM_V + 2 * SHM_K + NW * 64 * 4;
using bf16x8 = __attribute__((ext_vector_type(8))) short;
using s16x4  = __attribute__((ext_vector_type(4))) short;
using f32x16 = __attribute__((ext_vector_type(16))) float;
using f32x8  = __attribute__((ext_vector_type(8))) float;
using u32x4  = __attribute__((ext_vector_type(4))) unsigned;
#define KSWZ(row, colB) ((row) * 256 + ((colB) ^ (((row) & 7) << 4)))
#define SBAR() __builtin_amdgcn_sched_barrier(0)
__device__ __forceinline__ int crow(int r, int hi) { return (r & 3) + 8 * (r >> 2) + 4 * hi; }
__device__ __forceinline__ unsigned cvtpk(float lo, float hi) {
  unsigned r; asm volatile("v_cvt_pk_bf16_f32 %0, %1, %2" : "=v"(r) : "v"(lo), "v"(hi)); return r;
}
template <typename TIn> struct Stage;
template <> struct Stage<bf16>  { using T = bf16x8;
  __device__ static __forceinline__ T ld8(const bf16* p) { return *reinterpret_cast<const bf16x8*>(p); }
  __device__ static __forceinline__ bf16x8 tobf(T x) { return x; } };
template <> struct Stage<float> { using T = f32x8;
  __device__ static __forceinline__ T ld8(const float* p) { return *reinterpret_cast<const f32x8*>(p); }
  __device__ static __forceinline__ bf16x8 tobf(T x) {
    u32x4 w = {cvtpk(x[0], x[1]), cvtpk(x[2], x[3]), cvtpk(x[4], x[5]), cvtpk(x[6], x[7])}; return *reinterpret_cast<bf16x8*>(&w); } };

__device__ __forceinline__ void partialSM(f32x16& p0, f32x16& p1, float& m_reg, float& mn, float& alpha) {
  constexpr float C = SCALE * 1.4426950408889634f;
  float pmax = p0[0]; for (int r = 1; r < 16; ++r) pmax = fmaxf(pmax, p0[r]); for (int r = 0; r < 16; ++r) pmax = fmaxf(pmax, p1[r]);
  { auto rr = __builtin_amdgcn_permlane32_swap(__float_as_uint(pmax), __float_as_uint(pmax), false, false);
    pmax = fmaxf(__uint_as_float(rr[0]), __uint_as_float(rr[1])); }
  if (__builtin_expect(__all(pmax - m_reg <= THR / SCALE), 1)) { mn = m_reg; alpha = 1.f; }
  else { mn = fmaxf(m_reg, pmax); alpha = __builtin_amdgcn_exp2f((m_reg - mn) * C); m_reg = mn; }
  float mnC = -mn * C;
  for (int r = 0; r < 16; ++r) p0[r] = fmaf(p0[r], C, mnC); for (int r = 0; r < 16; ++r) p1[r] = fmaf(p1[r], C, mnC);
  for (int r = 0; r < 16; ++r) p0[r] = __builtin_amdgcn_exp2f(p0[r]);
}
__device__ __forceinline__ void finishSM(f32x16& p0, f32x16& p1, float alpha, float& l_reg, bf16x8& pa0, bf16x8& pa1, bf16x8& pa2, bf16x8& pa3) {
  for (int r = 0; r < 16; ++r) p1[r] = __builtin_amdgcn_exp2f(p1[r]);
  float ps = 0; for (int r = 0; r < 16; ++r) ps += p0[r]; for (int r = 0; r < 16; ++r) ps += p1[r];
  { auto rr = __builtin_amdgcn_permlane32_swap(__float_as_uint(ps), __float_as_uint(ps), false, false);
    ps = __uint_as_float(rr[0]) + __uint_as_float(rr[1]); }
  l_reg = l_reg * alpha + ps;
#define PK4(P, BASE, OUT) do { unsigned a0 = cvtpk(P[BASE + 0], P[BASE + 1]), a1 = cvtpk(P[BASE + 2], P[BASE + 3]);   \
    unsigned b0 = cvtpk(P[BASE + 4], P[BASE + 5]), b1 = cvtpk(P[BASE + 6], P[BASE + 7]);                              \
    auto r0 = __builtin_amdgcn_permlane32_swap(a0, b0, false, false); auto r1 = __builtin_amdgcn_permlane32_swap(a1, b1, false, false); \
    u32x4 w = {r0[0], r1[0], r0[1], r1[1]}; OUT = *reinterpret_cast<bf16x8*>(&w); } while (0)
  PK4(p0, 0, pa0); PK4(p0, 8, pa1); PK4(p1, 0, pa2); PK4(p1, 8, pa3);
#undef PK4
}
__device__ __forceinline__ void qkt(f32x16& p0, f32x16& p1, const bf16* Ks, const bf16x8* qr, int r32, int hi) {
  p0 = f32x16{}; p1 = f32x16{};
  for (int d0 = 0; d0 < 8; ++d0) { int cb = (d0 * 16 + hi * 8) * 2;
    bf16x8 b0 = *reinterpret_cast<const bf16x8*>((const char*)Ks + KSWZ(r32, cb));
    bf16x8 b1 = *reinterpret_cast<const bf16x8*>((const char*)Ks + KSWZ(32 + r32, cb));
    p0 = __builtin_amdgcn_mfma_f32_32x32x16_bf16(b0, qr[d0], p0, 0, 0, 0);
    p1 = __builtin_amdgcn_mfma_f32_32x32x16_bf16(b1, qr[d0], p1, 0, 0, 0); }
}
__device__ __forceinline__ int v_st(int k, int c) { const int kk = (k & ~0xC) | ((k & 4) << 1) | ((k & 8) >> 1); return ((kk >> 3) * 4 + (c >> 5)) * 512 + ((kk & 7) * 32 + (c & 31)) * 2; }
__device__ __forceinline__ int v_rd_base(int lane) { return ((lane & 3) << 3) | (((lane >> 2) & 3) << 6) | (((lane >> 4) & 1) << 5) | (((lane >> 5) & 1) << 8); }
constexpr int v_rd_off(int d0, int ks, int half) { return d0 * 512 + ks * 4096 + half * 2048; }
template <int OFF> __device__ __forceinline__ s16x4 tr_read(int vb) {
  s16x4 r; asm volatile("ds_read_b64_tr_b16 %0, %1 offset:%2" : "=&v"(r) : "v"(vb), "i"(OFF) : "memory"); return r;
}
template <int D0> __device__ __forceinline__ void pv_one(f32x16& od, int vb, bf16x8 pa0, bf16x8 pa1, bf16x8 pa2, bf16x8 pa3) {
  const s16x4 l0 = tr_read<v_rd_off(D0, 0, 0)>(vb), h0 = tr_read<v_rd_off(D0, 0, 1)>(vb), l1 = tr_read<v_rd_off(D0, 1, 0)>(vb), h1 = tr_read<v_rd_off(D0, 1, 1)>(vb);
  const s16x4 l2 = tr_read<v_rd_off(D0, 2, 0)>(vb), h2 = tr_read<v_rd_off(D0, 2, 1)>(vb), l3 = tr_read<v_rd_off(D0, 3, 0)>(vb), h3 = tr_read<v_rd_off(D0, 3, 1)>(vb);
  asm volatile("s_waitcnt lgkmcnt(0)" ::: "memory"); SBAR();
#define PK(L, H) (bf16x8){L[0], L[1], L[2], L[3], H[0], H[1], H[2], H[3]}
  od = __builtin_amdgcn_mfma_f32_32x32x16_bf16(pa0, PK(l0, h0), od, 0, 0, 0);
  od = __builtin_amdgcn_mfma_f32_32x32x16_bf16(pa1, PK(l1, h1), od, 0, 0, 0);
  od = __builtin_amdgcn_mfma_f32_32x32x16_bf16(pa2, PK(l2, h2), od, 0, 0, 0);
  od = __builtin_amdgcn_mfma_f32_32x32x16_bf16(pa3, PK(l3, h3), od, 0, 0, 0);
#undef PK
}
__device__ __forceinline__ void pv_d0(f32x16* o, int vb, bf16x8 pa0, bf16x8 pa1, bf16x8 pa2, bf16x8 pa3) {
  pv_one<0>(o[0], vb, pa0, pa1, pa2, pa3); pv_one<1>(o[1], vb, pa0, pa1, pa2, pa3); pv_one<2>(o[2], vb, pa0, pa1, pa2, pa3); pv_one<3>(o[3], vb, pa0, pa1, pa2, pa3);
}
__device__ __forceinline__ void attn_dense_body(const bf16* __restrict__ Qb, const bf16* __restrict__ Kh, const bf16* __restrict__ Vh,
                                                float* __restrict__ ML, bf16* __restrict__ Mx, int seq, char* lds) {
  using TQ = bf16;
  using St = Stage<bf16>; using SQ = Stage<TQ>;
  const int tid = tidx(), wid = tid >> 6, lane = tid & 63, r32 = lane & 31, hi = lane >> 5;
  bf16* V_lds = (bf16*)lds; bf16* K_lds = (bf16*)(lds + 2 * SHM_V);
  float* ws = (float*)(lds + 2 * SHM_V + 2 * SHM_K) + wid * 64; float* li_l = ws; float* al_l = ws + 32;
  float m_reg = -1e30f, l_reg = 0; f32x16 o[4] = {}; bf16x8 qr[8];
  const TQ* Qw = Qb + (long)(wid * QBLK + r32) * LDQ + hi * 8;
#pragma unroll
  for (int d0 = 0; d0 < 8; ++d0) qr[d0] = SQ::tobf(SQ::ld8(Qw + d0 * 16));
  const int sr = tid >> 4, sc = (tid & 15) * 8, vst0 = v_st(sr, sc), vst1 = v_st(32 + sr, sc);
  const int vb0 = (int)(uintptr_t)V_lds + v_rd_base(lane);
  struct { typename St::T vs0, vs1, ks0, ks1; } sr_[SDEPTH];
#define SLOAD(i, k0) do { sr_[i].vs0 = St::ld8(&Vh[(long)((k0) + sr) * LDK + sc]); sr_[i].vs1 = St::ld8(&Vh[(long)((k0) + 32 + sr) * LDK + sc]); \
    sr_[i].ks0 = St::ld8(&Kh[(long)((k0) + sr) * LDK + sc]); sr_[i].ks1 = St::ld8(&Kh[(long)((k0) + 32 + sr) * LDK + sc]); } while (0)
#define SWRITE(b, i) do { *(bf16x8*)((char*)V_lds + (b) * SHM_V + vst0) = St::tobf(sr_[i].vs0);          \
    *(bf16x8*)((char*)V_lds + (b) * SHM_V + vst1) = St::tobf(sr_[i].vs1); int kc = sc * 2;               \
    *(bf16x8*)((char*)K_lds + (b) * SHM_K + KSWZ(sr, kc)) = St::tobf(sr_[i].ks0);                       \
    *(bf16x8*)((char*)K_lds + (b) * SHM_K + KSWZ(32 + sr, kc)) = St::tobf(sr_[i].ks1); } while (0)
#define SWAIT() do { if constexpr (SDEPTH == 2) asm volatile("s_waitcnt vmcnt(4)" ::: "memory"); else asm volatile("s_waitcnt vmcnt(0)" ::: "memory"); } while (0)
#define RESC(a) do { if (__any((a) < 1.f)) { if (hi == 0) al_l[r32] = (a); asm volatile("s_waitcnt lgkmcnt(0)" ::: "memory"); \
    for (int d = 0; d < 4; ++d) for (int r = 0; r < 16; ++r) o[d][r] *= al_l[crow(r, hi)]; } } while (0)
  f32x16 pA0, pA1, pB0, pB1; float mnA, mnB, alA, alB; bf16x8 pa0, pa1, pa2, pa3; const int NT = seq / KVBLK;
  constexpr int SE = 0, SO = SDEPTH - 1;
  SLOAD(SE, 0); asm volatile("s_waitcnt vmcnt(0)" ::: "memory"); SWRITE(0, SE); __syncthreads();
  qkt(pA0, pA1, K_lds, qr, r32, hi); partialSM(pA0, pA1, m_reg, mnA, alA);
  SLOAD(SO, KVBLK); if constexpr (SDEPTH == 2) { if (2 < NT) SLOAD(SE, 2 * KVBLK); }
  SWAIT(); SWRITE(1, SO); __syncthreads();
  for (int j = 1; j + 1 < NT; j += 2) {
    SBAR(); qkt(pB0, pB1, (bf16*)((char*)K_lds + SHM_K), qr, r32, hi);
    finishSM(pA0, pA1, alA, l_reg, pa0, pa1, pa2, pa3); SBAR();
    SLOAD(SO, (j + SDEPTH) * KVBLK); SBAR();
    pv_d0(o, vb0, pa0, pa1, pa2, pa3); partialSM(pB0, pB1, m_reg, mnB, alB);
    __syncthreads(); SWAIT(); SWRITE(0, SE);
    RESC(alB); __syncthreads();
    SBAR(); qkt(pA0, pA1, K_lds, qr, r32, hi);
    finishSM(pB0, pB1, alB, l_reg, pa0, pa1, pa2, pa3); SBAR();
    if (SDEPTH == 1 || j + 3 < NT) SLOAD(SE, (j + 1 + SDEPTH) * KVBLK); SBAR();
    pv_d0(o, vb0 + (int)SHM_V, pa0, pa1, pa2, pa3); partialSM(pA0, pA1, m_reg, mnA, alA);
    __syncthreads(); SWAIT(); SWRITE(1, SO);
    RESC(alA); __syncthreads();
  }
  SBAR(); qkt(pB0, pB1, (bf16*)((char*)K_lds + SHM_K), qr, r32, hi);
  finishSM(pA0, pA1, alA, l_reg, pa0, pa1, pa2, pa3); SBAR();
  pv_d0(o, vb0, pa0, pa1, pa2, pa3); partialSM(pB0, pB1, m_reg, mnB, alB);
  __syncthreads(); RESC(alB);
  finishSM(pB0, pB1, alB, l_reg, pa0, pa1, pa2, pa3); SBAR();
  pv_d0(o, vb0 + (int)SHM_V, pa0, pa1, pa2, pa3);
  if (hi == 0) { li_l[r32] = l_reg; if (ML != nullptr) { *(float2*)(ML + (long)(wid * QBLK + r32) * 16) = make_float2(m_reg, l_reg); } } asm volatile("s_waitcnt lgkmcnt(0)" ::: "memory");
  float rli[16];
#pragma unroll
  for (int r = 0; r < 16; ++r) rli[r] = __builtin_amdgcn_rcpf(li_l[crow(r, hi)]);
  bf16* Mw = Mx + (long)(wid * QBLK) * LDO;
#pragma unroll
  for (int r = 0; r < 16; ++r) { int orow = crow(r, hi);
#pragma unroll
    for (int d0 = 0; d0 < 4; ++d0) Mw[(long)orow * LDO + d0 * 32 + r32] = f2bf(o[d0][r] * rli[r]); }
#undef SLOAD
#undef SWRITE
#undef SWAIT
#undef RESC
}
}

constexpr int CV_NT_IN = 32 * 23, CV_NT_OUT = 32 * 8, CV_TILES = CV_NT_IN + CV_NT_OUT, CV_ITEMS = CV_TILES + 96;
__device__ __forceinline__ void convert_tile(const Params& p, int l, int r, unsigned char* smem) {
  const int tid = tidx();
  float* tile = (float*)smem;
  const bool isin = r < CV_NT_IN;
  const float* src; bf16_t* dst; int kt, nt, ldsrc;
  if (isin) { kt = r / 23; nt = r % 23; src = p.w_in + (size_t)l * DM * DIN; ldsrc = DIN; dst = (bf16_t*)(p.ws + WS_WIN) + (size_t)l * ZLD * DM; }
  else { r -= CV_NT_IN; kt = r / 8; nt = r % 8; src = p.w_out + (size_t)l * DM * DM; ldsrc = DM; dst = (bf16_t*)(p.ws + WS_WOUT) + (size_t)l * DM * DM; }
  __syncthreads();
  float4 v[8];
#pragma unroll
  for (int i = 0; i < 8; ++i) {
    const int e = tid + 512 * i, kk = e >> 6, n = nt * 256 + (e & 63) * 4;
    const int oc = isin ? (n < 3072 ? n : (n < 5632 ? n + 16 : (n < 5648 ? n - 2560 : -1))) : n;
    v[i] = oc >= 0 ? *(const float4*)(src + (size_t)(kt * 64 + kk) * ldsrc + oc) : make_float4(0.f, 0.f, 0.f, 0.f);
  }
#pragma unroll
  for (int i = 0; i < 8; ++i) { const int e = tid + 512 * i; *(float4*)(tile + (e >> 6) * 260 + (e & 63) * 4) = v[i]; }
  __syncthreads();
  {
    const int nn = tid >> 1, k0 = (tid & 1) * 32;
    bf16_t* d = dst + (size_t)(nt * 256 + nn) * DM + kt * 64 + k0;
#pragma unroll
    for (int q = 0; q < 4; ++q) {
      float f[8];
#pragma unroll
      for (int i = 0; i < 8; ++i) f[i] = tile[(k0 + q * 8 + i) * 260 + nn];
      u32x4_t w = {cvtpk2(f[0], f[1]), cvtpk2(f[2], f[3]), cvtpk2(f[4], f[5]), cvtpk2(f[6], f[7])};
      *(u32x4_t*)(d + q * 8) = w;
    }
  }
}
__device__ __forceinline__ void mod_item(const Params& p, int l, int jg, unsigned char* smem) {
  const int tid = tidx();
  float* sc = (float*)smem;
  float* red = (float*)smem + 4096;
  __syncthreads();
  for (int k = tid; k < 2048; k += 512) { sc[k] = siluf_(p.c[k]); sc[2048 + k] = siluf_(p.c_ctx[k]); }
  __syncthreads();
  float* mod = (float*)(p.ws + WS_MOD);
  const int cq = tid & 15, kg = tid >> 4, j0 = jg * 64;
  const float* wp = p.w_mod + ((size_t)l * DM + kg * 64) * 6144 + j0 + cq * 4;
  float4 a0 = {0.f, 0.f, 0.f, 0.f}, a1 = {0.f, 0.f, 0.f, 0.f};
#pragma unroll 16
  for (int k = 0; k < 64; ++k) {
    const float4 w = *(const float4*)(wp + (size_t)k * 6144);
    const float s0 = sc[kg * 64 + k], s1 = sc[2048 + kg * 64 + k];
    a0.x += s0 * w.x; a0.y += s0 * w.y; a0.z += s0 * w.z; a0.w += s0 * w.w;
    a1.x += s1 * w.x; a1.y += s1 * w.y; a1.z += s1 * w.z; a1.w += s1 * w.w;
  }
  *(float4*)(red + (kg * 2 + 0) * 64 + cq * 4) = a0;
  *(float4*)(red + (kg * 2 + 1) * 64 + cq * 4) = a1;
  __syncthreads();
  if (tid < 128) {
    const int s = tid >> 6, j = tid & 63; float acc = 0.f;
#pragma unroll 8
    for (int g = 0; g < 32; ++g) acc += red[(g * 2 + s) * 64 + j];
    mod[((size_t)l * 2 + s) * 6144 + j0 + j] = acc + p.b_mod[(size_t)l * 6144 + j0 + j];
  }
}
__device__ __forceinline__ void convert_item(const Params& p, int l, int it, unsigned char* smem) {
  if (it < CV_TILES) convert_tile(p, l, it, smem); else mod_item(p, l, it - CV_TILES, smem);
}
__device__ void convert_queue(const Params& p, int l, unsigned char* smem) {
  unsigned* ctr = (unsigned*)(p.ws + WS_CTR) + 8 + l;
  volatile int* slot = (volatile int*)(smem + 144000);
  for (;;) {
    __syncthreads();
    if (tidx() == 0) *slot = (int)atomicAdd(ctr, 1u);
    __syncthreads();
    const int it = *slot;
    if (it >= CV_ITEMS) break;
    convert_item(p, l, it, smem);
  }
  __syncthreads();
}
__device__ void phase_prep0(const Params& p, unsigned char* smem) {
  const int tid = tidx(), nb = gridDim.x, bid = bidx();
  {
    float4* h4 = (float4*)(p.ws + WS_H);
    const float4* c4 = (const float4*)p.ctx; const float4* x4 = (const float4*)p.x;
    const long nctx = (long)TC * DM / 4, ntot = (long)TA * DM / 4;
    for (long i = (long)bid * 512 + tid; i < ntot; i += (long)nb * 512) h4[i] = i < nctx ? c4[i] : x4[i - nctx];
  }
  for (int it = bid; it < CV_ITEMS; it += nb) convert_item(p, 0, it, smem);
  {
    bf16_t* wg = (bf16_t*)(p.ws + WS_WG);
    const int total = NL * 2 * 2 * 8 * 4096;
    for (int e = bid * 512 + tid; e < total; e += nb * 512) {
      const int i = e & 63, j = (e >> 6) & 63, n = (e >> 12) & 7, g = (e >> 15) & 1, d = (e >> 16) & 1, l = e >> 17;
      const float* src = g ? p.w_ia : p.w_ra;
      wg[e] = f2bf(src[((((size_t)l * 2 + d) * 8 + n) * 64 + i) * 64 + j]);
    }
  }
  __syncthreads();
}

__device__ void phase_norm(const Params& p, int l) {
  const int tid = tidx(), lane = tid & 63, wid = tid >> 6;
  const float* H = (const float*)(p.ws + WS_H);
  bf16_t* XN = (bf16_t*)(p.ws + WS_XN);
  const float* g = p.norm_g + (size_t)l * DM;
  const float* mod = (const float*)(p.ws + WS_MOD) + (size_t)l * 2 * 6144;
  for (int r = bidx() * 8 + wid; r < TA; r += gridDim.x * 8) {
    const float* hr = H + (size_t)r * DM;
    const float* md = mod + (r < TC ? 6144 : 0);
    float4 v[8]; float ss = 0.f;
#pragma unroll
    for (int i = 0; i < 8; ++i) { v[i] = *(const float4*)(hr + i * 256 + lane * 4); ss += v[i].x * v[i].x + v[i].y * v[i].y + v[i].z * v[i].z + v[i].w * v[i].w; }
    ss = wave_sum(ss);
    const float rstd = rsqrtf(ss * (1.f / DM) + 1e-6f);
#pragma unroll
    for (int i = 0; i < 8; ++i) {
      const int c = i * 256 + lane * 4;
      const float4 gg = *(const float4*)(g + c), sh = *(const float4*)(md + c), scl = *(const float4*)(md + 2048 + c);
      const float o0 = v[i].x * rstd * gg.x * (1.f + scl.x) + sh.x, o1 = v[i].y * rstd * gg.y * (1.f + scl.y) + sh.y;
      const float o2 = v[i].z * rstd * gg.z * (1.f + scl.z) + sh.z, o3 = v[i].w * rstd * gg.w * (1.f + scl.w) + sh.w;
      u32x2_t w = {cvtpk2(o0, o1), cvtpk2(o2, o3)};
      *(u32x2_t*)(XN + (size_t)r * DM + c) = w;
    }
  }
}

__device__ void phase_final(const Params& p) {
  const int tid = tidx(), lane = tid & 63, wid = tid >> 6;
  const float* H = (const float*)(p.ws + WS_H);
  for (int t = bidx() * 8 + wid; t < TL; t += gridDim.x * 8) {
    const float* hr = H + (size_t)(TC + t) * DM;
    float4 v[8]; float ss = 0.f;
#pragma unroll
    for (int i = 0; i < 8; ++i) { v[i] = *(const float4*)(hr + i * 256 + lane * 4); ss += v[i].x * v[i].x + v[i].y * v[i].y + v[i].z * v[i].z + v[i].w * v[i].w; }
    ss = wave_sum(ss);
    const float rstd = rsqrtf(ss * (1.f / DM) + 1e-6f);
#pragma unroll
    for (int i = 0; i < 8; ++i) {
      const int c = i * 256 + lane * 4;
      const float4 gg = *(const float4*)(p.final_g + c);
      float4 o = {v[i].x * rstd * gg.x, v[i].y * rstd * gg.y, v[i].z * rstd * gg.z, v[i].w * rstd * gg.w};
      *(float4*)(p.out + (size_t)t * DM + c) = o;
    }
  }
}

__device__ void phase_qkprep(const Params& p, int l) {
  const int tid = tidx(), lane = tid & 63, wid = tid >> 6;
  const bf16_t* Z = (const bf16_t*)(p.ws + WS_Z);
  bf16_t* QB = (bf16_t*)(p.ws + WS_QB); bf16_t* KB = (bf16_t*)(p.ws + WS_KB); bf16_t* VB = (bf16_t*)(p.ws + WS_VB);
  const float gq1 = p.qn_c[l * 128 + lane], gq2 = p.qn_c[l * 128 + 64 + lane];
  const float gk1 = p.kn_c[l * 128 + lane], gk2 = p.kn_c[l * 128 + 64 + lane];
  const float inv_freq = exp2f(-(float)(lane & 31) * (13.287712379549449f / 32.f));
  for (int r = bidx() * 8 + wid; r < TA; r += gridDim.x * 8) {
    float cs = 1.f, sn = 0.f;
    if (r >= TC) {
      const int t = r - TC; const float pos = (float)(lane < 32 ? (t >> 6) : (t & 63));
      const float ang = pos * inv_freq;
      const float k = rintf(ang * 0.15915494309189535f);
      float rr = fmaf(-k, 6.2831854820251465f, ang); rr = fmaf(-k, -1.7484555e-7f, rr);
      cs = cosf(rr); sn = sinf(rr);
    }
    const bf16_t* zr = Z + (size_t)r * ZLD;
#pragma unroll
    for (int hh = 0; hh < 10; ++hh) {
      const int zc = hh < 8 ? ZC_QC + hh * 128 : ZC_KC + (hh - 8) * 128;
      const float x1 = bf2f(zr[zc + lane]), x2 = bf2f(zr[zc + 64 + lane]);
      const float ss = wave_sum(x1 * x1 + x2 * x2);
      const float rstd = rsqrtf(ss * (1.f / 128.f) + 1e-6f);
      const float y1 = x1 * rstd * (hh < 8 ? gq1 : gk1), y2 = x2 * rstd * (hh < 8 ? gq2 : gk2);
      const float o1 = y1 * cs - y2 * sn, o2 = y2 * cs + y1 * sn;
      bf16_t* dst = hh < 8 ? QB + (size_t)r * 1024 + hh * 128 : KB + (size_t)r * 256 + (hh - 8) * 128;
      dst[lane] = f2bf(o1); dst[64 + lane] = f2bf(o2);
    }
    *(u32x2_t*)(VB + (size_t)r * 256 + lane * 4) = *(const u32x2_t*)(zr + ZC_VC + lane * 4);
  }
}

__device__ __forceinline__ void lru_ab_item(const Params& p, int l, int it, unsigned char* smem) {
  const int tid = tidx(), lane = tid & 63, wid = tid >> 6, fr = lane & 15, fq = lane >> 4;
  const bf16_t* Z = (const bf16_t*)(p.ws + WS_Z);
  float* uS = (float*)smem;
  bf16_t* uB = (bf16_t*)(smem + 16640);
  float* aS = (float*)(smem + 16640 + 9216);
  float* bS = aS + 2 * 64 * 64;
  float* LA = (float*)(p.ws + WS_LA); float* LB = (float*)(p.ws + WS_LB);
  float* LSEG = (float*)(p.ws + WS_LSEG);
  const bf16_t* WG = (const bf16_t*)(p.ws + WS_WG) + (size_t)l * 2 * 2 * 8 * 4096;
  {
    const int rs = it >> 3, n = it & 7, r0 = rs * 64;
    const int seg_lo = r0 < TC ? 0 : TC, seg_hi = r0 < TC ? TC : TA;
    __syncthreads();
    {
      const int tk = tid >> 3, c8 = (tid & 7) * 8, ch0 = n * 64 + c8;
      float acc[8];
#pragma unroll
      for (int i = 0; i < 8; ++i) acc[i] = p.conv_a_b[l * 512 + ch0 + i];
#pragma unroll
      for (int kk = 0; kk < 4; ++kk) {
        const int rr = r0 + tk + kk - 2;
        if (rr >= seg_lo && rr < seg_hi) {
          const bf16x8_t xv = *(const bf16x8_t*)(Z + (size_t)rr * ZLD + ZC_XA + ch0);
          const float* cw = p.conv_a_w + ((size_t)l * 4 + kk) * 512 + ch0;
#pragma unroll
          for (int i = 0; i < 8; ++i) acc[i] += cw[i] * bf2f((bf16_t)xv[i]);
        }
      }
#pragma unroll
      for (int i = 0; i < 8; ++i) { uS[tk * 65 + c8 + i] = acc[i]; uB[tk * 72 + c8 + i] = f2bf(acc[i]); }
    }
    __syncthreads();
    {
      const int d = wid & 1, ct = wid >> 1;
      f32x4_t ar[4], ai[4];
#pragma unroll
      for (int m = 0; m < 4; ++m) { ar[m] = (f32x4_t){0.f, 0.f, 0.f, 0.f}; ai[m] = (f32x4_t){0.f, 0.f, 0.f, 0.f}; }
      const bf16_t* wr_ = WG + ((size_t)(d * 2 + 0) * 8 + n) * 4096 + (ct * 16 + fr) * 64;
      const bf16_t* wi_ = WG + ((size_t)(d * 2 + 1) * 8 + n) * 4096 + (ct * 16 + fr) * 64;
#pragma unroll
      for (int ks = 0; ks < 2; ++ks) {
        const bf16x8_t br = *(const bf16x8_t*)(wr_ + ks * 32 + fq * 8);
        const bf16x8_t bi = *(const bf16x8_t*)(wi_ + ks * 32 + fq * 8);
#pragma unroll
        for (int m = 0; m < 4; ++m) {
          const bf16x8_t a = *(const bf16x8_t*)(uB + (m * 16 + fr) * 72 + ks * 32 + fq * 8);
          ar[m] = __builtin_amdgcn_mfma_f32_16x16x32_bf16(a, br, ar[m], 0, 0, 0);
          ai[m] = __builtin_amdgcn_mfma_f32_16x16x32_bf16(a, bi, ai[m], 0, 0, 0);
        }
      }
      const int cl = ct * 16 + fr, ch = n * 64 + cl;
      const float bra = p.b_ra[(l * 2 + d) * 512 + ch], bia = p.b_ia[(l * 2 + d) * 512 + ch];
      const float spl = softplusf_(-p.lam_a[(l * 2 + d) * 512 + ch]);
#pragma unroll
      for (int m = 0; m < 4; ++m)
#pragma unroll
        for (int j = 0; j < 4; ++j) {
          const int tk = m * 16 + fq * 4 + j;
          const float gr = sigmoidf_(ar[m][j] + bra), gi = sigmoidf_(ai[m][j] + bia);
          const float la = -8.f * gr * spl, x2 = 2.f * la;
          const float om = x2 > -0.05f ? -x2 * (1.f + x2 * (0.5f + x2 * (0.16666667f + x2 * 0.041666668f))) : 1.f - fexp_(x2);
          const float a = fexp_(la), b = __builtin_amdgcn_sqrtf(om) * gi * uS[tk * 65 + cl];
          aS[(d * 64 + tk) * 64 + cl] = a; bS[(d * 64 + tk) * 64 + cl] = b;
          LA[((size_t)d * TA + r0 + tk) * 512 + ch] = a; LB[((size_t)d * TA + r0 + tk) * 512 + ch] = b;
        }
    }
    __syncthreads();
    if (tid < 128) {
      const int d = tid >> 6, cl = tid & 63;
      float A = 1.f, B = 0.f;
      for (int s = 0; s < 64; ++s) { const int tk = d ? 63 - s : s; const float a = aS[(d * 64 + tk) * 64 + cl], b = bS[(d * 64 + tk) * 64 + cl]; A *= a; B = a * B + b; }
      const int ps = d == 0 ? rs : (rs < 4 ? 3 - rs : 135 - rs);
      float* o = LSEG + (((size_t)d * NCH + ps) * 512 + n * 64 + cl) * 2;
      o[0] = A; o[1] = B;
    }
  }
}

__device__ void lru_carry(const Params& p, int blk  ) {
  const int d = blk, ch = tidx();
  const float* LSEG = (const float*)(p.ws + WS_LSEG) + (size_t)d * NCH * 512 * 2;
  float* LCAR = (float*)(p.ws + WS_LCAR) + (size_t)d * NCH * 512;
  float h = 0.f;
#pragma unroll 4
  for (int ps = 0; ps < NCH; ++ps) {
    const float2 ab = *(const float2*)(LSEG + ((size_t)ps * 512 + ch) * 2);
    LCAR[ps * 512 + ch] = h; h = ab.x * h + ab.y;
  }
}

__device__ __forceinline__ void lru_fin_item(const Params& p, int l, int rs) {
  const int ch = tidx();
  const float* LA = (const float*)(p.ws + WS_LA); const float* LB = (const float*)(p.ws + WS_LB);
  const float* LCAR = (const float*)(p.ws + WS_LCAR);
  const bf16_t* Z = (const bf16_t*)(p.ws + WS_Z); bf16_t* MIX = (bf16_t*)(p.ws + WS_MIX);
  {
    const int r0 = rs * 64, ps1 = rs < 4 ? 3 - rs : 135 - rs;
    float hb[64];
    float h = LCAR[((size_t)1 * NCH + ps1) * 512 + ch];
#pragma unroll
    for (int s = 0; s < 64; ++s) { const int tk = 63 - s; const size_t o = ((size_t)1 * TA + r0 + tk) * 512 + ch; h = LA[o] * h + LB[o]; hb[tk] = h; }
    h = LCAR[((size_t)0 * NCH + rs) * 512 + ch];
#pragma unroll
    for (int tk = 0; tk < 64; ++tk) {
      const size_t o = ((size_t)0 * TA + r0 + tk) * 512 + ch; h = LA[o] * h + LB[o];
      const float ga = bf2f(Z[(size_t)(r0 + tk) * ZLD + ZC_GA + ch]);
      MIX[(size_t)(r0 + tk) * DM + ch] = f2bf((h + hb[tk]) * siluf_(ga));
    }
  }
}

constexpr int GD_QN = 0, GD_KN = 17408, GD_KT = 34816, GD_VT = 53248, GD_KK = 71680, GD_QK = 88320, GD_MS = 104960, GD_SC = 141824;
__device__ __forceinline__ void gdn_local_item(const Params& p, int l, int it, unsigned char* smem) {
  const bf16_t* Z = (const bf16_t*)(p.ws + WS_Z);
  bf16_t* qN = (bf16_t*)(smem + GD_QN); bf16_t* kN = (bf16_t*)(smem + GD_KN);
  bf16_t* kT = (bf16_t*)(smem + GD_KT); bf16_t* vT = (bf16_t*)(smem + GD_VT);
  float* KKs = (float*)(smem + GD_KK); float* QKs = (float*)(smem + GD_QK);
  float* Ms = (float*)(smem + GD_MS);
  float* SC = (float*)(smem + GD_SC);
  unsigned char* GREC = p.ws + WS_GREC; float* GU = (float*)(p.ws + WS_GU); float* GGL = (float*)(p.ws + WS_GGL);
  {
    const int rc = it >> 2, h = it & 3, r0 = rc * 64;
    const int seg_lo = r0 < TC ? 0 : TC, seg_hi = r0 < TC ? TC : TA;
    __syncthreads();
    {
    const int tid = tidx(), lane = tid & 63, wid = tid >> 6;
#pragma unroll 1
    for (int i = 0; i < 6; ++i) {
      const int u = i * 512 + tid, tk = u / 48, part = (u % 48) >> 4, c8 = (u & 15) * 8;
      const int chq = part * 512 + h * 128 + c8;
      float acc[8];
#pragma unroll
      for (int e = 0; e < 8; ++e) acc[e] = 0.f;
#pragma unroll
      for (int kk = 0; kk < 4; ++kk) {
        const int rr = r0 + tk + kk - 2;
        if (rr >= seg_lo && rr < seg_hi) {
          const bf16x8_t xv = *(const bf16x8_t*)(Z + (size_t)rr * ZLD + ZC_QKVB + chq);
          const float* cw = p.conv_b_w + ((size_t)l * 4 + kk) * 1536 + chq;
#pragma unroll
          for (int e = 0; e < 8; ++e) acc[e] += cw[e] * bf2f((bf16_t)xv[e]);
        }
      }
      float ss = 0.f;
#pragma unroll
      for (int e = 0; e < 8; ++e) { acc[e] = siluf_(acc[e]); ss += acc[e] * acc[e]; }
      ss += __shfl_xor(ss, 1); ss += __shfl_xor(ss, 2); ss += __shfl_xor(ss, 4); ss += __shfl_xor(ss, 8);
      float scl = 1.f;
      if (part == 0) scl = rsqrtf(ss + 1e-6f) * 0.088388347648318440f;
      else if (part == 1) scl = rsqrtf(ss + 1e-6f);
#pragma unroll
      for (int e = 0; e < 8; ++e) {
        const bf16_t b = f2bf(acc[e] * scl);
        if (part == 0) qN[tk * 136 + c8 + e] = b;
        const int tsw = (((tk >> 3) ^ ((c8 >> 3) & 7)) << 3) | (tk & 7);
        if (part == 1) { kN[tk * 136 + c8 + e] = b; kT[(c8 + e) * 72 + tsw] = b; }
        else if (part == 2) vT[(c8 + e) * 72 + tsw] = b;
      }
    }
    if (wid < 2) {
      const int d = wid, tk = d ? 63 - lane : lane;
      const bf16_t* zr = Z + (size_t)(r0 + tk) * ZLD;
      const float beta = sigmoidf_(bf2f(zr[ZC_BETA + d * 4 + h]));
      const float g = -expf(p.a_log_b[(l * 2 + d) * 4 + h]) * softplusf_(bf2f(zr[ZC_ALPHA + d * 4 + h]) + p.dt_bias_b[(l * 2 + d) * 4 + h]);
      float gc = g;
#pragma unroll
      for (int o = 1; o < 64; o <<= 1) { const float t = __shfl_up(gc, o); if (lane >= o) gc += t; }
      const float gl = __shfl(gc, 63);
      float* s = SC + d * 256;
      s[lane] = beta; s[64 + lane] = gc; s[128 + lane] = expf(gc); s[192 + lane] = expf(gl - gc);
      if (lane == 0) { const int pc = d == 0 ? rc : (rc < 4 ? 3 - rc : 135 - rc); GGL[(size_t)(d * 4 + h) * NCH + pc] = expf(gl); }
    }
    }
    __syncthreads();
    {
      const int tid = tidx(), lane = tid & 63, wid = tid >> 6, fr = lane & 15, fq = lane >> 4;
      const int which = wid >> 2, mt = wid & 3;
      const bf16_t* Asrc = which ? qN : kN;
      f32x4_t acc[4];
#pragma unroll
      for (int ct = 0; ct < 4; ++ct) acc[ct] = (f32x4_t){0.f, 0.f, 0.f, 0.f};
#pragma unroll
      for (int ks = 0; ks < 4; ++ks) {
        const bf16x8_t a = *(const bf16x8_t*)(Asrc + (mt * 16 + fr) * 136 + ks * 32 + fq * 8);
#pragma unroll
        for (int ct = 0; ct < 4; ++ct) {
          const bf16x8_t b = *(const bf16x8_t*)(kN + (ct * 16 + fr) * 136 + ks * 32 + fq * 8);
          acc[ct] = __builtin_amdgcn_mfma_f32_16x16x32_bf16(a, b, acc[ct], 0, 0, 0);
        }
      }
      float* dst = which ? QKs : KKs;
#pragma unroll
      for (int ct = 0; ct < 4; ++ct)
#pragma unroll
        for (int j = 0; j < 4; ++j) dst[(mt * 16 + fq * 4 + j) * 65 + ct * 16 + fr] = acc[ct][j];
    }
    __syncthreads();
#pragma unroll 1
    for (int i = 0; i < 16; ++i) {
      const int e = i * 512 + tidx(), d = e >> 12, pi = (e >> 6) & 63, pj = e & 63;
      const int ti = d ? 63 - pi : pi, tj = d ? 63 - pj : pj;
      const float* s = SC + d * 256;
      const float dec = pi >= pj ? fexp_(s[64 + pi] - s[64 + pj]) : 0.f;
      Ms[(d * 64 + pi) * 72 + pj] = pi > pj ? s[pi] * KKs[ti * 65 + tj] * dec : 0.f;
      const int pc = d == 0 ? rc : (rc < 4 ? 3 - rc : 135 - rc);
      ((bf16_t*)(GREC + ((size_t)(d * 4 + h) * NCH + pc) * GREC_BYTES + 32768))[pi * 64 + pj] = f2bf(QKs[ti * 65 + tj] * dec);
    }
    __syncthreads();
    if ((tidx() >> 6) < 2) {
      const int d = tidx() >> 6, c = tidx() & 63;
      const float* Md = Ms + d * 64 * 72;
      float T[64];
#pragma unroll
      for (int i = 0; i < 64; ++i) T[i] = 0.f;
#pragma unroll
      for (int i = 0; i < 64; ++i) {
        float a0 = (i == c) ? 1.f : 0.f, a1 = 0.f;
#pragma unroll
        for (int jb = 0; jb < i; jb += 4) {
          const float4 m = *(const float4*)(Md + i * 72 + jb);
          a0 -= m.x * T[jb]; a1 -= m.y * T[jb + 1]; a0 -= m.z * T[jb + 2]; a1 -= m.w * T[jb + 3];
        }
        T[i] = a0 + a1;
      }
      const float* s = SC + d * 256;
      const float bc = s[c], bce = s[c] * s[128 + c];
      const int tc = d ? 63 - c : c;
      bf16_t* Tu = (bf16_t*)(Ms + d * 64 * 72); bf16_t* Tw = Tu + 64 * 72;
      asm volatile("s_waitcnt lgkmcnt(0)" ::: "memory");
#pragma unroll
      for (int i = 0; i < 64; ++i) { Tu[i * 72 + tc] = f2bf(T[i] * bc); Tw[i * 72 + tc] = f2bf(T[i] * bce); }
    } else {
#pragma unroll 1
      for (int e = tidx() - 128; e < 2048; e += 384) {
        const int d = e >> 10, pi = (e >> 4) & 63, c8 = (e & 15) * 8;
        const int ti = d ? 63 - pi : pi; const float sc = SC[d * 256 + 128 + pi];
        const int pc = d == 0 ? rc : (rc < 4 ? 3 - rc : 135 - rc);
        const bf16x8_t qv = *(const bf16x8_t*)(qN + ti * 136 + c8);
        float f[8];
#pragma unroll
        for (int k = 0; k < 8; ++k) f[k] = bf2f((bf16_t)qv[k]) * sc;
        u32x4_t w = {cvtpk2(f[0], f[1]), cvtpk2(f[2], f[3]), cvtpk2(f[4], f[5]), cvtpk2(f[6], f[7])};
        *(u32x4_t*)((bf16_t*)(GREC + ((size_t)(d * 4 + h) * NCH + pc) * GREC_BYTES + 16384) + pi * 128 + c8) = w;
      }
#pragma unroll 1
      for (int e = tidx() - 128; e < 2048; e += 384) {
        const int d = e >> 10, chn = (e >> 3) & 127, p8 = (e & 7) * 8;
        const int pc = d == 0 ? rc : (rc < 4 ? 3 - rc : 135 - rc);
        float f[8];
#pragma unroll
        for (int k = 0; k < 8; ++k) { const int pi = p8 + k, ti = d ? 63 - pi : pi; f[k] = bf2f(kT[chn * 72 + ((((ti >> 3) ^ ((chn >> 3) & 7)) << 3) | (ti & 7))]) * SC[d * 256 + 192 + pi]; }
        u32x4_t w = {cvtpk2(f[0], f[1]), cvtpk2(f[2], f[3]), cvtpk2(f[4], f[5]), cvtpk2(f[6], f[7])};
        *(u32x4_t*)((bf16_t*)(GREC + ((size_t)(d * 4 + h) * NCH + pc) * GREC_BYTES + 40960) + chn * 64 + p8) = w;
      }
    }
    __syncthreads();
    {
      const int tid = tidx(), lane = tid & 63, wid = tid >> 6, fr = lane & 15, fq = lane >> 4;
      const int d = wid >> 2, which = (wid >> 1) & 1, half = wid & 1;
      const int pc = d == 0 ? rc : (rc < 4 ? 3 - rc : 135 - rc);
      const size_t cbase = (size_t)(d * 4 + h) * NCH + pc;
      const bf16_t* Tm = (const bf16_t*)(Ms + d * 64 * 72) + which * 64 * 72;
      const bf16_t* Bs = which ? kT : vT;
#pragma unroll 1
      for (int cti = 0; cti < 4; ++cti) {
        const int ct = half * 4 + cti;
        f32x4_t acc[4];
#pragma unroll
        for (int m = 0; m < 4; ++m) acc[m] = (f32x4_t){0.f, 0.f, 0.f, 0.f};
#pragma unroll
        for (int ks = 0; ks < 2; ++ks) {
          const bf16x8_t b = *(const bf16x8_t*)(Bs + (ct * 16 + fr) * 72 + (((ks * 4 + fq) ^ ((2 * ct + (fr >> 3)) & 7)) << 3));
#pragma unroll
          for (int m = 0; m < 4; ++m) {
            const bf16x8_t a = *(const bf16x8_t*)(Tm + (m * 16 + fr) * 72 + ks * 32 + fq * 8);
            acc[m] = __builtin_amdgcn_mfma_f32_16x16x32_bf16(a, b, acc[m], 0, 0, 0);
          }
        }
#pragma unroll
        for (int m = 0; m < 4; ++m)
#pragma unroll
          for (int j = 0; j < 4; ++j) {
            const int pi = m * 16 + fq * 4 + j, chn = ct * 16 + fr;
            if (which) ((bf16_t*)(GREC + cbase * GREC_BYTES))[pi * 128 + chn] = f2bf(acc[m][j]);
            else GU[cbase * 8192 + pi * 128 + chn] = acc[m][j];
          }
      }
    }
  }
}

constexpr int GS_W = 0, GS_QH = 17408, GS_QK = 34816, GS_KT = 44032, GS_BUF = 62464, GS_GAM = 2 * GS_BUF, GS_OST = GS_GAM + 1024;
__device__ void gdn_scan(const Params& p, unsigned char* smem, int sq, int sg) {
  const int tid = tidx(), lane = tid & 63, wid = tid >> 6, fr = lane & 15, fq = lane >> 4;
  const int d = sq >> 2, h = sq & 3;
  const unsigned char* REC = p.ws + WS_GREC + (size_t)sq * NCH * GREC_BYTES;
  const float* GGL = (const float*)(p.ws + WS_GGL) + (size_t)sq * NCH;
  float* gamS = (float*)(smem + GS_GAM);
  __syncthreads();
  if (tid < NCH) gamS[tid] = GGL[tid];
  if (wid < 4) {
    const int slice = sg * 4 + wid, n0 = slice * 16;
    const float* up = (const float*)(p.ws + WS_GU) + (size_t)sq * NCH * 8192 + (fq * 4) * 128 + n0 + fr;
    float* GO = (float*)(p.ws + WS_GO) + (size_t)(sq * 8 + slice) * TA * 16;
    float* ost = (float*)(smem + GS_OST + wid * 4096);
    f32x4_t S[8], U[4];
#pragma unroll
    for (int t = 0; t < 8; ++t) S[t] = (f32x4_t){0.f, 0.f, 0.f, 0.f};
#pragma unroll
    for (int m = 0; m < 4; ++m)
#pragma unroll
      for (int j = 0; j < 4; ++j) U[m][j] = up[(m * 16 + j) * 128];
    __syncthreads();
#pragma unroll 1
    for (int pc = 0; pc < NCH; ++pc) {
      const unsigned char* B_ = smem + (pc & 1) * GS_BUF;
#define GS_AFRAG(base, stride, row, ks) ({ const unsigned char* a_ = B_ + (base) + (row) * (stride) + (ks) * 64 + fq * 8; \
      u32x2_t lo_ = *(const u32x2_t*)a_; u32x2_t hi_ = *(const u32x2_t*)(a_ + 32); u32x4_t w_ = {lo_.x, lo_.y, hi_.x, hi_.y}; *reinterpret_cast<bf16x8_t*>(&w_); })
      const float gam = gamS[pc];
      f32x4_t Un[4];
      { const int pn = pc + 1 < NCH ? pc + 1 : pc;
#pragma unroll
        for (int m = 0; m < 4; ++m)
#pragma unroll
          for (int j = 0; j < 4; ++j) Un[m][j] = up[(size_t)pn * 8192 + (m * 16 + j) * 128]; }
      bf16x8_t Sb[4];
#pragma unroll
      for (int ks = 0; ks < 4; ++ks) Sb[ks] = pack8(S[2 * ks], S[2 * ks + 1]);
      f32x4_t P[4], O[4];
#pragma unroll
      for (int m = 0; m < 4; ++m) { P[m] = (f32x4_t){0.f, 0.f, 0.f, 0.f}; O[m] = (f32x4_t){0.f, 0.f, 0.f, 0.f}; }
#pragma unroll
      for (int ks = 0; ks < 4; ++ks)
#pragma unroll
        for (int m = 0; m < 4; ++m) {
          const bf16x8_t aw = GS_AFRAG(GS_W, 272, m * 16 + fr, ks);
          const bf16x8_t aq = GS_AFRAG(GS_QH, 272, m * 16 + fr, ks);
          P[m] = __builtin_amdgcn_mfma_f32_16x16x32_bf16(aw, Sb[ks], P[m], 0, 0, 0);
          O[m] = __builtin_amdgcn_mfma_f32_16x16x32_bf16(aq, Sb[ks], O[m], 0, 0, 0);
        }
      f32x4_t Vn[4];
#pragma unroll
      for (int m = 0; m < 4; ++m) Vn[m] = U[m] - P[m];
      bf16x8_t Vb[2];
      Vb[0] = pack8(Vn[0], Vn[1]); Vb[1] = pack8(Vn[2], Vn[3]);
#pragma unroll
      for (int ks = 0; ks < 2; ++ks)
#pragma unroll
        for (int m = 0; m < 4; ++m) {
          const bf16x8_t a = GS_AFRAG(GS_QK, 144, m * 16 + fr, ks);
          O[m] = __builtin_amdgcn_mfma_f32_16x16x32_bf16(a, Vb[ks], O[m], 0, 0, 0);
        }
#pragma unroll
      for (int t = 0; t < 8; ++t) {
        S[t] = S[t] * gam;
#pragma unroll
        for (int ks = 0; ks < 2; ++ks) {
          const bf16x8_t a = GS_AFRAG(GS_KT, 144, t * 16 + fr, ks);
          S[t] = __builtin_amdgcn_mfma_f32_16x16x32_bf16(a, Vb[ks], S[t], 0, 0, 0);
        }
      }
#undef GS_AFRAG
#pragma unroll
      for (int m = 0; m < 4; ++m)
#pragma unroll
        for (int j = 0; j < 4; ++j) { const int pi = m * 16 + fq * 4 + j, tk = d ? 63 - pi : pi; ost[tk * 16 + fr] = O[m][j]; }
      const int rcn = d == 0 ? pc : (pc < 4 ? 3 - pc : 135 - pc);
      float* gop = GO + (size_t)rcn * 1024 + lane * 4;
#pragma unroll
      for (int i = 0; i < 4; ++i) *(f32x4_t*)(gop + i * 256) = *(const f32x4_t*)(ost + i * 256 + lane * 4);
#pragma unroll
      for (int m = 0; m < 4; ++m) U[m] = Un[m];
      __syncthreads();
    }
  } else {
    const int lt = tid - 256;
    int lo[14];
#pragma unroll
    for (int i = 0; i < 14; ++i) {
      const int q = lt + 256 * i;
      lo[i] = q < 1024 ? GS_W + (q >> 4) * 272 + (q & 15) * 16
            : q < 2048 ? GS_QH + ((q - 1024) >> 4) * 272 + (q & 15) * 16
            : q < 2560 ? GS_QK + ((q - 2048) >> 3) * 144 + (q & 7) * 16
                       : GS_KT + ((q - 2560) >> 3) * 144 + (q & 7) * 16;
    }
    u32x4_t R0[14], R1[14], R2[14];
#define GS_LOAD(R, pc) do { const int pc_ = (pc) < NCH ? (pc) : NCH - 1; const u32x4_t* s_ = (const u32x4_t*)(REC + (size_t)pc_ * GREC_BYTES) + lt; \
    _Pragma("unroll") for (int i = 0; i < 14; ++i) R[i] = s_[256 * i]; } while (0)
#define GS_WRITE(R, pc) do { unsigned char* B_ = smem + ((pc) & 1) * GS_BUF; \
    _Pragma("unroll") for (int i = 0; i < 14; ++i) *(u32x4_t*)(B_ + lo[i]) = R[i]; } while (0)
    GS_LOAD(R0, 0); GS_WRITE(R0, 0);
    GS_LOAD(R1, 1); GS_LOAD(R2, 2);
    __syncthreads();
#pragma unroll 1
    for (int pc = 0; pc < NCH; pc += 3) {
      GS_LOAD(R0, pc + 3); GS_WRITE(R1, pc + 1); __syncthreads();
      GS_LOAD(R1, pc + 4); GS_WRITE(R2, pc + 2); __syncthreads();
      GS_LOAD(R2, pc + 5); GS_WRITE(R0, pc + 3); __syncthreads();
    }
#undef GS_LOAD
#undef GS_WRITE
  }
}

__device__ __forceinline__ void phase_gdn_fin(const Params& p, int l, int rb, int re, int rstep) {
  const int tid = tidx(), lane = tid & 63, wid = tid >> 6;
  const float* GO = (const float*)(p.ws + WS_GO);
  const bf16_t* Z = (const bf16_t*)(p.ws + WS_Z); bf16_t* MIX = (bf16_t*)(p.ws + WS_MIX);
  const int c0 = lane * 8;
  float on[8];
#pragma unroll
  for (int e = 0; e < 8; ++e) on[e] = p.onorm_b[l * 128 + (c0 & 127) + e];
  for (int r = rb + wid; r < re; r += rstep) {
    if (l == NL - 1 && r < TC) continue;
    const int hh = lane >> 4, sl = (lane >> 1) & 7, off = (lane & 1) * 8;
    const float* g0 = GO + ((size_t)((0 * 4 + hh) * 8 + sl) * TA + r) * 16 + off;
    const float* g1 = GO + ((size_t)((1 * 4 + hh) * 8 + sl) * TA + r) * 16 + off;
    const float4 a0 = *(const float4*)g0, a1 = *(const float4*)(g0 + 4);
    const float4 b0 = *(const float4*)g1, b1 = *(const float4*)(g1 + 4);
    float v[8] = {a0.x + b0.x, a0.y + b0.y, a0.z + b0.z, a0.w + b0.w, a1.x + b1.x, a1.y + b1.y, a1.z + b1.z, a1.w + b1.w};
    float ss = 0.f;
#pragma unroll
    for (int e = 0; e < 8; ++e) ss += v[e] * v[e];
    ss += __shfl_xor(ss, 1); ss += __shfl_xor(ss, 2); ss += __shfl_xor(ss, 4); ss += __shfl_xor(ss, 8);
    const float rstd = rsqrtf(ss * (1.f / 128.f) + 1e-6f);
    const bf16x8_t gv = *(const bf16x8_t*)(Z + (size_t)r * ZLD + ZC_GB + c0);
    float f[8];
#pragma unroll
    for (int e = 0; e < 8; ++e) f[e] = v[e] * rstd * on[e] * siluf_(bf2f((bf16_t)gv[e]));
    u32x4_t w = {cvtpk2(f[0], f[1]), cvtpk2(f[2], f[3]), cvtpk2(f[4], f[5]), cvtpk2(f[6], f[7])};
    *(u32x4_t*)(MIX + (size_t)r * DM + 512 + c0) = w;
  }
}

constexpr int ATT_ITEMS = 512;
__device__ __forceinline__ void attn_item(const Params& p, int it, unsigned char* smem) {
  const bf16_t* QB = (const bf16_t*)(p.ws + WS_QB); const bf16_t* KB = (const bf16_t*)(p.ws + WS_KB); const bf16_t* VB = (const bf16_t*)(p.ws + WS_VB);
  int head, r0, seq, k0, split;
  if (it < ATT_ITEMS) { const int half = it >> 8, idx = it & 255; split = half * 3; head = idx >> 5; r0 = TC + (idx & 31) * 256; seq = half ? 44 * 64 : 88 * 64; k0 = half ? 88 * 64 : 0; }
  else { split = 0; head = it - ATT_ITEMS; r0 = 0; seq = TC; k0 = 0; }
  const int kvh = head >> 2;
  bf16_t* OUT = (bf16_t*)(p.ws + WS_PO) + ((size_t)split * TA + r0) * 1024 + head * 128;
  float* ML = (float*)(p.ws + WS_ML) + (((size_t)split * TA + r0) * 8 + head) * 2;
  __syncthreads();
  att::attn_dense_body(QB + (size_t)r0 * 1024 + head * 128, KB + (size_t)k0 * 256 + kvh * 128, VB + (size_t)k0 * 256 + kvh * 128, ML, OUT, seq, (char*)smem);
}
__device__ void attn_queue(const Params& p, int l, unsigned char* smem) {
  unsigned* ctr = (unsigned*)(p.ws + WS_CTR) + l;
  volatile int* slot = (volatile int*)(smem + 144000);
  for (;;) {
    __syncthreads();
    if (tidx() == 0) *slot = (int)atomicAdd(ctr, 1u);
    __syncthreads();
    const int it = *slot;
    if (it >= ATT_ITEMS) break;
    attn_item(p, it, smem);
  }
}

__device__ __forceinline__ void phase_attn_gate(const Params& p, int l, int rb, int re, int rstep) {
  const int tid = tidx(), lane = tid & 63, wid = tid >> 6;
  const bf16_t* Z = (const bf16_t*)(p.ws + WS_Z); bf16_t* MIX = (bf16_t*)(p.ws + WS_MIX); const bf16_t* PO = (const bf16_t*)(p.ws + WS_PO);
  const float* ML = (const float*)(p.ws + WS_ML);
  constexpr float C = 0.088388347648318440f * 1.4426950408889634f;
  for (int r = rb + wid; r < re; r += rstep) {
    if (l == NL - 1 && r < TC) continue;
#pragma unroll
    for (int hlf = 0; hlf < 2; ++hlf) {
      const int c0 = hlf * 512 + lane * 8, head = c0 >> 7;
      const bf16x8_t gv = *(const bf16x8_t*)(Z + (size_t)r * ZLD + ZC_GC + c0);
      float f[8];
      if (r >= TC) {
        float2 st[NSPLIT]; float mm = -3.0e38f;
#pragma unroll
        for (int k = 0; k < NSPLIT; ++k) { const bool use = k % 3 == 0;
          st[k] = use ? *(const float2*)(ML + (((size_t)k * TA + r) * 8 + head) * 2) : make_float2(-3.0e38f, 0.f); mm = fmaxf(mm, st[k].x); }
        float wsum = 0.f;
#pragma unroll
        for (int e = 0; e < 8; ++e) f[e] = 0.f;
#pragma unroll
        for (int k = 0; k < NSPLIT; ++k) {
          if (k % 3 == 0) {
            const float w = st[k].y * exp2f((st[k].x - mm) * C); wsum += w;
            const bf16x8_t ov = *(const bf16x8_t*)(PO + ((size_t)k * TA + r) * 1024 + c0);
#pragma unroll
            for (int e = 0; e < 8; ++e) f[e] += bf2f((bf16_t)ov[e]) * w;
          }
        }
        const float inv = 1.f / wsum;
#pragma unroll
        for (int e = 0; e < 8; ++e) f[e] *= inv * siluf_(bf2f((bf16_t)gv[e]));
      } else {
        const bf16x8_t ov = *(const bf16x8_t*)(PO + (size_t)r * 1024 + c0);
#pragma unroll
        for (int e = 0; e < 8; ++e) f[e] = bf2f((bf16_t)ov[e]) * siluf_(bf2f((bf16_t)gv[e]));
      }
      u32x4_t w = {cvtpk2(f[0], f[1]), cvtpk2(f[2], f[3]), cvtpk2(f[4], f[5]), cvtpk2(f[6], f[7])};
      *(u32x4_t*)(MIX + (size_t)r * DM + 1024 + c0) = w;
    }
  }
}

template <int S>
__device__ __forceinline__ void run_phase(const Params& p0, int l, unsigned char* smem) {
  Params p = p0;
  { unsigned long long w_ = (unsigned long long)p.ws; asm volatile("" : "+s"(w_)); p.ws = (unsigned char*)w_; }
  const int bid = bidx();
  if constexpr (S == 0) phase_prep0(p, smem);
  else if constexpr (S == 1) phase_norm(p, l);
  else if constexpr (S == 2) {
    pg8::Gemm g; g.A = (const bf16_t*)(p.ws + WS_XN); g.Bt = (const bf16_t*)(p.ws + WS_WIN) + (size_t)l * ZLD * DM; g.M = TA; g.N = ZLD; g.K = DM; g.ld = DM;
    pg8::StaticOrder So; So.init(g.M, g.N, (int)gridDim.x, bid);
    pg8::EpiZ E; E.O = (bf16_t*)(p.ws + WS_Z); E.ldc = ZLD;
    pg8::gemm_phase<pg8::EpiZ, pg8::StaticOrder, false>((PG8_LAS unsigned char*)smem, g, So, E, nullptr);
  } else if constexpr (S == 3) {
    phase_qkprep(p, l);
    {
      unsigned* ctr = (unsigned*)(p.ws + WS_CTR) + 16 + l;
      volatile int* slot = (volatile int*)(smem + 144000);
      for (;;) {
        __syncthreads();
        if (tidx() == 0) *slot = (int)atomicAdd(ctr, 1u);
        __syncthreads();
        const int it = *slot;
        if (it >= NCH * 4 + NCH * 8) break;
        if (it < NCH * 4) gdn_local_item(p, l, it, smem); else lru_ab_item(p, l, it - NCH * 4, smem);
      }
    }
  }
  else if constexpr (S == 4) {
    if (bid < 16) gdn_scan(p, smem, bid & 7, bid >> 3);
    else if (bid < 18) lru_carry(p, bid - 16);
    else if (bid < 26) { if (l != NL - 1) attn_item(p, ATT_ITEMS + bid - 18, smem); }
    attn_queue(p, l, smem);
    if (l + 1 < NL) convert_queue(p, l + 1, smem);
  }
  else if constexpr (S == 5) { }
  else if constexpr (S == 6) {
    unsigned* ctr = (unsigned*)(p.ws + WS_CTR) + 24 + l;
    volatile int* slot = (volatile int*)(smem + 144000);
    const int first = (l == NL - 1) ? 4 : 0;
    for (;;) {
      __syncthreads();
      if (tidx() == 0) *slot = (int)atomicAdd(ctr, 1u);
      __syncthreads();
      const int it = *slot + first;
      if (it >= NCH + TA / 32) break;
      if (it < NCH) lru_fin_item(p, l, it);
      else { const int r0 = (it - NCH) * 32; if (l == NL - 1 && r0 < TC) continue; phase_gdn_fin(p, l, r0, r0 + 32, 8); phase_attn_gate(p, l, r0, r0 + 32, 8); }
    }
  }
  else if constexpr (S == 7) {
    const bool last = (l == NL - 1);
    const float* mod = (const float*)(p.ws + WS_MOD) + (size_t)l * 2 * 6144;
    {
      pg8::Gemm g; g.A = (const bf16_t*)(p.ws + WS_MIX) + (size_t)TC * DM; g.Bt = (const bf16_t*)(p.ws + WS_WOUT) + (size_t)l * DM * DM;
      g.M = TL; g.N = DM; g.K = DM; g.ld = DM;
      pg8::StaticOrder So; So.init(g.M, g.N, (int)gridDim.x, bid);
      pg8::EpiRes E; E.H = (float*)(p.ws + WS_H); E.gate_lat = mod + 4096; E.gate_ctx = mod + 6144 + 4096; E.row_off = TC;
      pg8::gemm_phase<pg8::EpiRes, pg8::StaticOrder, false>((PG8_LAS unsigned char*)smem, g, So, E, nullptr);
    }
    if (!last) {
      const int G_ = (int)gridDim.x;
#pragma unroll 1
      for (int kq = 0; kq < 4; ++kq) {
        pg8::Gemm g; g.A = (const bf16_t*)(p.ws + WS_MIX) + kq * 512; g.Bt = (const bf16_t*)(p.ws + WS_WOUT) + (size_t)l * DM * DM + kq * 512;
        g.M = TC; g.N = DM; g.K = 512; g.ld = DM;
        pg8::StaticOrder So; So.init(g.M, g.N, G_, (bid - 8 * kq - 8 + 2 * G_) % G_);
        pg8::EpiResAtomic E; E.H = (float*)(p.ws + WS_H); E.gate = mod + 6144 + 4096;
        pg8::gemm_phase<pg8::EpiResAtomic, pg8::StaticOrder, false>((PG8_LAS unsigned char*)smem, g, So, E, nullptr);
      }
    }
  } else phase_final(p);
}

#ifdef MK_MULTI
template <int S>
__global__ __launch_bounds__(512, 2) void k_phase(Params p, int l) {
  extern __shared__ __attribute__((aligned(16))) unsigned char smem[];
  run_phase<S>(p, l, smem);
}
#else
__global__ __launch_bounds__(512, 2) void hybrid_fwd(Params p) {
  extern __shared__ __attribute__((aligned(16))) unsigned char smem[];
  cg::grid_group grid = cg::this_grid();
  volatile LAS unsigned* xst = (volatile LAS unsigned*)(smem + (LDS_BYTES - 16));
  if (threadIdx.x == 0) { xst[0] = 0u; xst[1] = 0u; }
  __syncthreads();
  const XcdBarrier xb = xcd_barrier_post((unsigned*)(p.ws + WS_BAR), xst);
#define GSYNC() xcd_barrier(xb)
  run_phase<0>(p, 0, smem); grid.sync();
#ifndef REP1
#define REP1 1
#endif
#ifndef REP2
#define REP2 1
#endif
#ifndef REP3
#define REP3 1
#endif
#ifndef REP4
#define REP4 1
#endif
#ifndef REP5
#define REP5 1
#endif
#ifndef REP6
#define REP6 1
#endif
#ifndef REPSYNC
#define REPSYNC 0
#endif
#pragma unroll 1
  for (int l = 0; l < NL; ++l) {
#pragma unroll 1
    for (int r = 0; r < REP1; ++r) { run_phase<1>(p, l, smem); GSYNC(); }
#pragma unroll 1
    for (int r = 0; r < REP2; ++r) { run_phase<2>(p, l, smem); GSYNC(); }
#pragma unroll 1
    for (int r = 0; r < REP3; ++r) { run_phase<3>(p, l, smem); GSYNC(); }
#pragma unroll 1
    for (int r = 0; r < REP4; ++r) { run_phase<4>(p, l, smem); GSYNC(); }
#pragma unroll 1
    for (int r = 0; r < REP6; ++r) { run_phase<6>(p, l, smem); GSYNC(); }
#pragma unroll 1
    for (int r = 0; r < REPSYNC; ++r) GSYNC();
    run_phase<7>(p, l, smem); GSYNC();
  }
  run_phase<8>(p, 0, smem);
}
#endif

template <class K> static bool set_lds(K k) { return hipFuncSetAttribute((const void*)k, hipFuncAttributeMaxDynamicSharedMemorySize, LDS_BYTES) == hipSuccess; }

extern "C" void kernel_launch(void* const* d_in, const int* in_sizes, int n_in, void* d_out, int out_size, void* d_ws, size_t ws_size, hipStream_t stream) {
  static int grid = 0;
  if (grid == 0) {
    if (n_in != 23 || out_size != TL * DM || ws_size < WS_END) { fprintf(stderr, "kernel_launch: unexpected shapes (n_in %d out %d ws %zu need %zu)\n", n_in, out_size, ws_size, (size_t)WS_END); grid = -1; return; }
    int dev = 0, cus = 0;
    (void)hipGetDevice(&dev); (void)hipDeviceGetAttribute(&cus, hipDeviceAttributeMultiprocessorCount, dev);
    bool ok = true;
#ifdef MK_MULTI
    ok = ok && set_lds(k_phase<0>) && set_lds(k_phase<1>) && set_lds(k_phase<2>) && set_lds(k_phase<3>) && set_lds(k_phase<4>) && set_lds(k_phase<5>) && set_lds(k_phase<6>) && set_lds(k_phase<7>) && set_lds(k_phase<8>);
#else
    ok = ok && set_lds(hybrid_fwd);
    int per_cu = 0; (void)hipOccupancyMaxActiveBlocksPerMultiprocessor(&per_cu, (const void*)hybrid_fwd, 512, LDS_BYTES); (void)hipGetLastError();
    if (per_cu < 1) fprintf(stderr, "kernel_launch: occupancy query says %d blocks per CU\n", per_cu);
#endif
    if (!ok) { fprintf(stderr, "kernel_launch: hipFuncSetAttribute failed\n"); grid = -1; return; }
    grid = cus > 0 ? cus : 256;
  }
  if (grid < 0) return;
  Params p{};
  const float** pp = (const float**)&p;
  for (int i = 0; i < 23; ++i) pp[i] = (const float*)d_in[i];
  p.out = (float*)d_out; p.ws = (unsigned char*)d_ws;
#ifdef MK_MULTI
#define LAUNCH(S, l) hipLaunchKernelGGL(k_phase<S>, dim3(grid), dim3(512), LDS_BYTES, stream, p, l)
  LAUNCH(0, 0);
  for (int l = 0; l < NL; ++l) { LAUNCH(1, l); LAUNCH(2, l); LAUNCH(3, l); LAUNCH(4, l); LAUNCH(6, l); LAUNCH(7, l); }
  LAUNCH(8, 0);
#else
  (void)hipMemsetAsync((unsigned char*)d_ws + WS_CTR, 0, 256 + 16384, stream);
  void* args[] = {&p};
  hipError_t e = hipLaunchCooperativeKernel((const void*)hybrid_fwd, dim3(grid), dim3(512), args, LDS_BYTES, stream);
  if (e != hipSuccess) fprintf(stderr, "cooperative launch failed: %s (grid %d)\n", hipGetErrorString(e), grid);
#endif
}
```

```cpp
#include <hip/hip_runtime.h>
#include <hip/hip_cooperative_groups.h>
#include <cstdio>
namespace cg = cooperative_groups;

typedef unsigned short bf16_t;
typedef short bf16x8_t __attribute__((ext_vector_type(8)));
typedef float f32x4_t __attribute__((ext_vector_type(4)));
typedef unsigned u32x4_t __attribute__((ext_vector_type(4)));
typedef unsigned u32x2_t __attribute__((ext_vector_type(2)));

constexpr int DM = 2048, TL = 8192, TC = 256, TA = 8448, NL = 4;
constexpr int DIN = 5648, ZLD = 5888, NCH = 132;
constexpr int ZC_XA = 0, ZC_GA = 512, ZC_QKVB = 1024, ZC_GB = 2560, ZC_QC = 3072, ZC_KC = 4096, ZC_VC = 4352, ZC_GC = 4608, ZC_BETA = 5632, ZC_ALPHA = 5640;
constexpr int LDS_BYTES = 147456;

constexpr size_t al256(size_t x) { return (x + 255) / 256 * 256; }
constexpr size_t WS_H    = 0;
constexpr size_t WS_XN   = WS_H    + al256((size_t)TA * DM * 4);
constexpr size_t WS_Z    = WS_XN   + al256((size_t)TA * DM * 2);
constexpr size_t WS_MIX  = WS_Z    + al256((size_t)TA * ZLD * 2);
constexpr size_t WS_QB   = WS_MIX  + al256((size_t)TA * DM * 2);
constexpr size_t WS_KB   = WS_QB   + al256((size_t)TA * 1024 * 2);
constexpr size_t WS_VB   = WS_KB   + al256((size_t)TA * 256 * 2);
constexpr size_t WS_WIN  = WS_VB   + al256((size_t)TA * 256 * 2);
constexpr size_t WS_WOUT = WS_WIN  + al256((size_t)NL * ZLD * DM * 2);
constexpr size_t WS_MOD  = WS_WOUT + al256((size_t)NL * DM * DM * 2);
constexpr size_t WS_WG   = WS_MOD  + al256((size_t)NL * 2 * 6144 * 4);
constexpr size_t WS_LA   = WS_WG   + al256((size_t)NL * 2 * 2 * 8 * 4096 * 2);
constexpr size_t WS_LB   = WS_LA   + al256((size_t)2 * TA * 512 * 4);
constexpr size_t WS_LSEG = WS_LB   + al256((size_t)2 * TA * 512 * 4);
constexpr size_t WS_LCAR = WS_LSEG + al256((size_t)2 * NCH * 512 * 2 * 4);
constexpr size_t GREC_BYTES = 57344;
constexpr size_t WS_GREC = WS_LCAR + al256((size_t)2 * NCH * 512 * 4);
constexpr size_t WS_GU   = WS_GREC + al256((size_t)8 * NCH * GREC_BYTES);
constexpr size_t WS_GGL  = WS_GU   + al256((size_t)8 * NCH * 8192 * 4);
constexpr size_t WS_GO   = WS_GGL  + al256((size_t)8 * NCH * 4);
constexpr int NSPLIT = 6, SPLIT_KEYS = TA / NSPLIT;
constexpr size_t WS_PO   = WS_GO   + al256((size_t)2 * TA * 512 * 4);
constexpr size_t WS_ML   = WS_PO   + al256((size_t)NSPLIT * TA * 1024 * 2);
constexpr size_t WS_CTR  = WS_ML   + al256((size_t)NSPLIT * TA * 16 * 4);
constexpr size_t WS_BAR  = WS_CTR  + 256;
constexpr size_t WS_END  = WS_BAR  + 16384;

struct Params {
  const float *x, *c, *ctx, *c_ctx, *norm_g, *w_mod, *b_mod, *w_in, *conv_a_w, *conv_a_b, *w_ra, *b_ra, *w_ia, *b_ia, *lam_a,
              *conv_b_w, *a_log_b, *dt_bias_b, *onorm_b, *qn_c, *kn_c, *w_out, *final_g;
  float* out; unsigned char* ws;
};

__device__ __forceinline__ unsigned cvtpk2(float lo, float hi) { unsigned r; asm volatile("v_cvt_pk_bf16_f32 %0, %1, %2" : "=v"(r) : "v"(lo), "v"(hi)); return r; }
__device__ __forceinline__ bf16_t f2bf(float x) { return (bf16_t)(cvtpk2(x, 0.f) & 0xffffu); }
__device__ __forceinline__ float bf2f(bf16_t b) { return __uint_as_float(((unsigned)b) << 16); }
__device__ __forceinline__ float fexp_(float x) { return __builtin_amdgcn_exp2f(x * 1.4426950408889634f); }
__device__ __forceinline__ float sigmoidf_(float x) { return __builtin_amdgcn_rcpf(1.f + fexp_(-x)); }
__device__ __forceinline__ float siluf_(float x) { return x * __builtin_amdgcn_rcpf(1.f + fexp_(-x)); }
__device__ __forceinline__ float softplusf_(float x) { return fmaxf(x, 0.f) + log1pf(expf(-fabsf(x))); }
__device__ __forceinline__ float wave_sum(float v) {
#pragma unroll
  for (int o = 32; o >= 1; o >>= 1) v += __shfl_xor(v, o);
  return v;
}
__device__ __forceinline__ bf16x8_t pack8(f32x4_t a, f32x4_t b) {
  u32x4_t w = {cvtpk2(a[0], a[1]), cvtpk2(a[2], a[3]), cvtpk2(b[0], b[1]), cvtpk2(b[2], b[3])};
  return *reinterpret_cast<bf16x8_t*>(&w);
}

__device__ __forceinline__ int tidx() { int t = (int)__builtin_amdgcn_workitem_id_x(); asm volatile("" : "+v"(t)); return t; }
__device__ __forceinline__ int bidx() { int b = (int)__builtin_amdgcn_workgroup_id_x(); asm volatile("" : "+s"(b)); return b; }
namespace pg8 {
#define PG8_LAS __attribute__((address_space(3)))
typedef unsigned short bf16_t;
typedef short bf16x8 __attribute__((ext_vector_type(8)));
typedef float f32x4 __attribute__((ext_vector_type(4)));
typedef unsigned u32x4 __attribute__((ext_vector_type(4)));
constexpr int BM = 256, BK = 64, HALF = 128, HTB = HALF * BK * 2  , STAGE_BYTES = 8 * HTB, NXCD = 8, WGM = 8;

__host__ __device__ __forceinline__ int lds_byte(int r, int c) { const int st = (r >> 4) * 2 + (c >> 5), rr = r & 15, cc = c & 31, ob = rr * 64 + cc * 2; return st * 1024 + (ob ^ (((ob >> 9) & 1) << 5)); }
__host__ __device__ __forceinline__ void stage_rc(int b, int& R, int& C) { const int st = b / 1024, sb = b % 1024, swz = sb ^ (((sb >> 9) & 1) << 5); R = (st >> 1) * 16 + swz / 64; C = (st & 1) * 32 + (swz % 64) / 2; }
__host__ __device__ __forceinline__ int perm32(int rho) { const int n = rho >> 4, i = rho & 15; return 8 * (i >> 2) + 4 * n + (i & 3); }

struct Unit { int pm, pn; };
struct Gemm { const bf16_t* A; const bf16_t* Bt; int M, N, K, ld; };

struct StaticOrder {
    int nM, nN, nwg, G, c;
    __host__ __device__ void init(int M, int N, int G_, int c_) { nM = M / BM; nN = N / BM; nwg = nM * nN; G = G_; c = c_; }
    __host__ __device__ bool next(int i, Unit& u) const {
        const long L = (long)i * G + c; if (L >= nwg) return false;
        int wgid = (int)L; { const int q = nwg / NXCD, r = nwg % NXCD, xcd = wgid % NXCD, off = wgid / NXCD; wgid = (xcd < r ? xcd * (q + 1) : r * (q + 1) + (xcd - r) * q) + off; }
        const int nig = WGM * nN, gid = wgid / nig, fm = gid * WGM, gsz = (nM - fm) < WGM ? (nM - fm) : WGM;
        u.pm = fm + ((wgid % nig) % gsz); u.pn = (wgid % nig) / gsz; return true;
    }
    __device__ __forceinline__ void a_ready(const Unit&) const {}
    __device__ __forceinline__ void done(const Unit&) const {}
};
__device__ __forceinline__ unsigned cvt_pk_bf16(float lo, float hi) { unsigned r; asm volatile("v_cvt_pk_bf16_f32 %0, %1, %2" : "=v"(r) : "v"(lo), "v"(hi)); return r; }
template <class Epi, class Sched, bool STAMP = false>
__device__ __forceinline__ void gemm_phase(PG8_LAS unsigned char* lds, const Gemm g, const Sched& S, const Epi& E, unsigned long long* stamps) {
    const int tid = tidx(), wid = __builtin_amdgcn_readfirstlane(tid >> 6), lane = tid & 63, wr = wid >> 2, wc = wid & 3, fr = lane & 15, fq = lane >> 4;
    const int K = g.K, nt = K / BK;
    int ts_lo = 0, ts_hi = 0, nts = 0; const unsigned long long rt_entry = STAMP ? (unsigned long long)wall_clock64() : 0ull;
#define PG8_STAMP() do { if (STAMP && wid == 0 && nts < 64) { const unsigned long long _c = (unsigned long long)clock64(); \
        ts_lo = (lane == nts) ? (int)(unsigned)_c : ts_lo; ts_hi = (lane == nts) ? (int)(unsigned)(_c >> 32) : ts_hi; ++nts; } } while (0)
    PG8_STAMP();
    unsigned voffA[2], voffB[2];
#pragma unroll
    for (int i = 0; i < 2; ++i) { int R, C; stage_rc(tid * 16 + i * 8192, R, C); const int Rb = Epi::PERM ? ((R & ~31) + perm32(R & 31)) : R;
        voffA[i] = (unsigned)(R * g.ld + C) * 2u; voffB[i] = (unsigned)(Rb * g.ld + C) * 2u; }
    const size_t kstep = (size_t)(BK * 2);
    const size_t hstep = (size_t)HALF * g.ld * 2;
    const size_t tstep = 2 * hstep;
    const unsigned ldsw = (unsigned)wid * 1024u;
    const int aoff = lds_byte(wr * 64 + fr, fq * 8), boff = lds_byte(wc * 32 + fr, fq * 8);
#define PG8_SA(b, h) (((b) * 2 + (h)) * HTB)
#define PG8_SB(b, h) ((4 + (b) * 2 + (h)) * HTB)
#define PG8_STAGE(bufoff, gbase, voff) do { _Pragma("unroll") for (int _i = 0; _i < 2; ++_i) \
        __builtin_amdgcn_global_load_lds((const unsigned*)((const char*)(gbase) + (voff)[_i]), (PG8_LAS unsigned*)(lds + (bufoff) + ldsw + _i * 8192), 16, 0, 0); } while (0)
#define PG8_LDA(dst, b, h) do { _Pragma("unroll") for (int m = 0; m < 4; ++m) _Pragma("unroll") for (int k = 0; k < 2; ++k) dst[m][k] = *(const PG8_LAS bf16x8*)(lds + PG8_SA(b, h) + aoff + m * 2048 + k * 1024); } while (0)
#define PG8_LDB(dst, b, h) do { _Pragma("unroll") for (int n = 0; n < 2; ++n) _Pragma("unroll") for (int k = 0; k < 2; ++k) dst[n][k] = *(const PG8_LAS bf16x8*)(lds + PG8_SB(b, h) + boff + n * 2048 + k * 1024); } while (0)
#define PG8_MMA(ai, bj, At, Bt) do { __builtin_amdgcn_s_setprio(1); _Pragma("unroll") for (int m = 0; m < 4; ++m) _Pragma("unroll") for (int n = 0; n < 2; ++n) _Pragma("unroll") for (int k = 0; k < 2; ++k) \
        acc[ai][bj][m][n] = __builtin_amdgcn_mfma_f32_16x16x32_bf16(Bt[n][k], At[m][k], acc[ai][bj][m][n], 0, 0, 0); __builtin_amdgcn_s_setprio(0); } while (0)
#define PG8_WAIT_V(n) asm volatile("s_waitcnt vmcnt(" #n ")" ::: "memory")
#define PG8_WAIT_L(n) asm volatile("s_waitcnt lgkmcnt(" #n ")" ::: "memory")
#define PG8_BAR __builtin_amdgcn_s_barrier()
#define PG8_SCHED __builtin_amdgcn_sched_barrier(0)
    Unit cur, nxt; int ui = 0;
    if (!S.next(0, cur)) return;
    f32x4 acc[2][2][4][2];
#pragma unroll
    for (int a = 0; a < 2; ++a)
#pragma unroll
        for (int b = 0; b < 2; ++b)
#pragma unroll
            for (int m = 0; m < 4; ++m)
#pragma unroll
                for (int n = 0; n < 2; ++n) acc[a][b][m][n] = (f32x4){0.f, 0.f, 0.f, 0.f};
    bf16x8 At[4][2], B0[2][2], B1[2][2];
    const char* cA = (const char*)g.A + (size_t)cur.pm * tstep; const char* cB = (const char*)g.Bt + (size_t)cur.pn * tstep;
    S.a_ready(cur);
    PG8_STAGE(PG8_SB(0, 0), cB, voffB); PG8_STAGE(PG8_SA(0, 0), cA, voffA); PG8_STAGE(PG8_SB(0, 1), cB + hstep, voffB); PG8_STAGE(PG8_SA(0, 1), cA + hstep, voffA);
    if (wr == 1) PG8_BAR;
    PG8_WAIT_V(4); PG8_BAR;
    PG8_STAGE(PG8_SB(1, 0), cB + kstep, voffB); PG8_STAGE(PG8_SA(1, 0), cA + kstep, voffA); PG8_STAGE(PG8_SB(1, 1), cB + hstep + kstep, voffB);
    PG8_WAIT_V(6); PG8_BAR;
    PG8_STAMP();
    for (;;) {
        const bool has_next = S.next(ui + 1, nxt);
        const char* nA = has_next ? (const char*)g.A + (size_t)nxt.pm * tstep : cA; const char* nB = has_next ? (const char*)g.Bt + (size_t)nxt.pn * tstep : cB;
        for (int t = 0; t < nt; t += 2) {
            const bool last = (t == nt - 2);
            const char* a1 = cA + (size_t)(t + 1) * kstep;
            const char* a2 = last ? nA : cA + (size_t)(t + 2) * kstep; const char* b2 = last ? nB : cB + (size_t)(t + 2) * kstep;
            const char* a3 = a2 + kstep; const char* b3 = b2 + kstep;
            if (last && has_next) S.a_ready(nxt);
            PG8_LDB(B0, 0, 0); PG8_SCHED; PG8_LDA(At, 0, 0); PG8_STAGE(PG8_SA(1, 1), a1 + hstep, voffA);
            PG8_WAIT_L(8); PG8_BAR; PG8_WAIT_L(0); PG8_MMA(0, 0, At, B0); PG8_BAR; PG8_SCHED;
            PG8_LDB(B1, 0, 1); PG8_STAGE(PG8_SB(0, 0), b2, voffB);
            PG8_BAR; PG8_WAIT_L(0); PG8_MMA(0, 1, At, B1); PG8_BAR;
            PG8_LDA(At, 0, 1); PG8_STAGE(PG8_SA(0, 0), a2, voffA);
            PG8_BAR; PG8_WAIT_L(0); PG8_MMA(1, 0, At, B0); PG8_BAR; PG8_SCHED;
            PG8_STAGE(PG8_SB(0, 1), b2 + hstep, voffB);
            PG8_WAIT_V(6); PG8_BAR; PG8_MMA(1, 1, At, B1); PG8_BAR;
            PG8_LDB(B0, 1, 0); PG8_SCHED; PG8_LDA(At, 1, 0); PG8_STAGE(PG8_SA(0, 1), a2 + hstep, voffA);
            PG8_WAIT_L(8); PG8_BAR; PG8_WAIT_L(0); PG8_MMA(0, 0, At, B0); PG8_BAR; PG8_SCHED;
            PG8_LDB(B1, 1, 1); PG8_STAGE(PG8_SB(1, 0), b3, voffB);
            PG8_BAR; PG8_WAIT_L(0); PG8_MMA(0, 1, At, B1); PG8_BAR;
            PG8_LDA(At, 1, 1); PG8_STAGE(PG8_SA(1, 0), a3, voffA);
            PG8_BAR; PG8_WAIT_L(0); PG8_MMA(1, 0, At, B0); PG8_BAR; PG8_SCHED;
            PG8_STAGE(PG8_SB(1, 1), b3 + hstep, voffB);
            PG8_WAIT_V(6); PG8_BAR; PG8_MMA(1, 1, At, B1); PG8_BAR;
        }
        PG8_STAMP();
        if constexpr (!Epi::AFTER_DRAIN) { E(acc, cur, wr, wc, fr, fq); S.done(cur); }
        PG8_STAMP();
        if (!has_next) break;
#pragma unroll
        for (int a = 0; a < 2; ++a)
#pragma unroll
            for (int b = 0; b < 2; ++b)
#pragma unroll
                for (int m = 0; m < 4; ++m)
#pragma unroll
                    for (int n = 0; n < 2; ++n) acc[a][b][m][n] = (f32x4){0.f, 0.f, 0.f, 0.f};
        cur = nxt; cA = nA; cB = nB; ++ui;
    }
    PG8_WAIT_V(0);
    if (wr == 0) PG8_BAR;
    PG8_BAR;
    if constexpr (Epi::AFTER_DRAIN) { E.fused(acc, cur, wr, wc, fr, fq, lds, wid, lane); S.done(cur); }
    PG8_STAMP();
    if (STAMP && wid == 0) { stamps[lane] = lane < nts ? (((unsigned long long)(unsigned)ts_hi << 32) | (unsigned)ts_lo) : 0ull;
        if (lane == 62) stamps[62] = rt_entry; if (lane == 63) stamps[63] = (unsigned long long)wall_clock64(); }
#undef PG8_STAMP
#undef PG8_SA
#undef PG8_SB
#undef PG8_STAGE
#undef PG8_LDA
#undef PG8_LDB
#undef PG8_MMA
#undef PG8_WAIT_V
#undef PG8_WAIT_L
#undef PG8_BAR
#undef PG8_SCHED
}
}
#define XB_TMO      128
#define XB_XCNT(j)  (256  + 64 * (j))
#define XB_XSUB(j)  (1280 + 64 * (j))
#define XB_XGEN(j)  (2304 + 64 * (j))
#define XB_TOP      3328
#define XB_TOPGEN   3392
#define XCD_BAR_WORDS 3456
#define XB_SPIN_CAP (1u << 18)
#define LAS __attribute__((address_space(3)))

__device__ __forceinline__ unsigned xb_ld(unsigned* p)              { return __hip_atomic_load(p, __ATOMIC_RELAXED, __HIP_MEMORY_SCOPE_AGENT); }
__device__ __forceinline__ unsigned xb_add(unsigned* p, unsigned v) { return __hip_atomic_fetch_add(p, v, __ATOMIC_RELAXED, __HIP_MEMORY_SCOPE_AGENT); }
__device__ __forceinline__ unsigned xb_xcc_id() { return (unsigned)__builtin_amdgcn_s_getreg((3 << 11) | 20) & 0xFu; }
#define XB_SPIN(cond, bar) do { unsigned _sp = 0; while (cond) { __builtin_amdgcn_s_sleep(1); \
    if ((++_sp & 255u) == 0u) { if (xb_ld(&(bar)[XB_TMO])) break; if (_sp > XB_SPIN_CAP) { atomicAdd(&(bar)[XB_TMO], 1u); break; } } } } while (0)

struct XcdBarrier {
    unsigned* bar; unsigned x;
    volatile LAS unsigned* st;
};

__device__ __forceinline__ XcdBarrier xcd_barrier_post(unsigned* bar, volatile LAS unsigned* st) {
    XcdBarrier b; b.bar = bar; b.x = xb_xcc_id(); b.st = st;
    if (threadIdx.x == 0) (void)xb_add(&bar[XB_XCNT(b.x)], 1u);
    return b;
}
__device__ __forceinline__ void xcd_barrier_complete(unsigned* bar, unsigned x, unsigned& nloc, unsigned& nx) {
    const unsigned G = gridDim.x * gridDim.y * gridDim.z;
    unsigned sum, cnt, mine, sp = 0u;
    for (;;) {
        sum = 0u; cnt = 0u; mine = 0u;
#pragma unroll
        for (unsigned j = 0; j < 16; ++j) { const unsigned c = xb_ld(&bar[XB_XCNT(j)]); sum += c; cnt += (c > 0u) ? 1u : 0u; mine = (j == x) ? c : mine; }
        if (sum == G) break;
        __builtin_amdgcn_s_sleep(1);
        if ((++sp & 255u) == 0u) { if (xb_ld(&bar[XB_TMO])) break; if (sp > XB_SPIN_CAP) { atomicAdd(&bar[XB_TMO], 1u); break; } }
    }
    nloc = mine > 0u ? mine : 1u; nx = cnt > 0u ? cnt : 1u;
}

__device__ __forceinline__ void xcd_barrier(const XcdBarrier& b) {
    asm volatile("s_waitcnt vmcnt(0)" ::: "memory");
    __syncthreads();
    if (threadIdx.x == 0) {
        unsigned* bar = b.bar;
        __builtin_amdgcn_s_waitcnt(0);
        unsigned nloc = b.st[0], nx = b.st[1];
        if (nloc == 0u) { xcd_barrier_complete(bar, b.x, nloc, nx); b.st[0] = nloc; b.st[1] = nx; }
        const unsigned old = xb_add(&bar[XB_XSUB(b.x)], 1u);
        const unsigned gen = old / nloc;
        if (old + 1u == (gen + 1u) * nloc) {
            __builtin_amdgcn_fence(__ATOMIC_RELEASE, "agent");
            asm volatile("s_waitcnt vmcnt(0)" ::: "memory");
            const unsigned og = xb_add(&bar[XB_TOP], 1u);
            const unsigned tg = og / nx;
            if (og + 1u == (tg + 1u) * nx) xb_add(&bar[XB_TOPGEN], 1u);
            else XB_SPIN(xb_ld(&bar[XB_TOPGEN]) == tg, bar);
            __builtin_amdgcn_fence(__ATOMIC_ACQUIRE, "agent");
            xb_add(&bar[XB_XGEN(b.x)], 1u);
            asm volatile("s_waitcnt vmcnt(0)" ::: "memory");
        } else {
            XB_SPIN(xb_ld(&bar[XB_XGEN(b.x)]) == gen, bar);
            __builtin_amdgcn_fence(__ATOMIC_ACQUIRE, "agent");
            asm volatile("s_waitcnt vmcnt(0)" ::: "memory");
        }
    }
    __syncthreads();
}
namespace pg8 {
struct EpiZ {
    static constexpr bool PERM = true, AFTER_DRAIN = false;
    bf16_t* O; int ldc;
    __device__ __forceinline__ void operator()(const f32x4 (&acc)[2][2][4][2], const Unit& u, int wr, int wc, int fr, int fq) const {
        const int row0 = u.pm * BM + wr * 64 + fr, col0 = u.pn * BM + wc * 32 + 8 * fq;
#pragma unroll
        for (int ai = 0; ai < 2; ++ai)
#pragma unroll
            for (int m = 0; m < 4; ++m) { bf16_t* rowp = O + (size_t)(row0 + ai * HALF + m * 16) * ldc + col0;
#pragma unroll
                for (int bj = 0; bj < 2; ++bj) { const f32x4 v0 = acc[ai][bj][m][0], v1 = acc[ai][bj][m][1];
                    u32x4 w; w.x = cvt_pk_bf16(v0[0], v0[1]); w.y = cvt_pk_bf16(v0[2], v0[3]); w.z = cvt_pk_bf16(v1[0], v1[1]); w.w = cvt_pk_bf16(v1[2], v1[3]);
                    *(u32x4*)(rowp + bj * HALF) = w; } }
    }
};
struct EpiRes {
    static constexpr bool PERM = false, AFTER_DRAIN = false;
    float* H; const float* gate_ctx; const float* gate_lat; int row_off;
    __device__ __forceinline__ void operator()(const f32x4 (&acc)[2][2][4][2], const Unit& u, int wr, int wc, int fr, int fq) const {
        const int row0 = row_off + u.pm * BM + wr * 64 + fr, col0 = u.pn * BM + wc * 32 + 4 * fq;
        const float* gt = (row_off + u.pm * BM) < 256 ? gate_ctx : gate_lat;
        f32x4 gv[2][2];
#pragma unroll
        for (int bj = 0; bj < 2; ++bj)
#pragma unroll
            for (int n = 0; n < 2; ++n) gv[bj][n] = *(const f32x4*)(gt + col0 + bj * HALF + n * 16);
#pragma unroll
        for (int ai = 0; ai < 2; ++ai) {
            f32x4 hv[4][2][2];
#pragma unroll
            for (int m = 0; m < 4; ++m)
#pragma unroll
                for (int bj = 0; bj < 2; ++bj)
#pragma unroll
                    for (int n = 0; n < 2; ++n) hv[m][bj][n] = *(const f32x4*)(H + (size_t)(row0 + ai * HALF + m * 16) * 2048 + col0 + bj * HALF + n * 16);
#pragma unroll
            for (int m = 0; m < 4; ++m)
#pragma unroll
                for (int bj = 0; bj < 2; ++bj)
#pragma unroll
                    for (int n = 0; n < 2; ++n) *(f32x4*)(H + (size_t)(row0 + ai * HALF + m * 16) * 2048 + col0 + bj * HALF + n * 16) = hv[m][bj][n] + gv[bj][n] * acc[ai][bj][m][n];
        }
    }
};
struct EpiResAtomic {
    static constexpr bool PERM = false, AFTER_DRAIN = false;
    float* H; const float* gate;
    __device__ __forceinline__ void operator()(const f32x4 (&acc)[2][2][4][2], const Unit& u, int wr, int wc, int fr, int fq) const {
        const int row0 = u.pm * BM + wr * 64 + fr, col0 = u.pn * BM + wc * 32 + 4 * fq;
#pragma unroll
        for (int bj = 0; bj < 2; ++bj)
#pragma unroll
            for (int n = 0; n < 2; ++n) { const f32x4 gv = *(const f32x4*)(gate + col0 + bj * HALF + n * 16);
#pragma unroll
                for (int ai = 0; ai < 2; ++ai)
#pragma unroll
                    for (int m = 0; m < 4; ++m) { float* q = H + (size_t)(row0 + ai * HALF + m * 16) * 2048 + col0 + bj * HALF + n * 16;
#pragma unroll
                        for (int j = 0; j < 4; ++j) atomicAdd(q + j, gv[j] * acc[ai][bj][m][n][j]); } }
    }
};
}

namespace att {
using bf16 = unsigned short;
constexpr int   D = 128, NW = 8, QBLK = 32, KVBLK = 64;
constexpr float SCALE = 0.088388347648318440f;
constexpr float THR = 8.f;
constexpr int SDEPTH = 2;
constexpr int LDQ = 1024, LDK = 256, LDV = 5888, LDG = 5888, LDO = 1024;
constexpr size_t SHM_V = KVBLK * D * 2, SHM_K = KVBLK * D * 2, SHM_ATTN = 2 * SHM_V + 2 * SHM_K + NW * 64 * 4;
using bf16x8 = __attribute__((ext_vector_type(8))) short;
using s16x4  = __attribute__((ext_vector_type(4))) short;
using f32x16 = __attribute__((ext_vector_type(16))) float;
using f32x8  = __attribute__((ext_vector_type(8))) float;
using u32x4  = __attribute__((ext_vector_type(4))) unsigned;
#define KSWZ(row, colB) ((row) * 256 + ((colB) ^ (((row) & 7) << 4)))
#define SBAR() __builtin_amdgcn_sched_barrier(0)
__device__ __forceinline__ int crow(int r, int hi) { return (r & 3) + 8 * (r >> 2) + 4 * hi; }
__device__ __forceinline__ unsigned cvtpk(float lo, float hi) {
  unsigned r; asm volatile("v_cvt_pk_bf16_f32 %0, %1, %2" : "=v"(r) : "v"(lo), "v"(hi)); return r;
}
template <typename TIn> struct Stage;
template <> struct Stage<bf16>  { using T = bf16x8;
  __device__ static __forceinline__ T ld8(const bf16* p) { return *reinterpret_cast<const bf16x8*>(p); }
  __device__ static __forceinline__ bf16x8 tobf(T x) { return x; } };
template <> struct Stage<float> { using T = f32x8;
  __device__ static __forceinline__ T ld8(const float* p) { return *reinterpret_cast<const f32x8*>(p); }
  __device__ static __forceinline__ bf16x8 tobf(T x) {
    u32x4 w = {cvtpk(x[0], x[1]), cvtpk(x[2], x[3]), cvtpk(x[4], x[5]), cvtpk(x[6], x[7])}; return *reinterpret_cast<bf16x8*>(&w); } };

__device__ __forceinline__ void partialSM(f32x16& p0, f32x16& p1, float& m_reg, float& mn, float& alpha) {
  constexpr float C = SCALE * 1.4426950408889634f;
  float pmax = p0[0]; for (int r = 1; r < 16; ++r) pmax = fmaxf(pmax, p0[r]); for (int r = 0; r < 16; ++r) pmax = fmaxf(pmax, p1[r]);
  { auto rr = __builtin_amdgcn_permlane32_swap(__float_as_uint(pmax), __float_as_uint(pmax), false, false);
    pmax = fmaxf(__uint_as_float(rr[0]), __uint_as_float(rr[1])); }
  if (__builtin_expect(__all(pmax - m_reg <= THR / SCALE), 1)) { mn = m_reg; alpha = 1.f; }
  else { mn = fmaxf(m_reg, pmax); alpha = __builtin_amdgcn_exp2f((m_reg - mn) * C); m_reg = mn; }
  float mnC = -mn * C;
  for (int r = 0; r < 16; ++r) p0[r] = fmaf(p0[r], C, mnC); for (int r = 0; r < 16; ++r) p1[r] = fmaf(p1[r], C, mnC);
  for (int r = 0; r < 16; ++r) p0[r] = __builtin_amdgcn_exp2f(p0[r]);
}
__device__ __forceinline__ void finishSM(f32x16& p0, f32x16& p1, float alpha, float& l_reg, bf16x8& pa0, bf16x8& pa1, bf16x8& pa2, bf16x8& pa3) {
  for (int r = 0; r < 16; ++r) p1[r] = __builtin_amdgcn_exp2f(p1[r]);
  float ps = 0; for (int r = 0; r < 16; ++r) ps += p0[r]; for (int r = 0; r < 16; ++r) ps += p1[r];
  { auto rr = __builtin_amdgcn_permlane32_swap(__float_as_uint(ps), __float_as_uint(ps), false, false);
    ps = __uint_as_float(rr[0]) + __uint_as_float(rr[1]); }
  l_reg = l_reg * alpha + ps;
#define PK4(P, BASE, OUT) do { unsigned a0 = cvtpk(P[BASE + 0], P[BASE + 1]), a1 = cvtpk(P[BASE + 2], P[BASE + 3]);   \
    unsigned b0 = cvtpk(P[BASE + 4], P[BASE + 5]), b1 = cvtpk(P[BASE + 6], P[BASE + 7]);                              \
    auto r0 = __builtin_amdgcn_permlane32_swap(a0, b0, false, false); auto r1 = __builtin_amdgcn_permlane32_swap(a1, b1, false, false); \
    u32x4 w = {r0[0], r1[0], r0[1], r1[1]}; OUT = *reinterpret_cast<bf16x8*>(&w); } while (0)
  PK4(p0, 0, pa0); PK4(p0, 8, pa1); PK4(p1, 0, pa2); PK4(p1, 8, pa3);
#undef PK4
}
__device__ __forceinline__ void qkt(f32x16& p0, f32x16& p1, const bf16* Ks, const bf16x8* qr, int r32, int hi) {
  p0 = f32x16{}; p1 = f32x16{};
  for (int d0 = 0; d0 < 8; ++d0) { int cb = (d0 * 16 + hi * 8) * 2;
    bf16x8 b0 = *reinterpret_cast<const bf16x8*>((const char*)Ks + KSWZ(r32, cb));
    bf16x8 b1 = *reinterpret_cast<const bf16x8*>((const char*)Ks + KSWZ(32 + r32, cb));
    p0 = __builtin_amdgcn_mfma_f32_32x32x16_bf16(b0, qr[d0], p0, 0, 0, 0);
    p1 = __builtin_amdgcn_mfma_f32_32x32x16_bf16(b1, qr[d0], p1, 0, 0, 0); }
}
__device__ __forceinline__ int v_st(int k, int c) { const int kk = (k & ~0xC) | ((k & 4) << 1) | ((k & 8) >> 1); return ((kk >> 3) * 4 + (c >> 5)) * 512 + ((kk & 7) * 32 + (c & 31)) * 2; }
__device__ __forceinline__ int v_rd_base(int lane) { return ((lane & 3) << 3) | (((lane >> 2) & 3) << 6) | (((lane >> 4) & 1) << 5) | (((lane >> 5) & 1) << 8); }
constexpr int v_rd_off(int d0, int ks, int half) { return d0 * 512 + ks * 4096 + half * 2048; }
template <int OFF> __device__ __forceinline__ s16x4 tr_read(int vb) {
  s16x4 r; asm volatile("ds_read_b64_tr_b16 %0, %1 offset:%2" : "=&v"(r) : "v"(vb), "i"(OFF) : "memory"); return r;
}
template <int D0> __device__ __forceinline__ void pv_one(f32x16& od, int vb, bf16x8 pa0, bf16x8 pa1, bf16x8 pa2, bf16x8 pa3) {
  const s16x4 l0 = tr_read<v_rd_off(D0, 0, 0)>(vb), h0 = tr_read<v_rd_off(D0, 0, 1)>(vb), l1 = tr_read<v_rd_off(D0, 1, 0)>(vb), h1 = tr_read<v_rd_off(D0, 1, 1)>(vb);
  const s16x4 l2 = tr_read<v_rd_off(D0, 2, 0)>(vb), h2 = tr_read<v_rd_off(D0, 2, 1)>(vb), l3 = tr_read<v_rd_off(D0, 3, 0)>(vb), h3 = tr_read<v_rd_off(D0, 3, 1)>(vb);
  asm volatile("s_waitcnt lgkmcnt(0)" ::: "memory"); SBAR();
#define PK(L, H) (bf16x8){L[0], L[1], L[2], L[3], H[0], H[1], H[2], H[3]}
  od = __builtin_amdgcn_mfma_f32_32x32x16_bf16(pa0, PK(l0, h0), od, 0, 0, 0);
  od = __builtin_amdgcn_mfma_f32_32x32x16_bf16(pa1, PK(l1, h1), od, 0, 0, 0);
  od = __builtin_amdgcn_mfma_f32_32x32x16_bf16(pa2, PK(l2, h2), od, 0, 0, 0);
  od = __builtin_amdgcn_mfma_f32_32x32x16_bf16(pa3, PK(l3, h3), od, 0, 0, 0);
#undef PK
}
__device__ __forceinline__ void pv_d0(f32x16* o, int vb, bf16x8 pa0, bf16x8 pa1, bf16x8 pa2, bf16x8 pa3) {
  pv_one<0>(o[0], vb, pa0, pa1, pa2, pa3); pv_one<1>(o[1], vb, pa0, pa1, pa2, pa3); pv_one<2>(o[2], vb, pa0, pa1, pa2, pa3); pv_one<3>(o[3], vb, pa0, pa1, pa2, pa3);
}
__device__ __forceinline__ void attn_dense_body(const bf16* __restrict__ Qb, const bf16* __restrict__ Kh, const bf16* __restrict__ Vh,
                                                float* __restrict__ ML, bf16* __restrict__ Mx, int seq, char* lds) {
  using TQ = bf16;
  using St = Stage<bf16>; using SQ = Stage<TQ>;
  const int tid = tidx(), wid = tid >> 6, lane = tid & 63, r32 = lane & 31, hi = lane >> 5;
  bf16* V_lds = (bf16*)lds; bf16* K_lds = (bf16*)(lds + 2 * SHM_V);
  float* ws = (float*)(lds + 2 * SHM_V + 2 * SHM_K) + wid * 64; float* li_l = ws; float* al_l = ws + 32;
  float m_reg = -1e30f, l_reg = 0; f32x16 o[4] = {}; bf16x8 qr[8];
  const TQ* Qw = Qb + (long)(wid * QBLK + r32) * LDQ + hi * 8;
#pragma unroll
  for (int d0 = 0; d0 < 8; ++d0) qr[d0] = SQ::tobf(SQ::ld8(Qw + d0 * 16));
  const int sr = tid >> 4, sc = (tid & 15) * 8, vst0 = v_st(sr, sc), vst1 = v_st(32 + sr, sc);
  const int vb0 = (int)(uintptr_t)V_lds + v_rd_base(lane);
  struct { typename St::T vs0, vs1, ks0, ks1; } sr_[SDEPTH];
#define SLOAD(i, k0) do { sr_[i].vs0 = St::ld8(&Vh[(long)((k0) + sr) * LDK + sc]); sr_[i].vs1 = St::ld8(&Vh[(long)((k0) + 32 + sr) * LDK + sc]); \
    sr_[i].ks0 = St::ld8(&Kh[(long)((k0) + sr) * LDK + sc]); sr_[i].ks1 = St::ld8(&Kh[(long)((k0) + 32 + sr) * LDK + sc]); } while (0)
#define SWRITE(b, i) do { *(bf16x8*)((char*)V_lds + (b) * SHM_V + vst0) = St::tobf(sr_[i].vs0);          \
    *(bf16x8*)((char*)V_lds + (b) * SHM_V + vst1) = St::tobf(sr_[i].vs1); int kc = sc * 2;               \
    *(bf16x8*)((char*)K_lds + (b) * SHM_K + KSWZ(sr, kc)) = St::tobf(sr_[i].ks0);                       \
    *(bf16x8*)((char*)K_lds + (b) * SHM_K + KSWZ(32 + sr, kc)) = St::tobf(sr_[i].ks1); } while (0)
#define SWAIT() do { if constexpr (SDEPTH == 2) asm volatile("s_waitcnt vmcnt(4)" ::: "memory"); else asm volatile("s_waitcnt vmcnt(0)" ::: "memory"); } while (0)
#define RESC(a) do { if (__any((a) < 1.f)) { if (hi == 0) al_l[r32] = (a); asm volatile("s_waitcnt lgkmcnt(0)" ::: "memory"); \
    for (int d = 0; d < 4; ++d) for (int r = 0; r < 16; ++r) o[d][r] *= al_l[crow(r, hi)]; } } while (0)
  f32x16 pA0, pA1, pB0, pB1; float mnA, mnB, alA, alB; bf16x8 pa0, pa1, pa2, pa3; const int NT = seq / KVBLK;
  constexpr int SE = 0, SO = SDEPTH - 1;
  SLOAD(SE, 0); asm volatile("s_waitcnt vmcnt(0)" ::: "memory"); SWRITE(0, SE); __syncthreads();
  qkt(pA0, pA1, K_lds, qr, r32, hi); partialSM(pA0, pA1, m_reg, mnA, alA);
  SLOAD(SO, KVBLK); if constexpr (SDEPTH == 2) { if (2 < NT) SLOAD(SE, 2 * KVBLK); }
  SWAIT(); SWRITE(1, SO); __syncthreads();
  for (int j = 1; j + 1 < NT; j += 2) {
    SBAR(); qkt(pB0, pB1, (bf16*)((char*)K_lds + SHM_K), qr, r32, hi);
    finishSM(pA0, pA1, alA, l_reg, pa0, pa1, pa2, pa3); SBAR();
    SLOAD(SO, (j + SDEPTH) * KVBLK); SBAR();
    pv_d0(o, vb0, pa0, pa1, pa2, pa3); partialSM(pB0, pB1, m_reg, mnB, alB);
    __syncthreads(); SWAIT(); SWRITE(0, SE);
    RESC(alB); __syncthreads();
    SBAR(); qkt(pA0, pA1, K_lds, qr, r32, hi);
    finishSM(pB0, pB1, alB, l_reg, pa0, pa1, pa2, pa3); SBAR();
    if (SDEPTH == 1 || j + 3 < NT) SLOAD(SE, (j + 1 + SDEPTH) * KVBLK); SBAR();
    pv_d0(o, vb0 + (int)SHM_V, pa0, pa1, pa2, pa3); partialSM(pA0, pA1, m_reg, mnA, alA);
    __syncthreads(); SWAIT(); SWRITE(1, SO);
    RESC(alA); __syncthreads();
  }
  SBAR(); qkt(pB0, pB1, (bf16*)((char*)K_lds + SHM_K), qr, r32, hi);
  finishSM(pA0, pA1, alA, l_reg, pa0, pa1, pa2, pa3); SBAR();
  pv_d0(o, vb0, pa0, pa1, pa2, pa3); partialSM(pB0, pB1, m_reg, mnB, alB);
  __syncthreads(); RESC(alB);
  finishSM(pB0, pB1, alB, l_reg, pa0, pa1, pa2, pa3); SBAR();
  pv_d0(o, vb0 + (int)SHM_V, pa0, pa1, pa2, pa3);
  if (hi == 0) { li_l[r32] = l_reg; if (ML != nullptr) { *(float2*)(ML + (long)(wid * QBLK + r32) * 16) = make_float2(m_reg, l_reg); } } asm volatile("s_waitcnt lgkmcnt(0)" ::: "memory");
  float rli[16];
#pragma unroll
  for (int r = 0; r < 16; ++r) rli[r] = __builtin_amdgcn_rcpf(li_l[crow(r, hi)]);
  bf16* Mw = Mx + (long)(wid * QBLK) * LDO;
#pragma unroll
  for (int r = 0; r < 16; ++r) { int orow = crow(r, hi);
#pragma unroll
    for (int d0 = 0; d0 < 4; ++d0) Mw[(long)orow * LDO + d0 * 32 + r32] = f2bf(o[d0][r] * rli[r]); }
#undef SLOAD
#undef SWRITE
#undef SWAIT
#undef RESC
}
}

constexpr int CV_NT_IN = 32 * 23, CV_NT_OUT = 32 * 8, CV_TILES = CV_NT_IN + CV_NT_OUT, CV_ITEMS = CV_TILES + 96;
__device__ __forceinline__ void convert_tile(const Params& p, int l, int r, unsigned char* smem) {
  const int tid = tidx();
  float* tile = (float*)smem;
  const bool isin = r < CV_NT_IN;
  const float* src; bf16_t* dst; int kt, nt, ldsrc;
  if (isin) { kt = r / 23; nt = r % 23; src = p.w_in + (size_t)l * DM * DIN; ldsrc = DIN; dst = (bf16_t*)(p.ws + WS_WIN) + (size_t)l * ZLD * DM; }
  else { r -= CV_NT_IN; kt = r / 8; nt = r % 8; src = p.w_out + (size_t)l * DM * DM; ldsrc = DM; dst = (bf16_t*)(p.ws + WS_WOUT) + (size_t)l * DM * DM; }
  __syncthreads();
  float4 v[8];
#pragma unroll
  for (int i = 0; i < 8; ++i) {
    const int e = tid + 512 * i, kk = e >> 6, n = nt * 256 + (e & 63) * 4;
    const int oc = isin ? (n < 3072 ? n : (n < 5632 ? n + 16 : (n < 5648 ? n - 2560 : -1))) : n;
    v[i] = oc >= 0 ? *(const float4*)(src + (size_t)(kt * 64 + kk) * ldsrc + oc) : make_float4(0.f, 0.f, 0.f, 0.f);
  }
#pragma unroll
  for (int i = 0; i < 8; ++i) { const int e = tid + 512 * i; *(float4*)(tile + (e >> 6) * 260 + (e & 63) * 4) = v[i]; }
  __syncthreads();
  {
    const int nn = tid >> 1, k0 = (tid & 1) * 32;
    bf16_t* d = dst + (size_t)(nt * 256 + nn) * DM + kt * 64 + k0;
#pragma unroll
    for (int q = 0; q < 4; ++q) {
      float f[8];
#pragma unroll
      for (int i = 0; i < 8; ++i) f[i] = tile[(k0 + q * 8 + i) * 260 + nn];
      u32x4_t w = {cvtpk2(f[0], f[1]), cvtpk2(f[2], f[3]), cvtpk2(f[4], f[5]), cvtpk2(f[6], f[7])};
      *(u32x4_t*)(d + q * 8) = w;
    }
  }
}
__device__ __forceinline__ void mod_item(const Params& p, int l, int jg, unsigned char* smem) {
  const int tid = tidx();
  float* sc = (float*)smem;
  float* red = (float*)smem + 4096;
  __syncthreads();
  for (int k = tid; k < 2048; k += 512) { sc[k] = siluf_(p.c[k]); sc[2048 + k] = siluf_(p.c_ctx[k]); }
  __syncthreads();
  float* mod = (float*)(p.ws + WS_MOD);
  const int cq = tid & 15, kg = tid >> 4, j0 = jg * 64;
  const float* wp = p.w_mod + ((size_t)l * DM + kg * 64) * 6144 + j0 + cq * 4;
  float4 a0 = {0.f, 0.f, 0.f, 0.f}, a1 = {0.f, 0.f, 0.f, 0.f};
#pragma unroll 16
  for (int k = 0; k < 64; ++k) {
    const float4 w = *(const float4*)(wp + (size_t)k * 6144);
    const float s0 = sc[kg * 64 + k], s1 = sc[2048 + kg * 64 + k];
    a0.x += s0 * w.x; a0.y += s0 * w.y; a0.z += s0 * w.z; a0.w += s0 * w.w;
    a1.x += s1 * w.x; a1.y += s1 * w.y; a1.z += s1 * w.z; a1.w += s1 * w.w;
  }
  *(float4*)(red + (kg * 2 + 0) * 64 + cq * 4) = a0;
  *(float4*)(red + (kg * 2 + 1) * 64 + cq * 4) = a1;
  __syncthreads();
  if (tid < 128) {
    const int s = tid >> 6, j = tid & 63; float acc = 0.f;
#pragma unroll 8
    for (int g = 0; g < 32; ++g) acc += red[(g * 2 + s) * 64 + j];
    mod[((size_t)l * 2 + s) * 6144 + j0 + j] = acc + p.b_mod[(size_t)l * 6144 + j0 + j];
  }
}
__device__ __forceinline__ void convert_item(const Params& p, int l, int it, unsigned char* smem) {
  if (it < CV_TILES) convert_tile(p, l, it, smem); else mod_item(p, l, it - CV_TILES, smem);
}
__device__ void convert_queue(const Params& p, int l, unsigned char* smem) {
  unsigned* ctr = (unsigned*)(p.ws + WS_CTR) + 8 + l;
  volatile int* slot = (volatile int*)(smem + 144000);
  for (;;) {
    __syncthreads();
    if (tidx() == 0) *slot = (int)atomicAdd(ctr, 1u);
    __syncthreads();
    const int it = *slot;
    if (it >= CV_ITEMS) break;
    convert_item(p, l, it, smem);
  }
  __syncthreads();
}
__device__ void phase_prep0(const Params& p, unsigned char* smem) {
  const int tid = tidx(), nb = gridDim.x, bid = bidx();
  {
    float4* h4 = (float4*)(p.ws + WS_H);
    const float4* c4 = (const float4*)p.ctx; const float4* x4 = (const float4*)p.x;
    const long nctx = (long)TC * DM / 4, ntot = (long)TA * DM / 4;
    for (long i = (long)bid * 512 + tid; i < ntot; i += (long)nb * 512) h4[i] = i < nctx ? c4[i] : x4[i - nctx];
  }
  for (int it = bid; it < CV_ITEMS; it += nb) convert_item(p, 0, it, smem);
  {
    bf16_t* wg = (bf16_t*)(p.ws + WS_WG);
    const int total = NL * 2 * 2 * 8 * 4096;
    for (int e = bid * 512 + tid; e < total; e += nb * 512) {
      const int i = e & 63, j = (e >> 6) & 63, n = (e >> 12) & 7, g = (e >> 15) & 1, d = (e >> 16) & 1, l = e >> 17;
      const float* src = g ? p.w_ia : p.w_ra;
      wg[e] = f2bf(src[((((size_t)l * 2 + d) * 8 + n) * 64 + i) * 64 + j]);
    }
  }
  __syncthreads();
}

__device__ void phase_norm(const Params& p, int l) {
  const int tid = tidx(), lane = tid & 63, wid = tid >> 6;
  const float* H = (const float*)(p.ws + WS_H);
  bf16_t* XN = (bf16_t*)(p.ws + WS_XN);
  const float* g = p.norm_g + (size_t)l * DM;
  const float* mod = (const float*)(p.ws + WS_MOD) + (size_t)l * 2 * 6144;
  for (int r = bidx() * 8 + wid; r < TA; r += gridDim.x * 8) {
    const float* hr = H + (size_t)r * DM;
    const float* md = mod + (r < TC ? 6144 : 0);
    float4 v[8]; float ss = 0.f;
#pragma unroll
    for (int i = 0; i < 8; ++i) { v[i] = *(const float4*)(hr + i * 256 + lane * 4); ss += v[i].x * v[i].x + v[i].y * v[i].y + v[i].z * v[i].z + v[i].w * v[i].w; }
    ss = wave_sum(ss);
    const float rstd = rsqrtf(ss * (1.f / DM) + 1e-6f);
#pragma unroll
    for (int i = 0; i < 8; ++i) {
      const int c = i * 256 + lane * 4;
      const float4 gg = *(const float4*)(g + c), sh = *(const float4*)(md + c), scl = *(const float4*)(md + 2048 + c);
      const float o0 = v[i].x * rstd * gg.x * (1.f + scl.x) + sh.x, o1 = v[i].y * rstd * gg.y * (1.f + scl.y) + sh.y;
      const float o2 = v[i].z * rstd * gg.z * (1.f + scl.z) + sh.z, o3 = v[i].w * rstd * gg.w * (1.f + scl.w) + sh.w;
      u32x2_t w = {cvtpk2(o0, o1), cvtpk2(o2, o3)};
      *(u32x2_t*)(XN + (size_t)r * DM + c) = w;
    }
  }
}

__device__ void phase_final(const Params& p) {
  const int tid = tidx(), lane = tid & 63, wid = tid >> 6;
  const float* H = (const float*)(p.ws + WS_H);
  for (int t = bidx() * 8 + wid; t < TL; t += gridDim.x * 8) {
    const float* hr = H + (size_t)(TC + t) * DM;
    float4 v[8]; float ss = 0.f;
#pragma unroll
    for (int i = 0; i < 8; ++i) { v[i] = *(const float4*)(hr + i * 256 + lane * 4); ss += v[i].x * v[i].x + v[i].y * v[i].y + v[i].z * v[i].z + v[i].w * v[i].w; }
    ss = wave_sum(ss);
    const float rstd = rsqrtf(ss * (1.f / DM) + 1e-6f);
#pragma unroll
    for (int i = 0; i < 8; ++i) {
      const int c = i * 256 + lane * 4;
      const float4 gg = *(const float4*)(p.final_g + c);
      float4 o = {v[i].x * rstd * gg.x, v[i].y * rstd * gg.y, v[i].z * rstd * gg.z, v[i].w * rstd * gg.w};
      *(float4*)(p.out + (size_t)t * DM + c) = o;
    }
  }
}

__device__ void phase_qkprep(const Params& p, int l) {
  const int tid = tidx(), lane = tid & 63, wid = tid >> 6;
  const bf16_t* Z = (const bf16_t*)(p.ws + WS_Z);
  bf16_t* QB = (bf16_t*)(p.ws + WS_QB); bf16_t* KB = (bf16_t*)(p.ws + WS_KB); bf16_t* VB = (bf16_t*)(p.ws + WS_VB);
  const float gq1 = p.qn_c[l * 128 + lane], gq2 = p.qn_c[l * 128 + 64 + lane];
  const float gk1 = p.kn_c[l * 128 + lane], gk2 = p.kn_c[l * 128 + 64 + lane];
  const float inv_freq = exp2f(-(float)(lane & 31) * (13.287712379549449f / 32.f));
  for (int r = bidx() * 8 + wid; r < TA; r += gridDim.x * 8) {
    float cs = 1.f, sn = 0.f;
    if (r >= TC) {
      const int t = r - TC; const float pos = (float)(lane < 32 ? (t >> 6) : (t & 63));
      const float ang = pos * inv_freq;
      const float k = rintf(ang * 0.15915494309189535f);
      float rr = fmaf(-k, 6.2831854820251465f, ang); rr = fmaf(-k, -1.7484555e-7f, rr);
      cs = cosf(rr); sn = sinf(rr);
    }
    const bf16_t* zr = Z + (size_t)r * ZLD;
#pragma unroll
    for (int hh = 0; hh < 10; ++hh) {
      const int zc = hh < 8 ? ZC_QC + hh * 128 : ZC_KC + (hh - 8) * 128;
      const float x1 = bf2f(zr[zc + lane]), x2 = bf2f(zr[zc + 64 + lane]);
      const float ss = wave_sum(x1 * x1 + x2 * x2);
      const float rstd = rsqrtf(ss * (1.f / 128.f) + 1e-6f);
      const float y1 = x1 * rstd * (hh < 8 ? gq1 : gk1), y2 = x2 * rstd * (hh < 8 ? gq2 : gk2);
      const float o1 = y1 * cs - y2 * sn, o2 = y2 * cs + y1 * sn;
      bf16_t* dst = hh < 8 ? QB + (size_t)r * 1024 + hh * 128 : KB + (size_t)r * 256 + (hh - 8) * 128;
      dst[lane] = f2bf(o1); dst[64 + lane] = f2bf(o2);
    }
    *(u32x2_t*)(VB + (size_t)r * 256 + lane * 4) = *(const u32x2_t*)(zr + ZC_VC + lane * 4);
  }
}

__device__ __forceinline__ void lru_ab_item(const Params& p, int l, int it, unsigned char* smem) {
  const int tid = tidx(), lane = tid & 63, wid = tid >> 6, fr = lane & 15, fq = lane >> 4;
  const bf16_t* Z = (const bf16_t*)(p.ws + WS_Z);
  float* uS = (float*)smem;
  bf16_t* uB = (bf16_t*)(smem + 16640);
  float* aS = (float*)(smem + 16640 + 9216);
  float* bS = aS + 2 * 64 * 64;
  float* LA = (float*)(p.ws + WS_LA); float* LB = (float*)(p.ws + WS_LB);
  float* LSEG = (float*)(p.ws + WS_LSEG);
  const bf16_t* WG = (const bf16_t*)(p.ws + WS_WG) + (size_t)l * 2 * 2 * 8 * 4096;
  {
    const int rs = it >> 3, n = it & 7, r0 = rs * 64;
    const int seg_lo = r0 < TC ? 0 : TC, seg_hi = r0 < TC ? TC : TA;
    __syncthreads();
    {
      const int tk = tid >> 3, c8 = (tid & 7) * 8, ch0 = n * 64 + c8;
      float acc[8];
#pragma unroll
      for (int i = 0; i < 8; ++i) acc[i] = p.conv_a_b[l * 512 + ch0 + i];
#pragma unroll
      for (int kk = 0; kk < 4; ++kk) {
        const int rr = r0 + tk + kk - 2;
        if (rr >= seg_lo && rr < seg_hi) {
          const bf16x8_t xv = *(const bf16x8_t*)(Z + (size_t)rr * ZLD + ZC_XA + ch0);
          const float* cw = p.conv_a_w + ((size_t)l * 4 + kk) * 512 + ch0;
#pragma unroll
          for (int i = 0; i < 8; ++i) acc[i] += cw[i] * bf2f((bf16_t)xv[i]);
        }
      }
#pragma unroll
      for (int i = 0; i < 8; ++i) { uS[tk * 65 + c8 + i] = acc[i]; uB[tk * 72 + c8 + i] = f2bf(acc[i]); }
    }
    __syncthreads();
    {
      const int d = wid & 1, ct = wid >> 1;
      f32x4_t ar[4], ai[4];
#pragma unroll
      for (int m = 0; m < 4; ++m) { ar[m] = (f32x4_t){0.f, 0.f, 0.f, 0.f}; ai[m] = (f32x4_t){0.f, 0.f, 0.f, 0.f}; }
      const bf16_t* wr_ = WG + ((size_t)(d * 2 + 0) * 8 + n) * 4096 + (ct * 16 + fr) * 64;
      const bf16_t* wi_ = WG + ((size_t)(d * 2 + 1) * 8 + n) * 4096 + (ct * 16 + fr) * 64;
#pragma unroll
      for (int ks = 0; ks < 2; ++ks) {
        const bf16x8_t br = *(const bf16x8_t*)(wr_ + ks * 32 + fq * 8);
        const bf16x8_t bi = *(const bf16x8_t*)(wi_ + ks * 32 + fq * 8);
#pragma unroll
        for (int m = 0; m < 4; ++m) {
          const bf16x8_t a = *(const bf16x8_t*)(uB + (m * 16 + fr) * 72 + ks * 32 + fq * 8);
          ar[m] = __builtin_amdgcn_mfma_f32_16x16x32_bf16(a, br, ar[m], 0, 0, 0);
          ai[m] = __builtin_amdgcn_mfma_f32_16x16x32_bf16(a, bi, ai[m], 0, 0, 0);
        }
      }
      const int cl = ct * 16 + fr, ch = n * 64 + cl;
      const float bra = p.b_ra[(l * 2 + d) * 512 + ch], bia = p.b_ia[(l * 2 + d) * 512 + ch];
      const float spl = softplusf_(-p.lam_a[(l * 2 + d) * 512 + ch]);
#pragma unroll
      for (int m = 0; m < 4; ++m)
#pragma unroll
        for (int j = 0; j < 4; ++j) {
          const int tk = m * 16 + fq * 4 + j;
          const float gr = sigmoidf_(ar[m][j] + bra), gi = sigmoidf_(ai[m][j] + bia);
          const float la = -8.f * gr * spl, x2 = 2.f * la;
          const float om = x2 > -0.05f ? -x2 * (1.f + x2 * (0.5f + x2 * (0.16666667f + x2 * 0.041666668f))) : 1.f - fexp_(x2);
          const float a = fexp_(la), b = __builtin_amdgcn_sqrtf(om) * gi * uS[tk * 65 + cl];
          aS[(d * 64 + tk) * 64 + cl] = a; bS[(d * 64 + tk) * 64 + cl] = b;
          LA[((size_t)d * TA + r0 + tk) * 512 + ch] = a; LB[((size_t)d * TA + r0 + tk) * 512 + ch] = b;
        }
    }
    __syncthreads();
    if (tid < 128) {
      const int d = tid >> 6, cl = tid & 63;
      float A = 1.f, B = 0.f;
      for (int s = 0; s < 64; ++s) { const int tk = d ? 63 - s : s; const float a = aS[(d * 64 + tk) * 64 + cl], b = bS[(d * 64 + tk) * 64 + cl]; A *= a; B = a * B + b; }
      const int ps = d == 0 ? rs : (rs < 4 ? 3 - rs : 135 - rs);
      float* o = LSEG + (((size_t)d * NCH + ps) * 512 + n * 64 + cl) * 2;
      o[0] = A; o[1] = B;
    }
  }
}

__device__ void lru_carry(const Params& p, int blk  ) {
  const int d = blk, ch = tidx();
  const float* LSEG = (const float*)(p.ws + WS_LSEG) + (size_t)d * NCH * 512 * 2;
  float* LCAR = (float*)(p.ws + WS_LCAR) + (size_t)d * NCH * 512;
  float h = 0.f;
#pragma unroll 4
  for (int ps = 0; ps < NCH; ++ps) {
    const float2 ab = *(const float2*)(LSEG + ((size_t)ps * 512 + ch) * 2);
    LCAR[ps * 512 + ch] = h; h = ab.x * h + ab.y;
  }
}

__device__ __forceinline__ void lru_fin_item(const Params& p, int l, int rs) {
  const int ch = tidx();
  const float* LA = (const float*)(p.ws + WS_LA); const float* LB = (const float*)(p.ws + WS_LB);
  const float* LCAR = (const float*)(p.ws + WS_LCAR);
  const bf16_t* Z = (const bf16_t*)(p.ws + WS_Z); bf16_t* MIX = (bf16_t*)(p.ws + WS_MIX);
  {
    const int r0 = rs * 64, ps1 = rs < 4 ? 3 - rs : 135 - rs;
    float hb[64];
    float h = LCAR[((size_t)1 * NCH + ps1) * 512 + ch];
#pragma unroll
    for (int s = 0; s < 64; ++s) { const int tk = 63 - s; const size_t o = ((size_t)1 * TA + r0 + tk) * 512 + ch; h = LA[o] * h + LB[o]; hb[tk] = h; }
    h = LCAR[((size_t)0 * NCH + rs) * 512 + ch];
#pragma unroll
    for (int tk = 0; tk < 64; ++tk) {
      const size_t o = ((size_t)0 * TA + r0 + tk) * 512 + ch; h = LA[o] * h + LB[o];
      const float ga = bf2f(Z[(size_t)(r0 + tk) * ZLD + ZC_GA + ch]);
      MIX[(size_t)(r0 + tk) * DM + ch] = f2bf((h + hb[tk]) * siluf_(ga));
    }
  }
}

constexpr int GD_QN = 0, GD_KN = 17408, GD_KT = 34816, GD_VT = 53248, GD_KK = 71680, GD_QK = 88320, GD_MS = 104960, GD_SC = 141824;
__device__ __forceinline__ void gdn_local_item(const Params& p, int l, int it, unsigned char* smem) {
  const bf16_t* Z = (const bf16_t*)(p.ws + WS_Z);
  bf16_t* qN = (bf16_t*)(smem + GD_QN); bf16_t* kN = (bf16_t*)(smem + GD_KN);
  bf16_t* kT = (bf16_t*)(smem + GD_KT); bf16_t* vT = (bf16_t*)(smem + GD_VT);
  float* KKs = (float*)(smem + GD_KK); float* QKs = (float*)(smem + GD_QK);
  float* Ms = (float*)(smem + GD_MS);
  float* SC = (float*)(smem + GD_SC);
  unsigned char* GREC = p.ws + WS_GREC; float* GU = (float*)(p.ws + WS_GU); float* GGL = (float*)(p.ws + WS_GGL);
  {
    const int rc = it >> 2, h = it & 3, r0 = rc * 64;
    const int seg_lo = r0 < TC ? 0 : TC, seg_hi = r0 < TC ? TC : TA;
    __syncthreads();
    {
    const int tid = tidx(), lane = tid & 63, wid = tid >> 6;
#pragma unroll 1
    for (int i = 0; i < 6; ++i) {
      const int u = i * 512 + tid, tk = u / 48, part = (u % 48) >> 4, c8 = (u & 15) * 8;
      const int chq = part * 512 + h * 128 + c8;
      float acc[8];
#pragma unroll
      for (int e = 0; e < 8; ++e) acc[e] = 0.f;
#pragma unroll
      for (int kk = 0; kk < 4; ++kk) {
        const int rr = r0 + tk + kk - 2;
        if (rr >= seg_lo && rr < seg_hi) {
          const bf16x8_t xv = *(const bf16x8_t*)(Z + (size_t)rr * ZLD + ZC_QKVB + chq);
          const float* cw = p.conv_b_w + ((size_t)l * 4 + kk) * 1536 + chq;
#pragma unroll
          for (int e = 0; e < 8; ++e) acc[e] += cw[e] * bf2f((bf16_t)xv[e]);
        }
      }
      float ss = 0.f;
#pragma unroll
      for (int e = 0; e < 8; ++e) { acc[e] = siluf_(acc[e]); ss += acc[e] * acc[e]; }
      ss += __shfl_xor(ss, 1); ss += __shfl_xor(ss, 2); ss += __shfl_xor(ss, 4); ss += __shfl_xor(ss, 8);
      float scl = 1.f;
      if (part == 0) scl = rsqrtf(ss + 1e-6f) * 0.088388347648318440f;
      else if (part == 1) scl = rsqrtf(ss + 1e-6f);
#pragma unroll
      for (int e = 0; e < 8; ++e) {
        const bf16_t b = f2bf(acc[e] * scl);
        if (part == 0) qN[tk * 136 + c8 + e] = b;
        const int tsw = (((tk >> 3) ^ ((c8 >> 3) & 7)) << 3) | (tk & 7);
        if (part == 1) { kN[tk * 136 + c8 + e] = b; kT[(c8 + e) * 72 + tsw] = b; }
        else if (part == 2) vT[(c8 + e) * 72 + tsw] = b;
      }
    }
    if (wid < 2) {
      const int d = wid, tk = d ? 63 - lane : lane;
      const bf16_t* zr = Z + (size_t)(r0 + tk) * ZLD;
      const float beta = sigmoidf_(bf2f(zr[ZC_BETA + d * 4 + h]));
      const float g = -expf(p.a_log_b[(l * 2 + d) * 4 + h]) * softplusf_(bf2f(zr[ZC_ALPHA + d * 4 + h]) + p.dt_bias_b[(l * 2 + d) * 4 + h]);
      float gc = g;
#pragma unroll
      for (int o = 1; o < 64; o <<= 1) { const float t = __shfl_up(gc, o); if (lane >= o) gc += t; }
      const float gl = __shfl(gc, 63);
      float* s = SC + d * 256;
      s[lane] = beta; s[64 + lane] = gc; s[128 + lane] = expf(gc); s[192 + lane] = expf(gl - gc);
      if (lane == 0) { const int pc = d == 0 ? rc : (rc < 4 ? 3 - rc : 135 - rc); GGL[(size_t)(d * 4 + h) * NCH + pc] = expf(gl); }
    }
    }
    __syncthreads();
    {
      const int tid = tidx(), lane = tid & 63, wid = tid >> 6, fr = lane & 15, fq = lane >> 4;
      const int which = wid >> 2, mt = wid & 3;
      const bf16_t* Asrc = which ? qN : kN;
      f32x4_t acc[4];
#pragma unroll
      for (int ct = 0; ct < 4; ++ct) acc[ct] = (f32x4_t){0.f, 0.f, 0.f, 0.f};
#pragma unroll
      for (int ks = 0; ks < 4; ++ks) {
        const bf16x8_t a = *(const bf16x8_t*)(Asrc + (mt * 16 + fr) * 136 + ks * 32 + fq * 8);
#pragma unroll
        for (int ct = 0; ct < 4; ++ct) {
          const bf16x8_t b = *(const bf16x8_t*)(kN + (ct * 16 + fr) * 136 + ks * 32 + fq * 8);
          acc[ct] = __builtin_amdgcn_mfma_f32_16x16x32_bf16(a, b, acc[ct], 0, 0, 0);
        }
      }
      float* dst = which ? QKs : KKs;
#pragma unroll
      for (int ct = 0; ct < 4; ++ct)
#pragma unroll
        for (int j = 0; j < 4; ++j) dst[(mt * 16 + fq * 4 + j) * 65 + ct * 16 + fr] = acc[ct][j];
    }
    __syncthreads();
#pragma unroll 1
    for (int i = 0; i < 16; ++i) {
      const int e = i * 512 + tidx(), d = e >> 12, pi = (e >> 6) & 63, pj = e & 63;
      const int ti = d ? 63 - pi : pi, tj = d ? 63 - pj : pj;
      const float* s = SC + d * 256;
      const float dec = pi >= pj ? fexp_(s[64 + pi] - s[64 + pj]) : 0.f;
      Ms[(d * 64 + pi) * 72 + pj] = pi > pj ? s[pi] * KKs[ti * 65 + tj] * dec : 0.f;
      const int pc = d == 0 ? rc : (rc < 4 ? 3 - rc : 135 - rc);
      ((bf16_t*)(GREC + ((size_t)(d * 4 + h) * NCH + pc) * GREC_BYTES + 32768))[pi * 64 + pj] = f2bf(QKs[ti * 65 + tj] * dec);
    }
    __syncthreads();
    if ((tidx() >> 6) < 2) {
      const int d = tidx() >> 6, c = tidx() & 63;
      const float* Md = Ms + d * 64 * 72;
      float T[64];
#pragma unroll
      for (int i = 0; i < 64; ++i) T[i] = 0.f;
#pragma unroll
      for (int i = 0; i < 64; ++i) {
        float a0 = (i == c) ? 1.f : 0.f, a1 = 0.f;
#pragma unroll
        for (int jb = 0; jb < i; jb += 4) {
          const float4 m = *(const float4*)(Md + i * 72 + jb);
          a0 -= m.x * T[jb]; a1 -= m.y * T[jb + 1]; a0 -= m.z * T[jb + 2]; a1 -= m.w * T[jb + 3];
        }
        T[i] = a0 + a1;
      }
      const float* s = SC + d * 256;
      const float bc = s[c], bce = s[c] * s[128 + c];
      const int tc = d ? 63 - c : c;
      bf16_t* Tu = (bf16_t*)(Ms + d * 64 * 72); bf16_t* Tw = Tu + 64 * 72;
      asm volatile("s_waitcnt lgkmcnt(0)" ::: "memory");
#pragma unroll
      for (int i = 0; i < 64; ++i) { Tu[i * 72 + tc] = f2bf(T[i] * bc); Tw[i * 72 + tc] = f2bf(T[i] * bce); }
    } else {
#pragma unroll 1
      for (int e = tidx() - 128; e < 2048; e += 384) {
        const int d = e >> 10, pi = (e >> 4) & 63, c8 = (e & 15) * 8;
        const int ti = d ? 63 - pi : pi; const float sc = SC[d * 256 + 128 + pi];
        const int pc = d == 0 ? rc : (rc < 4 ? 3 - rc : 135 - rc);
        const bf16x8_t qv = *(const bf16x8_t*)(qN + ti * 136 + c8);
        float f[8];
#pragma unroll
        for (int k = 0; k < 8; ++k) f[k] = bf2f((bf16_t)qv[k]) * sc;
        u32x4_t w = {cvtpk2(f[0], f[1]), cvtpk2(f[2], f[3]), cvtpk2(f[4], f[5]), cvtpk2(f[6], f[7])};
        *(u32x4_t*)((bf16_t*)(GREC + ((size_t)(d * 4 + h) * NCH + pc) * GREC_BYTES + 16384) + pi * 128 + c8) = w;
      }
#pragma unroll 1
      for (int e = tidx() - 128; e < 2048; e += 384) {
        const int d = e >> 10, chn = (e >> 3) & 127, p8 = (e & 7) * 8;
        const int pc = d == 0 ? rc : (rc < 4 ? 3 - rc : 135 - rc);
        float f[8];
#pragma unroll
        for (int k = 0; k < 8; ++k) { const int pi = p8 + k, ti = d ? 63 - pi : pi; f[k] = bf2f(kT[chn * 72 + ((((ti >> 3) ^ ((chn >> 3) & 7)) << 3) | (ti & 7))]) * SC[d * 256 + 192 + pi]; }
        u32x4_t w = {cvtpk2(f[0], f[1]), cvtpk2(f[2], f[3]), cvtpk2(f[4], f[5]), cvtpk2(f[6], f[7])};
        *(u32x4_t*)((bf16_t*)(GREC + ((size_t)(d * 4 + h) * NCH + pc) * GREC_BYTES + 40960) + chn * 64 + p8) = w;
      }
    }
    __syncthreads();
    {
      const int tid = tidx(), lane = tid & 63, wid = tid >> 6, fr = lane & 15, fq = lane >> 4;
      const int d = wid >> 2, which = (wid >> 1) & 1, half = wid & 1;
      const int pc = d == 0 ? rc : (rc < 4 ? 3 - rc : 135 - rc);
      const size_t cbase = (size_t)(d * 4 + h) * NCH + pc;
      const bf16_t* Tm = (const bf16_t*)(Ms + d * 64 * 72) + which * 64 * 72;
      const bf16_t* Bs = which ? kT : vT;
#pragma unroll 1
      for (int cti = 0; cti < 4; ++cti) {
        const int ct = half * 4 + cti;
        f32x4_t acc[4];
#pragma unroll
        for (int m = 0; m < 4; ++m) acc[m] = (f32x4_t){0.f, 0.f, 0.f, 0.f};
#pragma unroll
        for (int ks = 0; ks < 2; ++ks) {
          const bf16x8_t b = *(const bf16x8_t*)(Bs + (ct * 16 + fr) * 72 + (((ks * 4 + fq) ^ ((2 * ct + (fr >> 3)) & 7)) << 3));
#pragma unroll
          for (int m = 0; m < 4; ++m) {
            const bf16x8_t a = *(const bf16x8_t*)(Tm + (m * 16 + fr) * 72 + ks * 32 + fq * 8);
            acc[m] = __builtin_amdgcn_mfma_f32_16x16x32_bf16(a, b, acc[m], 0, 0, 0);
          }
        }
#pragma unroll
        for (int m = 0; m < 4; ++m)
#pragma unroll
          for (int j = 0; j < 4; ++j) {
            const int pi = m * 16 + fq * 4 + j, chn = ct * 16 + fr;
            if (which) ((bf16_t*)(GREC + cbase * GREC_BYTES))[pi * 128 + chn] = f2bf(acc[m][j]);
            else GU[cbase * 8192 + pi * 128 + chn] = acc[m][j];
          }
      }
    }
  }
}

constexpr int GS_W = 0, GS_QH = 17408, GS_QK = 34816, GS_KT = 44032, GS_BUF = 62464, GS_GAM = 2 * GS_BUF, GS_OST = GS_GAM + 1024;
__device__ void gdn_scan(const Params& p, unsigned char* smem, int sq, int sg) {
  const int tid = tidx(), lane = tid & 63, wid = tid >> 6, fr = lane & 15, fq = lane >> 4;
  const int d = sq >> 2, h = sq & 3;
  const unsigned char* REC = p.ws + WS_GREC + (size_t)sq * NCH * GREC_BYTES;
  const float* GGL = (const float*)(p.ws + WS_GGL) + (size_t)sq * NCH;
  float* gamS = (float*)(smem + GS_GAM);
  __syncthreads();
  if (tid < NCH) gamS[tid] = GGL[tid];
  if (wid < 4) {
    const int slice = sg * 4 + wid, n0 = slice * 16;
    const float* up = (const float*)(p.ws + WS_GU) + (size_t)sq * NCH * 8192 + (fq * 4) * 128 + n0 + fr;
    float* GO = (float*)(p.ws + WS_GO) + (size_t)(sq * 8 + slice) * TA * 16;
    float* ost = (float*)(smem + GS_OST + wid * 4096);
    f32x4_t S[8], U[4];
#pragma unroll
    for (int t = 0; t < 8; ++t) S[t] = (f32x4_t){0.f, 0.f, 0.f, 0.f};
#pragma unroll
    for (int m = 0; m < 4; ++m)
#pragma unroll
      for (int j = 0; j < 4; ++j) U[m][j] = up[(m * 16 + j) * 128];
    __syncthreads();
#pragma unroll 1
    for (int pc = 0; pc < NCH; ++pc) {
      const unsigned char* B_ = smem + (pc & 1) * GS_BUF;
#define GS_AFRAG(base, stride, row, ks) ({ const unsigned char* a_ = B_ + (base) + (row) * (stride) + (ks) * 64 + fq * 8; \
      u32x2_t lo_ = *(const u32x2_t*)a_; u32x2_t hi_ = *(const u32x2_t*)(a_ + 32); u32x4_t w_ = {lo_.x, lo_.y, hi_.x, hi_.y}; *reinterpret_cast<bf16x8_t*>(&w_); })
      const float gam = gamS[pc];
      f32x4_t Un[4];
      { const int pn = pc + 1 < NCH ? pc + 1 : pc;
#pragma unroll
        for (int m = 0; m < 4; ++m)
#pragma unroll
          for (int j = 0; j < 4; ++j) Un[m][j] = up[(size_t)pn * 8192 + (m * 16 + j) * 128]; }
      bf16x8_t Sb[4];
#pragma unroll
      for (int ks = 0; ks < 4; ++ks) Sb[ks] = pack8(S[2 * ks], S[2 * ks + 1]);
      f32x4_t P[4], O[4];
#pragma unroll
      for (int m = 0; m < 4; ++m) { P[m] = (f32x4_t){0.f, 0.f, 0.f, 0.f}; O[m] = (f32x4_t){0.f, 0.f, 0.f, 0.f}; }
#pragma unroll
      for (int ks = 0; ks < 4; ++ks)
#pragma unroll
        for (int m = 0; m < 4; ++m) {
          const bf16x8_t aw = GS_AFRAG(GS_W, 272, m * 16 + fr, ks);
          const bf16x8_t aq = GS_AFRAG(GS_QH, 272, m * 16 + fr, ks);
          P[m] = __builtin_amdgcn_mfma_f32_16x16x32_bf16(aw, Sb[ks], P[m], 0, 0, 0);
          O[m] = __builtin_amdgcn_mfma_f32_16x16x32_bf16(aq, Sb[ks], O[m], 0, 0, 0);
        }
      f32x4_t Vn[4];
#pragma unroll
      for (int m = 0; m < 4; ++m) Vn[m] = U[m] - P[m];
      bf16x8_t Vb[2];
      Vb[0] = pack8(Vn[0], Vn[1]); Vb[1] = pack8(Vn[2], Vn[3]);
#pragma unroll
      for (int ks = 0; ks < 2; ++ks)
#pragma unroll
        for (int m = 0; m < 4; ++m) {
          const bf16x8_t a = GS_AFRAG(GS_QK, 144, m * 16 + fr, ks);
          O[m] = __builtin_amdgcn_mfma_f32_16x16x32_bf16(a, Vb[ks], O[m], 0, 0, 0);
        }
#pragma unroll
      for (int t = 0; t < 8; ++t) {
        S[t] = S[t] * gam;
#pragma unroll
        for (int ks = 0; ks < 2; ++ks) {
          const bf16x8_t a = GS_AFRAG(GS_KT, 144, t * 16 + fr, ks);
          S[t] = __builtin_amdgcn_mfma_f32_16x16x32_bf16(a, Vb[ks], S[t], 0, 0, 0);
        }
      }
#undef GS_AFRAG
#pragma unroll
      for (int m = 0; m < 4; ++m)
#pragma unroll
        for (int j = 0; j < 4; ++j) { const int pi = m * 16 + fq * 4 + j, tk = d ? 63 - pi : pi; ost[tk * 16 + fr] = O[m][j]; }
      const int rcn = d == 0 ? pc : (pc < 4 ? 3 - pc : 135 - pc);
      float* gop = GO + (size_t)rcn * 1024 + lane * 4;
#pragma unroll
      for (int i = 0; i < 4; ++i) *(f32x4_t*)(gop + i * 256) = *(const f32x4_t*)(ost + i * 256 + lane * 4);
#pragma unroll
      for (int m = 0; m < 4; ++m) U[m] = Un[m];
      __syncthreads();
    }
  } else {
    const int lt = tid - 256;
    int lo[14];
#pragma unroll
    for (int i = 0; i < 14; ++i) {
      const int q = lt + 256 * i;
      lo[i] = q < 1024 ? GS_W + (q >> 4) * 272 + (q & 15) * 16
            : q < 2048 ? GS_QH + ((q - 1024) >> 4) * 272 + (q & 15) * 16
            : q < 2560 ? GS_QK + ((q - 2048) >> 3) * 144 + (q & 7) * 16
                       : GS_KT + ((q - 2560) >> 3) * 144 + (q & 7) * 16;
    }
    u32x4_t R0[14], R1[14], R2[14];
#define GS_LOAD(R, pc) do { const int pc_ = (pc) < NCH ? (pc) : NCH - 1; const u32x4_t* s_ = (const u32x4_t*)(REC + (size_t)pc_ * GREC_BYTES) + lt; \
    _Pragma("unroll") for (int i = 0; i < 14; ++i) R[i] = s_[256 * i]; } while (0)
#define GS_WRITE(R, pc) do { unsigned char* B_ = smem + ((pc) & 1) * GS_BUF; \
    _Pragma("unroll") for (int i = 0; i < 14; ++i) *(u32x4_t*)(B_ + lo[i]) = R[i]; } while (0)
    GS_LOAD(R0, 0); GS_WRITE(R0, 0);
    GS_LOAD(R1, 1); GS_LOAD(R2, 2);
    __syncthreads();
#pragma unroll 1
    for (int pc = 0; pc < NCH; pc += 3) {
      GS_LOAD(R0, pc + 3); GS_WRITE(R1, pc + 1); __syncthreads();
      GS_LOAD(R1, pc + 4); GS_WRITE(R2, pc + 2); __syncthreads();
      GS_LOAD(R2, pc + 5); GS_WRITE(R0, pc + 3); __syncthreads();
    }
#undef GS_LOAD
#undef GS_WRITE
  }
}

__device__ __forceinline__ void phase_gdn_fin(const Params& p, int l, int rb, int re, int rstep) {
  const int tid = tidx(), lane = tid & 63, wid = tid >> 6;
  const float* GO = (const float*)(p.ws + WS_GO);
  const bf16_t* Z = (const bf16_t*)(p.ws + WS_Z); bf16_t* MIX = (bf16_t*)(p.ws + WS_MIX);
  const int c0 = lane * 8;
  float on[8];
#pragma unroll
  for (int e = 0; e < 8; ++e) on[e] = p.onorm_b[l * 128 + (c0 & 127) + e];
  for (int r = rb + wid; r < re; r += rstep) {
    if (l == NL - 1 && r < TC) continue;
    const int hh = lane >> 4, sl = (lane >> 1) & 7, off = (lane & 1) * 8;
    const float* g0 = GO + ((size_t)((0 * 4 + hh) * 8 + sl) * TA + r) * 16 + off;
    const float* g1 = GO + ((size_t)((1 * 4 + hh) * 8 + sl) * TA + r) * 16 + off;
    const float4 a0 = *(const float4*)g0, a1 = *(const float4*)(g0 + 4);
    const float4 b0 = *(const float4*)g1, b1 = *(const float4*)(g1 + 4);
    float v[8] = {a0.x + b0.x, a0.y + b0.y, a0.z + b0.z, a0.w + b0.w, a1.x + b1.x, a1.y + b1.y, a1.z + b1.z, a1.w + b1.w};
    float ss = 0.f;
#pragma unroll
    for (int e = 0; e < 8; ++e) ss += v[e] * v[e];
    ss += __shfl_xor(ss, 1); ss += __shfl_xor(ss, 2); ss += __shfl_xor(ss, 4); ss += __shfl_xor(ss, 8);
    const float rstd = rsqrtf(ss * (1.f / 128.f) + 1e-6f);
    const bf16x8_t gv = *(const bf16x8_t*)(Z + (size_t)r * ZLD + ZC_GB + c0);
    float f[8];
#pragma unroll
    for (int e = 0; e < 8; ++e) f[e] = v[e] * rstd * on[e] * siluf_(bf2f((bf16_t)gv[e]));
    u32x4_t w = {cvtpk2(f[0], f[1]), cvtpk2(f[2], f[3]), cvtpk2(f[4], f[5]), cvtpk2(f[6], f[7])};
    *(u32x4_t*)(MIX + (size_t)r * DM + 512 + c0) = w;
  }
}

constexpr int ATT_ITEMS = 512;
__device__ __forceinline__ void attn_item(const Params& p, int it, unsigned char* smem) {
  const bf16_t* QB = (const bf16_t*)(p.ws + WS_QB); const bf16_t* KB = (const bf16_t*)(p.ws + WS_KB); const bf16_t* VB = (const bf16_t*)(p.ws + WS_VB);
  int head, r0, seq, k0, split;
  if (it < ATT_ITEMS) { const int half = it >> 8, idx = it & 255; split = half * 3; head = idx >> 5; r0 = TC + (idx & 31) * 256; seq = half ? 52 * 64 : 80 * 64; k0 = half ? 80 * 64 : 0; }
  else { split = 0; head = it - ATT_ITEMS; r0 = 0; seq = TC; k0 = 0; }
  const int kvh = head >> 2;
  bf16_t* OUT = (bf16_t*)(p.ws + WS_PO) + ((size_t)split * TA + r0) * 1024 + head * 128;
  float* ML = (float*)(p.ws + WS_ML) + (((size_t)split * TA + r0) * 8 + head) * 2;
  __syncthreads();
  att::attn_dense_body(QB + (size_t)r0 * 1024 + head * 128, KB + (size_t)k0 * 256 + kvh * 128, VB + (size_t)k0 * 256 + kvh * 128, ML, OUT, seq, (char*)smem);
}
__device__ void attn_queue(const Params& p, int l, unsigned char* smem) {
  unsigned* ctr = (unsigned*)(p.ws + WS_CTR) + l;
  volatile int* slot = (volatile int*)(smem + 144000);
  for (;;) {
    __syncthreads();
    if (tidx() == 0) *slot = (int)atomicAdd(ctr, 1u);
    __syncthreads();
    const int it = *slot;
    if (it >= ATT_ITEMS) break;
    attn_item(p, it, smem);
  }
}

__device__ __forceinline__ void phase_attn_gate(const Params& p, int l, int rb, int re, int rstep) {
  const int tid = tidx(), lane = tid & 63, wid = tid >> 6;
  const bf16_t* Z = (const bf16_t*)(p.ws + WS_Z); bf16_t* MIX = (bf16_t*)(p.ws + WS_MIX); const bf16_t* PO = (const bf16_t*)(p.ws + WS_PO);
  const float* ML = (const float*)(p.ws + WS_ML);
  constexpr float C = 0.088388347648318440f * 1.4426950408889634f;
  for (int r = rb + wid; r < re; r += rstep) {
    if (l == NL - 1 && r < TC) continue;
#pragma unroll
    for (int hlf = 0; hlf < 2; ++hlf) {
      const int c0 = hlf * 512 + lane * 8, head = c0 >> 7;
      const bf16x8_t gv = *(const bf16x8_t*)(Z + (size_t)r * ZLD + ZC_GC + c0);
      float f[8];
      if (r >= TC) {
        float2 st[NSPLIT]; float mm = -3.0e38f;
#pragma unroll
        for (int k = 0; k < NSPLIT; ++k) { const bool use = k % 3 == 0;
          st[k] = use ? *(const float2*)(ML + (((size_t)k * TA + r) * 8 + head) * 2) : make_float2(-3.0e38f, 0.f); mm = fmaxf(mm, st[k].x); }
        float wsum = 0.f;
#pragma unroll
        for (int e = 0; e < 8; ++e) f[e] = 0.f;
#pragma unroll
        for (int k = 0; k < NSPLIT; ++k) {
          if (k % 3 == 0) {
            const float w = st[k].y * exp2f((st[k].x - mm) * C); wsum += w;
            const bf16x8_t ov = *(const bf16x8_t*)(PO + ((size_t)k * TA + r) * 1024 + c0);
#pragma unroll
            for (int e = 0; e < 8; ++e) f[e] += bf2f((bf16_t)ov[e]) * w;
          }
        }
        const float inv = 1.f / wsum;
#pragma unroll
        for (int e = 0; e < 8; ++e) f[e] *= inv * siluf_(bf2f((bf16_t)gv[e]));
      } else {
        const bf16x8_t ov = *(const bf16x8_t*)(PO + (size_t)r * 1024 + c0);
#pragma unroll
        for (int e = 0; e < 8; ++e) f[e] = bf2f((bf16_t)ov[e]) * siluf_(bf2f((bf16_t)gv[e]));
      }
      u32x4_t w = {cvtpk2(f[0], f[1]), cvtpk2(f[2], f[3]), cvtpk2(f[4], f[5]), cvtpk2(f[6], f[7])};
      *(u32x4_t*)(MIX + (size_t)r * DM + 1024 + c0) = w;
    }
  }
}

template <int S>
__device__ __forceinline__ void run_phase(const Params& p0, int l, unsigned char* smem) {
  Params p = p0;
  { unsigned long long w_ = (unsigned long long)p.ws; asm volatile("" : "+s"(w_)); p.ws = (unsigned char*)w_; }
  const int bid = bidx();
  if constexpr (S == 0) phase_prep0(p, smem);
  else if constexpr (S == 1) phase_norm(p, l);
  else if constexpr (S == 2) {
    pg8::Gemm g; g.A = (const bf16_t*)(p.ws + WS_XN); g.Bt = (const bf16_t*)(p.ws + WS_WIN) + (size_t)l * ZLD * DM; g.M = TA; g.N = ZLD; g.K = DM; g.ld = DM;
    pg8::StaticOrder So; So.init(g.M, g.N, (int)gridDim.x, bid);
    pg8::EpiZ E; E.O = (bf16_t*)(p.ws + WS_Z); E.ldc = ZLD;
    pg8::gemm_phase<pg8::EpiZ, pg8::StaticOrder, false>((PG8_LAS unsigned char*)smem, g, So, E, nullptr);
  } else if constexpr (S == 3) {
    phase_qkprep(p, l);
    {
      unsigned* ctr = (unsigned*)(p.ws + WS_CTR) + 16 + l;
      volatile int* slot = (volatile int*)(smem + 144000);
      for (;;) {
        __syncthreads();
        if (tidx() == 0) *slot = (int)atomicAdd(ctr, 1u);
        __syncthreads();
        const int it = *slot;
        if (it >= NCH * 4 + NCH * 8) break;
        if (it < NCH * 4) gdn_local_item(p, l, it, smem); else lru_ab_item(p, l, it - NCH * 4, smem);
      }
    }
  }
  else if constexpr (S == 4) {
    if (bid < 16) gdn_scan(p, smem, bid & 7, bid >> 3);
    else if (bid < 18) lru_carry(p, bid - 16);
    else if (bid < 26) { if (l != NL - 1) attn_item(p, ATT_ITEMS + bid - 18, smem); }
    attn_queue(p, l, smem);
    if (l + 1 < NL) convert_queue(p, l + 1, smem);
  }
  else if constexpr (S == 5) { }
  else if constexpr (S == 6) {
    unsigned* ctr = (unsigned*)(p.ws + WS_CTR) + 24 + l;
    volatile int* slot = (volatile int*)(smem + 144000);
    const int first = (l == NL - 1) ? 4 : 0;
    for (;;) {
      __syncthreads();
      if (tidx() == 0) *slot = (int)atomicAdd(ctr, 1u);
      __syncthreads();
      const int it = *slot + first;
      if (it >= NCH + TA / 32) break;
      if (it < NCH) lru_fin_item(p, l, it);
      else { const int r0 = (it - NCH) * 32; if (l == NL - 1 && r0 < TC) continue; phase_gdn_fin(p, l, r0, r0 + 32, 8); phase_attn_gate(p, l, r0, r0 + 32, 8); }
    }
  }
  else if constexpr (S == 7) {
    const bool last = (l == NL - 1);
    const float* mod = (const float*)(p.ws + WS_MOD) + (size_t)l * 2 * 6144;
    {
      pg8::Gemm g; g.A = (const bf16_t*)(p.ws + WS_MIX) + (size_t)TC * DM; g.Bt = (const bf16_t*)(p.ws + WS_WOUT) + (size_t)l * DM * DM;
      g.M = TL; g.N = DM; g.K = DM; g.ld = DM;
      pg8::StaticOrder So; So.init(g.M, g.N, (int)gridDim.x, bid);
      pg8::EpiRes E; E.H = (float*)(p.ws + WS_H); E.gate_lat = mod + 4096; E.gate_ctx = mod + 6144 + 4096; E.row_off = TC;
      pg8::gemm_phase<pg8::EpiRes, pg8::StaticOrder, false>((PG8_LAS unsigned char*)smem, g, So, E, nullptr);
    }
    if (!last) {
      const int G_ = (int)gridDim.x;
#pragma unroll 1
      for (int kq = 0; kq < 4; ++kq) {
        pg8::Gemm g; g.A = (const bf16_t*)(p.ws + WS_MIX) + kq * 512; g.Bt = (const bf16_t*)(p.ws + WS_WOUT) + (size_t)l * DM * DM + kq * 512;
        g.M = TC; g.N = DM; g.K = 512; g.ld = DM;
        pg8::StaticOrder So; So.init(g.M, g.N, G_, (bid - 8 * kq - 8 + 2 * G_) % G_);
        pg8::EpiResAtomic E; E.H = (float*)(p.ws + WS_H); E.gate = mod + 6144 + 4096;
        pg8::gemm_phase<pg8::EpiResAtomic, pg8::StaticOrder, false>((PG8_LAS unsigned char*)smem, g, So, E, nullptr);
      }
    }
  } else phase_final(p);
}

#ifdef MK_MULTI
template <int S>
__global__ __launch_bounds__(512, 2) void k_phase(Params p, int l) {
  extern __shared__ __attribute__((aligned(16))) unsigned char smem[];
  run_phase<S>(p, l, smem);
}
#else
__global__ __launch_bounds__(512, 2) void hybrid_fwd(Params p) {
  extern __shared__ __attribute__((aligned(16))) unsigned char smem[];
  cg::grid_group grid = cg::this_grid();
  volatile LAS unsigned* xst = (volatile LAS unsigned*)(smem + (LDS_BYTES - 16));
  if (threadIdx.x == 0) { xst[0] = 0u; xst[1] = 0u; }
  __syncthreads();
  const XcdBarrier xb = xcd_barrier_post((unsigned*)(p.ws + WS_BAR), xst);
#define GSYNC() xcd_barrier(xb)
  run_phase<0>(p, 0, smem); grid.sync();
#ifndef REP1
#define REP1 1
#endif
#ifndef REP2
#define REP2 1
#endif
#ifndef REP3
#define REP3 1
#endif
#ifndef REP4
#define REP4 1
#endif
#ifndef REP5
#define REP5 1
#endif
#ifndef REP6
#define REP6 1
#endif
#ifndef REPSYNC
#define REPSYNC 0
#endif
#pragma unroll 1
  for (int l = 0; l < NL; ++l) {
#pragma unroll 1
    for (int r = 0; r < REP1; ++r) { run_phase<1>(p, l, smem); GSYNC(); }
#pragma unroll 1
    for (int r = 0; r < REP2; ++r) { run_phase<2>(p, l, smem); GSYNC(); }
#pragma unroll 1
    for (int r = 0; r < REP3; ++r) { run_phase<3>(p, l, smem); GSYNC(); }
#pragma unroll 1
    for (int r = 0; r < REP4; ++r) { run_phase<4>(p, l, smem); GSYNC(); }
#pragma unroll 1
    for (int r = 0; r < REP6; ++r) { run_phase<6>(p, l, smem); GSYNC(); }
#pragma unroll 1
    for (int r = 0; r < REPSYNC; ++r) GSYNC();
    run_phase<7>(p, l, smem); GSYNC();
  }
  run_phase<8>(p, 0, smem);
}
#endif

template <class K> static bool set_lds(K k) { return hipFuncSetAttribute((const void*)k, hipFuncAttributeMaxDynamicSharedMemorySize, LDS_BYTES) == hipSuccess; }

extern "C" void kernel_launch(void* const* d_in, const int* in_sizes, int n_in, void* d_out, int out_size, void* d_ws, size_t ws_size, hipStream_t stream) {
  static int grid = 0;
  if (grid == 0) {
    if (n_in != 23 || out_size != TL * DM || ws_size < WS_END) { fprintf(stderr, "kernel_launch: unexpected shapes (n_in %d out %d ws %zu need %zu)\n", n_in, out_size, ws_size, (size_t)WS_END); grid = -1; return; }
    int dev = 0, cus = 0;
    (void)hipGetDevice(&dev); (void)hipDeviceGetAttribute(&cus, hipDeviceAttributeMultiprocessorCount, dev);
    bool ok = true;
#ifdef MK_MULTI
    ok = ok && set_lds(k_phase<0>) && set_lds(k_phase<1>) && set_lds(k_phase<2>) && set_lds(k_phase<3>) && set_lds(k_phase<4>) && set_lds(k_phase<5>) && set_lds(k_phase<6>) && set_lds(k_phase<7>) && set_lds(k_phase<8>);
#else
    ok = ok && set_lds(hybrid_fwd);
    int per_cu = 0; (void)hipOccupancyMaxActiveBlocksPerMultiprocessor(&per_cu, (const void*)hybrid_fwd, 512, LDS_BYTES); (void)hipGetLastError();
    if (per_cu < 1) fprintf(stderr, "kernel_launch: occupancy query says %d blocks per CU\n", per_cu);
#endif
    if (!ok) { fprintf(stderr, "kernel_launch: hipFuncSetAttribute failed\n"); grid = -1; return; }
    grid = cus > 0 ? cus : 256;
  }
  if (grid < 0) return;
  Params p{};
  const float** pp = (const float**)&p;
  for (int i = 0; i < 23; ++i) pp[i] = (const float*)d_in[i];
  p.out = (float*)d_out; p.ws = (unsigned char*)d_ws;
#ifdef MK_MULTI
#define LAUNCH(S, l) hipLaunchKernelGGL(k_phase<S>, dim3(grid), dim3(512), LDS_BYTES, stream, p, l)
  LAUNCH(0, 0);
  for (int l = 0; l < NL; ++l) { LAUNCH(1, l); LAUNCH(2, l); LAUNCH(3, l); LAUNCH(4, l); LAUNCH(6, l); LAUNCH(7, l); }
  LAUNCH(8, 0);
#else
  (void)hipMemsetAsync((unsigned char*)d_ws + WS_CTR, 0, 256 + 16384, stream);
  void* args[] = {&p};
  hipError_t e = hipLaunchCooperativeKernel((const void*)hybrid_fwd, dim3(grid), dim3(512), args, LDS_BYTES, stream);
  if (e != hipSuccess) fprintf(stderr, "cooperative launch failed: %s (grid %d)\n", hipGetErrorString(e), grid);
#endif
}
```

```cpp
#include <hip/hip_runtime.h>
#include <hip/hip_cooperative_groups.h>
#include <cstdio>
namespace cg = cooperative_groups;

typedef unsigned short bf16_t;
typedef short bf16x8_t __attribute__((ext_vector_type(8)));
typedef float f32x4_t __attribute__((ext_vector_type(4)));
typedef unsigned u32x4_t __attribute__((ext_vector_type(4)));
typedef unsigned u32x2_t __attribute__((ext_vector_type(2)));

constexpr int DM = 2048, TL = 8192, TC = 256, TA = 8448, NL = 4;
constexpr int DIN = 5648, ZLD = 5888, NCH = 132;
constexpr int ZC_XA = 0, ZC_GA = 512, ZC_QKVB = 1024, ZC_GB = 2560, ZC_QC = 3072, ZC_KC = 4096, ZC_VC = 4352, ZC_GC = 4608, ZC_BETA = 5632, ZC_ALPHA = 5640;
constexpr int LDS_BYTES = 147456;

constexpr size_t al256(size_t x) { return (x + 255) / 256 * 256; }
constexpr size_t WS_H    = 0;
constexpr size_t WS_XN   = WS_H    + al256((size_t)TA * DM * 4);
constexpr size_t WS_Z    = WS_XN   + al256((size_t)TA * DM * 2);
constexpr size_t WS_MIX  = WS_Z    + al256((size_t)TA * ZLD * 2);
constexpr size_t WS_QB   = WS_MIX  + al256((size_t)TA * DM * 2);
constexpr size_t WS_KB   = WS_QB   + al256((size_t)TA * 1024 * 2);
constexpr size_t WS_VB   = WS_KB   + al256((size_t)TA * 256 * 2);
constexpr size_t WS_WIN  = WS_VB   + al256((size_t)TA * 256 * 2);
constexpr size_t WS_WOUT = WS_WIN  + al256((size_t)NL * ZLD * DM * 2);
constexpr size_t WS_MOD  = WS_WOUT + al256((size_t)NL * DM * DM * 2);
constexpr size_t WS_WG   = WS_MOD  + al256((size_t)NL * 2 * 6144 * 4);
constexpr size_t WS_LA   = WS_WG   + al256((size_t)NL * 2 * 2 * 8 * 4096 * 2);
constexpr size_t WS_LB   = WS_LA   + al256((size_t)2 * TA * 512 * 4);
constexpr size_t WS_LSEG = WS_LB   + al256((size_t)2 * TA * 512 * 4);
constexpr size_t WS_LCAR = WS_LSEG + al256((size_t)2 * NCH * 512 * 2 * 4);
constexpr size_t GREC_BYTES = 57344;
constexpr size_t WS_GREC = WS_LCAR + al256((size_t)2 * NCH * 512 * 4);
constexpr size_t WS_GU   = WS_GREC + al256((size_t)8 * NCH * GREC_BYTES);
constexpr size_t WS_GGL  = WS_GU   + al256((size_t)8 * NCH * 8192 * 4);
constexpr size_t WS_GO   = WS_GGL  + al256((size_t)8 * NCH * 4);
constexpr int NSPLIT = 6, SPLIT_KEYS = TA / NSPLIT;
constexpr size_t WS_PO   = WS_GO   + al256((size_t)2 * TA * 512 * 4);
constexpr size_t WS_ML   = WS_PO   + al256((size_t)NSPLIT * TA * 1024 * 2);
constexpr size_t WS_CTR  = WS_ML   + al256((size_t)NSPLIT * TA * 16 * 4);
constexpr size_t WS_BAR  = WS_CTR  + 256;
constexpr size_t WS_END  = WS_BAR  + 16384;

struct Params {
  const float *x, *c, *ctx, *c_ctx, *norm_g, *w_mod, *b_mod, *w_in, *conv_a_w, *conv_a_b, *w_ra, *b_ra, *w_ia, *b_ia, *lam_a,
              *conv_b_w, *a_log_b, *dt_bias_b, *onorm_b, *qn_c, *kn_c, *w_out, *final_g;
  float* out; unsigned char* ws;
};

__device__ __forceinline__ unsigned cvtpk2(float lo, float hi) { unsigned r; asm volatile("v_cvt_pk_bf16_f32 %0, %1, %2" : "=v"(r) : "v"(lo), "v"(hi)); return r; }
__device__ __forceinline__ bf16_t f2bf(float x) { return (bf16_t)(cvtpk2(x, 0.f) & 0xffffu); }
__device__ __forceinline__ float bf2f(bf16_t b) { return __uint_as_float(((unsigned)b) << 16); }
__device__ __forceinline__ float fexp_(float x) { return __builtin_amdgcn_exp2f(x * 1.4426950408889634f); }
__device__ __forceinline__ float sigmoidf_(float x) { return __builtin_amdgcn_rcpf(1.f + fexp_(-x)); }
__device__ __forceinline__ float siluf_(float x) { return x * __builtin_amdgcn_rcpf(1.f + fexp_(-x)); }
__device__ __forceinline__ float softplusf_(float x) { return fmaxf(x, 0.f) + log1pf(expf(-fabsf(x))); }
__device__ __forceinline__ float wave_sum(float v) {
#pragma unroll
  for (int o = 32; o >= 1; o >>= 1) v += __shfl_xor(v, o);
  return v;
}
__device__ __forceinline__ bf16x8_t pack8(f32x4_t a, f32x4_t b) {
  u32x4_t w = {cvtpk2(a[0], a[1]), cvtpk2(a[2], a[3]), cvtpk2(b[0], b[1]), cvtpk2(b[2], b[3])};
  return *reinterpret_cast<bf16x8_t*>(&w);
}

__device__ __forceinline__ int tidx() { int t = (int)__builtin_amdgcn_workitem_id_x(); asm volatile("" : "+v"(t)); return t; }
__device__ __forceinline__ int bidx() { int b = (int)__builtin_amdgcn_workgroup_id_x(); asm volatile("" : "+s"(b)); return b; }
namespace pg8 {
#define PG8_LAS __attribute__((address_space(3)))
typedef unsigned short bf16_t;
typedef short bf16x8 __attribute__((ext_vector_type(8)));
typedef float f32x4 __attribute__((ext_vector_type(4)));
typedef unsigned u32x4 __attribute__((ext_vector_type(4)));
constexpr int BM = 256, BK = 64, HALF = 128, HTB = HALF * BK * 2  , STAGE_BYTES = 8 * HTB, NXCD = 8, WGM = 8;

__host__ __device__ __forceinline__ int lds_byte(int r, int c) { const int st = (r >> 4) * 2 + (c >> 5), rr = r & 15, cc = c & 31, ob = rr * 64 + cc * 2; return st * 1024 + (ob ^ (((ob >> 9) & 1) << 5)); }
__host__ __device__ __forceinline__ void stage_rc(int b, int& R, int& C) { const int st = b / 1024, sb = b % 1024, swz = sb ^ (((sb >> 9) & 1) << 5); R = (st >> 1) * 16 + swz / 64; C = (st & 1) * 32 + (swz % 64) / 2; }
__host__ __device__ __forceinline__ int perm32(int rho) { const int n = rho >> 4, i = rho & 15; return 8 * (i >> 2) + 4 * n + (i & 3); }

struct Unit { int pm, pn; };
struct Gemm { const bf16_t* A; const bf16_t* Bt; int M, N, K, ld; };

struct StaticOrder {
    int nM, nN, nwg, G, c;
    __host__ __device__ void init(int M, int N, int G_, int c_) { nM = M / BM; nN = N / BM; nwg = nM * nN; G = G_; c = c_; }
    __host__ __device__ bool next(int i, Unit& u) const {
        const long L = (long)i * G + c; if (L >= nwg) return false;
        int wgid = (int)L; { const int q = nwg / NXCD, r = nwg % NXCD, xcd = wgid % NXCD, off = wgid / NXCD; wgid = (xcd < r ? xcd * (q + 1) : r * (q + 1) + (xcd - r) * q) + off; }
        const int nig = WGM * nN, gid = wgid / nig, fm = gid * WGM, gsz = (nM - fm) < WGM ? (nM - fm) : WGM;
        u.pm = fm + ((wgid % nig) % gsz); u.pn = (wgid % nig) / gsz; return true;
    }
    __device__ __forceinline__ void a_ready(const Unit&) const {}
    __device__ __forceinline__ void done(const Unit&) const {}
};
__device__ __forceinline__ unsigned cvt_pk_bf16(float lo, float hi) { unsigned r; asm volatile("v_cvt_pk_bf16_f32 %0, %1, %2" : "=v"(r) : "v"(lo), "v"(hi)); return r; }
template <class Epi, class Sched, bool STAMP = false>
__device__ __forceinline__ void gemm_phase(PG8_LAS unsigned char* lds, const Gemm g, const Sched& S, const Epi& E, unsigned long long* stamps) {
    const int tid = tidx(), wid = __builtin_amdgcn_readfirstlane(tid >> 6), lane = tid & 63, wr = wid >> 2, wc = wid & 3, fr = lane & 15, fq = lane >> 4;
    const int K = g.K, nt = K / BK;
    int ts_lo = 0, ts_hi = 0, nts = 0; const unsigned long long rt_entry = STAMP ? (unsigned long long)wall_clock64() : 0ull;
#define PG8_STAMP() do { if (STAMP && wid == 0 && nts < 64) { const unsigned long long _c = (unsigned long long)clock64(); \
        ts_lo = (lane == nts) ? (int)(unsigned)_c : ts_lo; ts_hi = (lane == nts) ? (int)(unsigned)(_c >> 32) : ts_hi; ++nts; } } while (0)
    PG8_STAMP();
    unsigned voffA[2], voffB[2];
#pragma unroll
    for (int i = 0; i < 2; ++i) { int R, C; stage_rc(tid * 16 + i * 8192, R, C); const int Rb = Epi::PERM ? ((R & ~31) + perm32(R & 31)) : R;
        voffA[i] = (unsigned)(R * g.ld + C) * 2u; voffB[i] = (unsigned)(Rb * g.ld + C) * 2u; }
    const size_t kstep = (size_t)(BK * 2);
    const size_t hstep = (size_t)HALF * g.ld * 2;
    const size_t tstep = 2 * hstep;
    const unsigned ldsw = (unsigned)wid * 1024u;
    const int aoff = lds_byte(wr * 64 + fr, fq * 8), boff = lds_byte(wc * 32 + fr, fq * 8);
#define PG8_SA(b, h) (((b) * 2 + (h)) * HTB)
#define PG8_SB(b, h) ((4 + (b) * 2 + (h)) * HTB)
#define PG8_STAGE(bufoff, gbase, voff) do { _Pragma("unroll") for (int _i = 0; _i < 2; ++_i) \
        __builtin_amdgcn_global_load_lds((const unsigned*)((const char*)(gbase) + (voff)[_i]), (PG8_LAS unsigned*)(lds + (bufoff) + ldsw + _i * 8192), 16, 0, 0); } while (0)
#define PG8_LDA(dst, b, h) do { _Pragma("unroll") for (int m = 0; m < 4; ++m) _Pragma("unroll") for (int k = 0; k < 2; ++k) dst[m][k] = *(const PG8_LAS bf16x8*)(lds + PG8_SA(b, h) + aoff + m * 2048 + k * 1024); } while (0)
#define PG8_LDB(dst, b, h) do { _Pragma("unroll") for (int n = 0; n < 2; ++n) _Pragma("unroll") for (int k = 0; k < 2; ++k) dst[n][k] = *(const PG8_LAS bf16x8*)(lds + PG8_SB(b, h) + boff + n * 2048 + k * 1024); } while (0)
#define PG8_MMA(ai, bj, At, Bt) do { __builtin_amdgcn_s_setprio(1); _Pragma("unroll") for (int m = 0; m < 4; ++m) _Pragma("unroll") for (int n = 0; n < 2; ++n) _Pragma("unroll") for (int k = 0; k < 2; ++k) \
        acc[ai][bj][m][n] = __builtin_amdgcn_mfma_f32_16x16x32_bf16(Bt[n][k], At[m][k], acc[ai][bj][m][n], 0, 0, 0); __builtin_amdgcn_s_setprio(0); } while (0)
#define PG8_WAIT_V(n) asm volatile("s_waitcnt vmcnt(" #n ")" ::: "memory")
#define PG8_WAIT_L(n) asm volatile("s_waitcnt lgkmcnt(" #n ")" ::: "memory")
#define PG8_BAR __builtin_amdgcn_s_barrier()
#define PG8_SCHED __builtin_amdgcn_sched_barrier(0)
    Unit cur, nxt; int ui = 0;
    if (!S.next(0, cur)) return;
    f32x4 acc[2][2][4][2];
#pragma unroll
    for (int a = 0; a < 2; ++a)
#pragma unroll
        for (int b = 0; b < 2; ++b)
#pragma unroll
            for (int m = 0; m < 4; ++m)
#pragma unroll
                for (int n = 0; n < 2; ++n) acc[a][b][m][n] = (f32x4){0.f, 0.f, 0.f, 0.f};
    bf16x8 At[4][2], B0[2][2], B1[2][2];
    const char* cA = (const char*)g.A + (size_t)cur.pm * tstep; const char* cB = (const char*)g.Bt + (size_t)cur.pn * tstep;
    S.a_ready(cur);
    PG8_STAGE(PG8_SB(0, 0), cB, voffB); PG8_STAGE(PG8_SA(0, 0), cA, voffA); PG8_STAGE(PG8_SB(0, 1), cB + hstep, voffB); PG8_STAGE(PG8_SA(0, 1), cA + hstep, voffA);
    if (wr == 1) PG8_BAR;
    PG8_WAIT_V(4); PG8_BAR;
    PG8_STAGE(PG8_SB(1, 0), cB + kstep, voffB); PG8_STAGE(PG8_SA(1, 0), cA + kstep, voffA); PG8_STAGE(PG8_SB(1, 1), cB + hstep + kstep, voffB);
    PG8_WAIT_V(6); PG8_BAR;
    PG8_STAMP();
    for (;;) {
        const bool has_next = S.next(ui + 1, nxt);
        const char* nA = has_next ? (const char*)g.A + (size_t)nxt.pm * tstep : cA; const char* nB = has_next ? (const char*)g.Bt + (size_t)nxt.pn * tstep : cB;
        for (int t = 0; t < nt; t += 2) {
            const bool last = (t == nt - 2);
            const char* a1 = cA + (size_t)(t + 1) * kstep;
            const char* a2 = last ? nA : cA + (size_t)(t + 2) * kstep; const char* b2 = last ? nB : cB + (size_t)(t + 2) * kstep;
            const char* a3 = a2 + kstep; const char* b3 = b2 + kstep;
            if (last && has_next) S.a_ready(nxt);
            PG8_LDB(B0, 0, 0); PG8_SCHED; PG8_LDA(At, 0, 0); PG8_STAGE(PG8_SA(1, 1), a1 + hstep, voffA);
            PG8_WAIT_L(8); PG8_BAR; PG8_WAIT_L(0); PG8_MMA(0, 0, At, B0); PG8_BAR; PG8_SCHED;
            PG8_LDB(B1, 0, 1); PG8_STAGE(PG8_SB(0, 0), b2, voffB);
            PG8_BAR; PG8_WAIT_L(0); PG8_MMA(0, 1, At, B1); PG8_BAR;
            PG8_LDA(At, 0, 1); PG8_STAGE(PG8_SA(0, 0), a2, voffA);
            PG8_BAR; PG8_WAIT_L(0); PG8_MMA(1, 0, At, B0); PG8_BAR; PG8_SCHED;
            PG8_STAGE(PG8_SB(0, 1), b2 + hstep, voffB);
            PG8_WAIT_V(6); PG8_BAR; PG8_MMA(1, 1, At, B1); PG8_BAR;
            PG8_LDB(B0, 1, 0); PG8_SCHED; PG8_LDA(At, 1, 0); PG8_STAGE(PG8_SA(0, 1), a2 + hstep, voffA);
            PG8_WAIT_L(8); PG8_BAR; PG8_WAIT_L(0); PG8_MMA(0, 0, At, B0); PG8_BAR; PG8_SCHED;
            PG8_LDB(B1, 1, 1); PG8_STAGE(PG8_SB(1, 0), b3, voffB);
            PG8_BAR; PG8_WAIT_L(0); PG8_MMA(0, 1, At, B1); PG8_BAR;
            PG8_LDA(At, 1, 1); PG8_STAGE(PG8_SA(1, 0), a3, voffA);
            PG8_BAR; PG8_WAIT_L(0); PG8_MMA(1, 0, At, B0); PG8_BAR; PG8_SCHED;
            PG8_STAGE(PG8_SB(1, 1), b3 + hstep, voffB);
            PG8_WAIT_V(6); PG8_BAR; PG8_MMA(1, 1, At, B1); PG8_BAR;
        }
        PG8_STAMP();
        if constexpr (!Epi::AFTER_DRAIN) { E(acc, cur, wr, wc, fr, fq); S.done(cur); }
        PG8_STAMP();
        if (!has_next) break;
#pragma unroll
        for (int a = 0; a < 2; ++a)
#pragma unroll
            for (int b = 0; b < 2; ++b)
#pragma unroll
                for (int m = 0; m < 4; ++m)
#pragma unroll
                    for (int n = 0; n < 2; ++n) acc[a][b][m][n] = (f32x4){0.f, 0.f, 0.f, 0.f};
        cur = nxt; cA = nA; cB = nB; ++ui;
    }
    PG8_WAIT_V(0);
    if (wr == 0) PG8_BAR;
    PG8_BAR;
    if constexpr (Epi::AFTER_DRAIN) { E.fused(acc, cur, wr, wc, fr, fq, lds, wid, lane); S.done(cur); }
    PG8_STAMP();
    if (STAMP && wid == 0) { stamps[lane] = lane < nts ? (((unsigned long long)(unsigned)ts_hi << 32) | (unsigned)ts_lo) : 0ull;
        if (lane == 62) stamps[62] = rt_entry; if (lane == 63) stamps[63] = (unsigned long long)wall_clock64(); }
#undef PG8_STAMP
#undef PG8_SA
#undef PG8_SB
#undef PG8_STAGE
#undef PG8_LDA
#undef PG8_LDB
#undef PG8_MMA
#undef PG8_WAIT_V
#undef PG8_WAIT_L
#undef PG8_BAR
#undef PG8_SCHED
}
}
#define XB_TMO      128
#define XB_XCNT(j)  (256  + 64 * (j))
#define XB_XSUB(j)  (1280 + 64 * (j))
#define XB_XGEN(j)  (2304 + 64 * (j))
#define XB_TOP      3328
#define XB_TOPGEN   3392
#define XCD_BAR_WORDS 3456
#define XB_SPIN_CAP (1u << 18)
#define LAS __attribute__((address_space(3)))

__device__ __forceinline__ unsigned xb_ld(unsigned* p)              { return __hip_atomic_load(p, __ATOMIC_RELAXED, __HIP_MEMORY_SCOPE_AGENT); }
__device__ __forceinline__ unsigned xb_add(unsigned* p, unsigned v) { return __hip_atomic_fetch_add(p, v, __ATOMIC_RELAXED, __HIP_MEMORY_SCOPE_AGENT); }
__device__ __forceinline__ unsigned xb_xcc_id() { return (unsigned)__builtin_amdgcn_s_getreg((3 << 11) | 20) & 0xFu; }
#define XB_SPIN(cond, bar) do { unsigned _sp = 0; while (cond) { __builtin_amdgcn_s_sleep(1); \
    if ((++_sp & 255u) == 0u) { if (xb_ld(&(bar)[XB_TMO])) break; if (_sp > XB_SPIN_CAP) { atomicAdd(&(bar)[XB_TMO], 1u); break; } } } } while (0)

struct XcdBarrier {
    unsigned* bar; unsigned x;
    volatile LAS unsigned* st;
};

__device__ __forceinline__ XcdBarrier xcd_barrier_post(unsigned* bar, volatile LAS unsigned* st) {
    XcdBarrier b; b.bar = bar; b.x = xb_xcc_id(); b.st = st;
    if (threadIdx.x == 0) (void)xb_add(&bar[XB_XCNT(b.x)], 1u);
    return b;
}
__device__ __forceinline__ void xcd_barrier_complete(unsigned* bar, unsigned x, unsigned& nloc, unsigned& nx) {
    const unsigned G = gridDim.x * gridDim.y * gridDim.z;
    unsigned sum, cnt, mine, sp = 0u;
    for (;;) {
        sum = 0u; cnt = 0u; mine = 0u;
#pragma unroll
        for (unsigned j = 0; j < 16; ++j) { const unsigned c = xb_ld(&bar[XB_XCNT(j)]); sum += c; cnt += (c > 0u) ? 1u : 0u; mine = (j == x) ? c : mine; }
        if (sum == G) break;
        __builtin_amdgcn_s_sleep(1);
        if ((++sp & 255u) == 0u) { if (xb_ld(&bar[XB_TMO])) break; if (sp > XB_SPIN_CAP) { atomicAdd(&bar[XB_TMO], 1u); break; } }
    }
    nloc = mine > 0u ? mine : 1u; nx = cnt > 0u ? cnt : 1u;
}

__device__ __forceinline__ void xcd_barrier(const XcdBarrier& b) {
    asm volatile("s_waitcnt vmcnt(0)" ::: "memory");
    __syncthreads();
    if (threadIdx.x == 0) {
        unsigned* bar = b.bar;
        __builtin_amdgcn_s_waitcnt(0);
        unsigned nloc = b.st[0], nx = b.st[1];
        if (nloc == 0u) { xcd_barrier_complete(bar, b.x, nloc, nx); b.st[0] = nloc; b.st[1] = nx; }
        const unsigned old = xb_add(&bar[XB_XSUB(b.x)], 1u);
        const unsigned gen = old / nloc;
        if (old + 1u == (gen + 1u) * nloc) {
            __builtin_amdgcn_fence(__ATOMIC_RELEASE, "agent");
            asm volatile("s_waitcnt vmcnt(0)" ::: "memory");
            const unsigned og = xb_add(&bar[XB_TOP], 1u);
            const unsigned tg = og / nx;
            if (og + 1u == (tg + 1u) * nx) xb_add(&bar[XB_TOPGEN], 1u);
            else XB_SPIN(xb_ld(&bar[XB_TOPGEN]) == tg, bar);
            __builtin_amdgcn_fence(__ATOMIC_ACQUIRE, "agent");
            xb_add(&bar[XB_XGEN(b.x)], 1u);
            asm volatile("s_waitcnt vmcnt(0)" ::: "memory");
        } else {
            XB_SPIN(xb_ld(&bar[XB_XGEN(b.x)]) == gen, bar);
            __builtin_amdgcn_fence(__ATOMIC_ACQUIRE, "agent");
            asm volatile("s_waitcnt vmcnt(0)" ::: "memory");
        }
    }
    __syncthreads();
}
namespace pg8 {
struct EpiZ {
    static constexpr bool PERM = true, AFTER_DRAIN = false;
    bf16_t* O; int ldc;
    __device__ __forceinline__ void operator()(const f32x4 (&acc)[2][2][4][2], const Unit& u, int wr, int wc, int fr, int fq) const {
        const int row0 = u.pm * BM + wr * 64 + fr, col0 = u.pn * BM + wc * 32 + 8 * fq;
#pragma unroll
        for (int ai = 0; ai < 2; ++ai)
#pragma unroll
            for (int m = 0; m < 4; ++m) { bf16_t* rowp = O + (size_t)(row0 + ai * HALF + m * 16) * ldc + col0;
#pragma unroll
                for (int bj = 0; bj < 2; ++bj) { const f32x4 v0 = acc[ai][bj][m][0], v1 = acc[ai][bj][m][1];
                    u32x4 w; w.x = cvt_pk_bf16(v0[0], v0[1]); w.y = cvt_pk_bf16(v0[2], v0[3]); w.z = cvt_pk_bf16(v1[0], v1[1]); w.w = cvt_pk_bf16(v1[2], v1[3]);
                    *(u32x4*)(rowp + bj * HALF) = w; } }
    }
};
struct EpiRes {
    static constexpr bool PERM = false, AFTER_DRAIN = false;
    float* H; const float* gate_ctx; const float* gate_lat; int row_off;
    __device__ __forceinline__ void operator()(const f32x4 (&acc)[2][2][4][2], const Unit& u, int wr, int wc, int fr, int fq) const {
        const int row0 = row_off + u.pm * BM + wr * 64 + fr, col0 = u.pn * BM + wc * 32 + 4 * fq;
        const float* gt = (row_off + u.pm * BM) < 256 ? gate_ctx : gate_lat;
        f32x4 gv[2][2];
#pragma unroll
        for (int bj = 0; bj < 2; ++bj)
#pragma unroll
            for (int n = 0; n < 2; ++n) gv[bj][n] = *(const f32x4*)(gt + col0 + bj * HALF + n * 16);
#pragma unroll
        for (int ai = 0; ai < 2; ++ai)
#pragma unroll
            for (int m = 0; m < 4; ++m) { float* rowp = H + (size_t)(row0 + ai * HALF + m * 16) * 2048 + col0;
#pragma unroll
                for (int bj = 0; bj < 2; ++bj)
#pragma unroll
                    for (int n = 0; n < 2; ++n) { f32x4* q = (f32x4*)(rowp + bj * HALF + n * 16); *q = *q + gv[bj][n] * acc[ai][bj][m][n]; } }
    }
};
struct EpiResAtomic {
    static constexpr bool PERM = false, AFTER_DRAIN = false;
    float* H; const float* gate;
    __device__ __forceinline__ void operator()(const f32x4 (&acc)[2][2][4][2], const Unit& u, int wr, int wc, int fr, int fq) const {
        const int row0 = u.pm * BM + wr * 64 + fr, col0 = u.pn * BM + wc * 32 + 4 * fq;
#pragma unroll
        for (int bj = 0; bj < 2; ++bj)
#pragma unroll
            for (int n = 0; n < 2; ++n) { const f32x4 gv = *(const f32x4*)(gate + col0 + bj * HALF + n * 16);
#pragma unroll
                for (int ai = 0; ai < 2; ++ai)
#pragma unroll
                    for (int m = 0; m < 4; ++m) { float* q = H + (size_t)(row0 + ai * HALF + m * 16) * 2048 + col0 + bj * HALF + n * 16;
#pragma unroll
                        for (int j = 0; j < 4; ++j) atomicAdd(q + j, gv[j] * acc[ai][bj][m][n][j]); } }
    }
};
}

namespace att {
using bf16 = unsigned short;
constexpr int   D = 128, NW = 8, QBLK = 32, KVBLK = 64;
constexpr float SCALE = 0.088388347648318440f;
constexpr float THR = 8.f;
constexpr int SDEPTH = 2;
constexpr int LDQ = 1024, LDK = 256, LDV = 5888, LDG = 5888, LDO = 1024;
constexpr size_t SHM_V = KVBLK * D * 2, SHM_K = KVBLK * D * 2, SHM_ATTN = 2 * SHM_V + 2 * SHM_K + NW * 64 * 4;
using bf16x8 = __attribute__((ext_vector_type(8))) short;
using s16x4  = __attribute__((ext_vector_type(4))) short;
using f32x16 = __attribute__((ext_vector_type(16))) float;
using f32x8  = __attribute__((ext_vector_type(8))) float;
using u32x4  = __attribute__((ext_vector_type(4))) unsigned;
#define KSWZ(row, colB) ((row) * 256 + ((colB) ^ (((row) & 7) << 4)))
#define SBAR() __builtin_amdgcn_sched_barrier(0)
__device__ __forceinline__ int crow(int r, int hi) { return (r & 3) + 8 * (r >> 2) + 4 * hi; }
__device__ __forceinline__ unsigned cvtpk(float lo, float hi) {
  unsigned r; asm volatile("v_cvt_pk_bf16_f32 %0, %1, %2" : "=v"(r) : "v"(lo), "v"(hi)); return r;
}
template <typename TIn> struct Stage;
template <> struct Stage<bf16>  { using T = bf16x8;
  __device__ static __forceinline__ T ld8(const bf16* p) { return *reinterpret_cast<const bf16x8*>(p); }
  __device__ static __forceinline__ bf16x8 tobf(T x) { return x; } };
template <> struct Stage<float> { using T = f32x8;
  __device__ static __forceinline__ T ld8(const float* p) { return *reinterpret_cast<const f32x8*>(p); }
  __device__ static __forceinline__ bf16x8 tobf(T x) {
    u32x4 w = {cvtpk(x[0], x[1]), cvtpk(x[2], x[3]), cvtpk(x[4], x[5]), cvtpk(x[6], x[7])}; return *reinterpret_cast<bf16x8*>(&w); } };

__device__ __forceinline__ void partialSM(f32x16& p0, f32x16& p1, float& m_reg, float& mn, float& alpha) {
  constexpr float C = SCALE * 1.4426950408889634f;
  float pmax = p0[0]; for (int r = 1; r < 16; ++r) pmax = fmaxf(pmax, p0[r]); for (int r = 0; r < 16; ++r) pmax = fmaxf(pmax, p1[r]);
  { auto rr = __builtin_amdgcn_permlane32_swap(__float_as_uint(pmax), __float_as_uint(pmax), false, false);
    pmax = fmaxf(__uint_as_float(rr[0]), __uint_as_float(rr[1])); }
  if (__builtin_expect(__all(pmax - m_reg <= THR / SCALE), 1)) { mn = m_reg; alpha = 1.f; }
  else { mn = fmaxf(m_reg, pmax); alpha = __builtin_amdgcn_exp2f((m_reg - mn) * C); m_reg = mn; }
  float mnC = -mn * C;
  for (int r = 0; r < 16; ++r) p0[r] = fmaf(p0[r], C, mnC); for (int r = 0; r < 16; ++r) p1[r] = fmaf(p1[r], C, mnC);
  for (int r = 0; r < 16; ++r) p0[r] = __builtin_amdgcn_exp2f(p0[r]);
}
__device__ __forceinline__ void finishSM(f32x16& p0, f32x16& p1, float alpha, float& l_reg, bf16x8& pa0, bf16x8& pa1, bf16x8& pa2, bf16x8& pa3) {
  for (int r = 0; r < 16; ++r) p1[r] = __builtin_amdgcn_exp2f(p1[r]);
  float ps = 0; for (int r = 0; r < 16; ++r) ps += p0[r]; for (int r = 0; r < 16; ++r) ps += p1[r];
  { auto rr = __builtin_amdgcn_permlane32_swap(__float_as_uint(ps), __float_as_uint(ps), false, false);
    ps = __uint_as_float(rr[0]) + __uint_as_float(rr[1]); }
  l_reg = l_reg * alpha + ps;
#define PK4(P, BASE, OUT) do { unsigned a0 = cvtpk(P[BASE + 0], P[BASE + 1]), a1 = cvtpk(P[BASE + 2], P[BASE + 3]);   \
    unsigned b0 = cvtpk(P[BASE + 4], P[BASE + 5]), b1 = cvtpk(P[BASE + 6], P[BASE + 7]);                              \
    auto r0 = __builtin_amdgcn_permlane32_swap(a0, b0, false, false); auto r1 = __builtin_amdgcn_permlane32_swap(a1, b1, false, false); \
    u32x4 w = {r0[0], r1[0], r0[1], r1[1]}; OUT = *reinterpret_cast<bf16x8*>(&w); } while (0)
  PK4(p0, 0, pa0); PK4(p0, 8, pa1); PK4(p1, 0, pa2); PK4(p1, 8, pa3);
#undef PK4
}
__device__ __forceinline__ void qkt(f32x16& p0, f32x16& p1, const bf16* Ks, const bf16x8* qr, int r32, int hi) {
  p0 = f32x16{}; p1 = f32x16{};
  for (int d0 = 0; d0 < 8; ++d0) { int cb = (d0 * 16 + hi * 8) * 2;
    bf16x8 b0 = *reinterpret_cast<const bf16x8*>((const char*)Ks + KSWZ(r32, cb));
    bf16x8 b1 = *reinterpret_cast<const bf16x8*>((const char*)Ks + KSWZ(32 + r32, cb));
    p0 = __builtin_amdgcn_mfma_f32_32x32x16_bf16(b0, qr[d0], p0, 0, 0, 0);
    p1 = __builtin_amdgcn_mfma_f32_32x32x16_bf16(b1, qr[d0], p1, 0, 0, 0); }
}
__device__ __forceinline__ int v_st(int k, int c) { const int kk = (k & ~0xC) | ((k & 4) << 1) | ((k & 8) >> 1); return ((kk >> 3) * 4 + (c >> 5)) * 512 + ((kk & 7) * 32 + (c & 31)) * 2; }
__device__ __forceinline__ int v_rd_base(int lane) { return ((lane & 3) << 3) | (((lane >> 2) & 3) << 6) | (((lane >> 4) & 1) << 5) | (((lane >> 5) & 1) << 8); }
constexpr int v_rd_off(int d0, int ks, int half) { return d0 * 512 + ks * 4096 + half * 2048; }
template <int OFF> __device__ __forceinline__ s16x4 tr_read(int vb) {
  s16x4 r; asm volatile("ds_read_b64_tr_b16 %0, %1 offset:%2" : "=&v"(r) : "v"(vb), "i"(OFF) : "memory"); return r;
}
template <int D0> __device__ __forceinline__ void pv_one(f32x16& od, int vb, bf16x8 pa0, bf16x8 pa1, bf16x8 pa2, bf16x8 pa3) {
  const s16x4 l0 = tr_read<v_rd_off(D0, 0, 0)>(vb), h0 = tr_read<v_rd_off(D0, 0, 1)>(vb), l1 = tr_read<v_rd_off(D0, 1, 0)>(vb), h1 = tr_read<v_rd_off(D0, 1, 1)>(vb);
  const s16x4 l2 = tr_read<v_rd_off(D0, 2, 0)>(vb), h2 = tr_read<v_rd_off(D0, 2, 1)>(vb), l3 = tr_read<v_rd_off(D0, 3, 0)>(vb), h3 = tr_read<v_rd_off(D0, 3, 1)>(vb);
  asm volatile("s_waitcnt lgkmcnt(0)" ::: "memory"); SBAR();
#define PK(L, H) (bf16x8){L[0], L[1], L[2], L[3], H[0], H[1], H[2], H[3]}
  od = __builtin_amdgcn_mfma_f32_32x32x16_bf16(pa0, PK(l0, h0), od, 0, 0, 0);
  od = __builtin_amdgcn_mfma_f32_32x32x16_bf16(pa1, PK(l1, h1), od, 0, 0, 0);
  od = __builtin_amdgcn_mfma_f32_32x32x16_bf16(pa2, PK(l2, h2), od, 0, 0, 0);
  od = __builtin_amdgcn_mfma_f32_32x32x16_bf16(pa3, PK(l3, h3), od, 0, 0, 0);
#undef PK
}
__device__ __forceinline__ void pv_d0(f32x16* o, int vb, bf16x8 pa0, bf16x8 pa1, bf16x8 pa2, bf16x8 pa3) {
  pv_one<0>(o[0], vb, pa0, pa1, pa2, pa3); pv_one<1>(o[1], vb, pa0, pa1, pa2, pa3); pv_one<2>(o[2], vb, pa0, pa1, pa2, pa3); pv_one<3>(o[3], vb, pa0, pa1, pa2, pa3);
}
__device__ __forceinline__ void attn_dense_body(const bf16* __restrict__ Qb, const bf16* __restrict__ Kh, const bf16* __restrict__ Vh,
                                                float* __restrict__ ML, bf16* __restrict__ Mx, int seq, char* lds) {
  using TQ = bf16;
  using St = Stage<bf16>; using SQ = Stage<TQ>;
  const int tid = tidx(), wid = tid >> 6, lane = tid & 63, r32 = lane & 31, hi = lane >> 5;
  bf16* V_lds = (bf16*)lds; bf16* K_lds = (bf16*)(lds + 2 * SHM_V);
  float* ws = (float*)(lds + 2 * SHM_V + 2 * SHM_K) + wid * 64; float* li_l = ws; float* al_l = ws + 32;
  float m_reg = -1e30f, l_reg = 0; f32x16 o[4] = {}; bf16x8 qr[8];
  const TQ* Qw = Qb + (long)(wid * QBLK + r32) * LDQ + hi * 8;
#pragma unroll
  for (int d0 = 0; d0 < 8; ++d0) qr[d0] = SQ::tobf(SQ::ld8(Qw + d0 * 16));
  const int sr = tid >> 4, sc = (tid & 15) * 8, vst0 = v_st(sr, sc), vst1 = v_st(32 + sr, sc);
  const int vb0 = (int)(uintptr_t)V_lds + v_rd_base(lane);
  struct { typename St::T vs0, vs1, ks0, ks1; } sr_[SDEPTH];
#define SLOAD(i, k0) do { sr_[i].vs0 = St::ld8(&Vh[(long)((k0) + sr) * LDK + sc]); sr_[i].vs1 = St::ld8(&Vh[(long)((k0) + 32 + sr) * LDK + sc]); \
    sr_[i].ks0 = St::ld8(&Kh[(long)((k0) + sr) * LDK + sc]); sr_[i].ks1 = St::ld8(&Kh[(long)((k0) + 32 + sr) * LDK + sc]); } while (0)
#define SWRITE(b, i) do { *(bf16x8*)((char*)V_lds + (b) * SHM_V + vst0) = St::tobf(sr_[i].vs0);          \
    *(bf16x8*)((char*)V_lds + (b) * SHM_V + vst1) = St::tobf(sr_[i].vs1); int kc = sc * 2;               \
    *(bf16x8*)((char*)K_lds + (b) * SHM_K + KSWZ(sr, kc)) = St::tobf(sr_[i].ks0);                       \
    *(bf16x8*)((char*)K_lds + (b) * SHM_K + KSWZ(32 + sr, kc)) = St::tobf(sr_[i].ks1); } while (0)
#define SWAIT() do { if constexpr (SDEPTH == 2) asm volatile("s_waitcnt vmcnt(4)" ::: "memory"); else asm volatile("s_waitcnt vmcnt(0)" ::: "memory"); } while (0)
#define RESC(a) do { if (__any((a) < 1.f)) { if (hi == 0) al_l[r32] = (a); asm volatile("s_waitcnt lgkmcnt(0)" ::: "memory"); \
    for (int d = 0; d < 4; ++d) for (int r = 0; r < 16; ++r) o[d][r] *= al_l[crow(r, hi)]; } } while (0)
  f32x16 pA0, pA1, pB0, pB1; float mnA, mnB, alA, alB; bf16x8 pa0, pa1, pa2, pa3; const int NT = seq / KVBLK;
  constexpr int SE = 0, SO = SDEPTH - 1;
  SLOAD(SE, 0); asm volatile("s_waitcnt vmcnt(0)" ::: "memory"); SWRITE(0, SE); __syncthreads();
  qkt(pA0, pA1, K_lds, qr, r32, hi); partialSM(pA0, pA1, m_reg, mnA, alA);
  SLOAD(SO, KVBLK); if constexpr (SDEPTH == 2) { if (2 < NT) SLOAD(SE, 2 * KVBLK); }
  SWAIT(); SWRITE(1, SO); __syncthreads();
  for (int j = 1; j + 1 < NT; j += 2) {
    SBAR(); qkt(pB0, pB1, (bf16*)((char*)K_lds + SHM_K), qr, r32, hi);
    finishSM(pA0, pA1, alA, l_reg, pa0, pa1, pa2, pa3); SBAR();
    SLOAD(SO, (j + SDEPTH) * KVBLK); SBAR();
    pv_d0(o, vb0, pa0, pa1, pa2, pa3); partialSM(pB0, pB1, m_reg, mnB, alB);
    __syncthreads(); SWAIT(); SWRITE(0, SE);
    RESC(alB); __syncthreads();
    SBAR(); qkt(pA0, pA1, K_lds, qr, r32, hi);
    finishSM(pB0, pB1, alB, l_reg, pa0, pa1, pa2, pa3); SBAR();
    if (SDEPTH == 1 || j + 3 < NT) SLOAD(SE, (j + 1 + SDEPTH) * KVBLK); SBAR();
    pv_d0(o, vb0 + (int)SHM_V, pa0, pa1, pa2, pa3); partialSM(pA0, pA1, m_reg, mnA, alA);
    __syncthreads(); SWAIT(); SWRITE(1, SO);
    RESC(alA); __syncthreads();
  }
  SBAR(); qkt(pB0, pB1, (bf16*)((char*)K_lds + SHM_K), qr, r32, hi);
  finishSM(pA0, pA1, alA, l_reg, pa0, pa1, pa2, pa3); SBAR();
  pv_d0(o, vb0, pa0, pa1, pa2, pa3); partialSM(pB0, pB1, m_reg, mnB, alB);
  __syncthreads(); RESC(alB);
  finishSM(pB0, pB1, alB, l_reg, pa0, pa1, pa2, pa3); SBAR();
  pv_d0(o, vb0 + (int)SHM_V, pa0, pa1, pa2, pa3);
  if (hi == 0) { li_l[r32] = l_reg; if (ML != nullptr) { *(float2*)(ML + (long)(wid * QBLK + r32) * 16) = make_float2(m_reg, l_reg); } } asm volatile("s_waitcnt lgkmcnt(0)" ::: "memory");
  float rli[16];
#pragma unroll
  for (int r = 0; r < 16; ++r) rli[r] = __builtin_amdgcn_rcpf(li_l[crow(r, hi)]);
  bf16* Mw = Mx + (long)(wid * QBLK) * LDO;
#pragma unroll
  for (int r = 0; r < 16; ++r) { int orow = crow(r, hi);
#pragma unroll
    for (int d0 = 0; d0 < 4; ++d0) Mw[(long)orow * LDO + d0 * 32 + r32] = f2bf(o[d0][r] * rli[r]); }
#undef SLOAD
#undef SWRITE
#undef SWAIT
#undef RESC
}
}

constexpr int CV_NT_IN = 32 * 23, CV_NT_OUT = 32 * 8, CV_TILES = CV_NT_IN + CV_NT_OUT, CV_ITEMS = CV_TILES + 96;
__device__ __forceinline__ void convert_tile(const Params& p, int l, int r, unsigned char* smem) {
  const int tid = tidx();
  float* tile = (float*)smem;
  const bool isin = r < CV_NT_IN;
  const float* src; bf16_t* dst; int kt, nt, ldsrc;
  if (isin) { kt = r / 23; nt = r % 23; src = p.w_in + (size_t)l * DM * DIN; ldsrc = DIN; dst = (bf16_t*)(p.ws + WS_WIN) + (size_t)l * ZLD * DM; }
  else { r -= CV_NT_IN; kt = r / 8; nt = r % 8; src = p.w_out + (size_t)l * DM * DM; ldsrc = DM; dst = (bf16_t*)(p.ws + WS_WOUT) + (size_t)l * DM * DM; }
  __syncthreads();
  float4 v[8];
#pragma unroll
  for (int i = 0; i < 8; ++i) {
    const int e = tid + 512 * i, kk = e >> 6, n = nt * 256 + (e & 63) * 4;
    const int oc = isin ? (n < 3072 ? n : (n < 5632 ? n + 16 : (n < 5648 ? n - 2560 : -1))) : n;
    v[i] = oc >= 0 ? *(const float4*)(src + (size_t)(kt * 64 + kk) * ldsrc + oc) : make_float4(0.f, 0.f, 0.f, 0.f);
  }
#pragma unroll
  for (int i = 0; i < 8; ++i) { const int e = tid + 512 * i; *(float4*)(tile + (e >> 6) * 260 + (e & 63) * 4) = v[i]; }
  __syncthreads();
  {
    const int nn = tid >> 1, k0 = (tid & 1) * 32;
    bf16_t* d = dst + (size_t)(nt * 256 + nn) * DM + kt * 64 + k0;
#pragma unroll
    for (int q = 0; q < 4; ++q) {
      float f[8];
#pragma unroll
      for (int i = 0; i < 8; ++i) f[i] = tile[(k0 + q * 8 + i) * 260 + nn];
      u32x4_t w = {cvtpk2(f[0], f[1]), cvtpk2(f[2], f[3]), cvtpk2(f[4], f[5]), cvtpk2(f[6], f[7])};
      *(u32x4_t*)(d + q * 8) = w;
    }
  }
}
__device__ __forceinline__ void mod_item(const Params& p, int l, int jg, unsigned char* smem) {
  const int tid = tidx();
  float* sc = (float*)smem;
  float* red = (float*)smem + 4096;
  __syncthreads();
  for (int k = tid; k < 2048; k += 512) { sc[k] = siluf_(p.c[k]); sc[2048 + k] = siluf_(p.c_ctx[k]); }
  __syncthreads();
  float* mod = (float*)(p.ws + WS_MOD);
  const int cq = tid & 15, kg = tid >> 4, j0 = jg * 64;
  const float* wp = p.w_mod + ((size_t)l * DM + kg * 64) * 6144 + j0 + cq * 4;
  float4 a0 = {0.f, 0.f, 0.f, 0.f}, a1 = {0.f, 0.f, 0.f, 0.f};
#pragma unroll 16
  for (int k = 0; k < 64; ++k) {
    const float4 w = *(const float4*)(wp + (size_t)k * 6144);
    const float s0 = sc[kg * 64 + k], s1 = sc[2048 + kg * 64 + k];
    a0.x += s0 * w.x; a0.y += s0 * w.y; a0.z += s0 * w.z; a0.w += s0 * w.w;
    a1.x += s1 * w.x; a1.y += s1 * w.y; a1.z += s1 * w.z; a1.w += s1 * w.w;
  }
  *(float4*)(red + (kg * 2 + 0) * 64 + cq * 4) = a0;
  *(float4*)(red + (kg * 2 + 1) * 64 + cq * 4) = a1;
  __syncthreads();
  if (tid < 128) {
    const int s = tid >> 6, j = tid & 63; float acc = 0.f;
#pragma unroll 8
    for (int g = 0; g < 32; ++g) acc += red[(g * 2 + s) * 64 + j];
    mod[((size_t)l * 2 + s) * 6144 + j0 + j] = acc + p.b_mod[(size_t)l * 6144 + j0 + j];
  }
}
__device__ __forceinline__ void convert_item(const Params& p, int l, int it, unsigned char* smem) {
  if (it < CV_TILES) convert_tile(p, l, it, smem); else mod_item(p, l, it - CV_TILES, smem);
}
__device__ void convert_queue(const Params& p, int l, unsigned char* smem) {
  unsigned* ctr = (unsigned*)(p.ws + WS_CTR) + 8 + l;
  volatile int* slot = (volatile int*)(smem + 144000);
  for (;;) {
    __syncthreads();
    if (tidx() == 0) *slot = (int)atomicAdd(ctr, 1u);
    __syncthreads();
    const int it = *slot;
    if (it >= CV_ITEMS) break;
    convert_item(p, l, it, smem);
  }
  __syncthreads();
}
__device__ void phase_prep0(const Params& p, unsigned char* smem) {
  const int tid = tidx(), nb = gridDim.x, bid = bidx();
  {
    float4* h4 = (float4*)(p.ws + WS_H);
    const float4* c4 = (const float4*)p.ctx; const float4* x4 = (const float4*)p.x;
    const long nctx = (long)TC * DM / 4, ntot = (long)TA * DM / 4;
    for (long i = (long)bid * 512 + tid; i < ntot; i += (long)nb * 512) h4[i] = i < nctx ? c4[i] : x4[i - nctx];
  }
  for (int it = bid; it < CV_ITEMS; it += nb) convert_item(p, 0, it, smem);
  {
    bf16_t* wg = (bf16_t*)(p.ws + WS_WG);
    const int total = NL * 2 * 2 * 8 * 4096;
    for (int e = bid * 512 + tid; e < total; e += nb * 512) {
      const int i = e & 63, j = (e >> 6) & 63, n = (e >> 12) & 7, g = (e >> 15) & 1, d = (e >> 16) & 1, l = e >> 17;
      const float* src = g ? p.w_ia : p.w_ra;
      wg[e] = f2bf(src[((((size_t)l * 2 + d) * 8 + n) * 64 + i) * 64 + j]);
    }
  }
  __syncthreads();
}

__device__ void phase_norm(const Params& p, int l) {
  const int tid = tidx(), lane = tid & 63, wid = tid >> 6;
  const float* H = (const float*)(p.ws + WS_H);
  bf16_t* XN = (bf16_t*)(p.ws + WS_XN);
  const float* g = p.norm_g + (size_t)l * DM;
  const float* mod = (const float*)(p.ws + WS_MOD) + (size_t)l * 2 * 6144;
  for (int r = bidx() * 8 + wid; r < TA; r += gridDim.x * 8) {
    const float* hr = H + (size_t)r * DM;
    const float* md = mod + (r < TC ? 6144 : 0);
    float4 v[8]; float ss = 0.f;
#pragma unroll
    for (int i = 0; i < 8; ++i) { v[i] = *(const float4*)(hr + i * 256 + lane * 4); ss += v[i].x * v[i].x + v[i].y * v[i].y + v[i].z * v[i].z + v[i].w * v[i].w; }
    ss = wave_sum(ss);
    const float rstd = rsqrtf(ss * (1.f / DM) + 1e-6f);
#pragma unroll
    for (int i = 0; i < 8; ++i) {
      const int c = i * 256 + lane * 4;
      const float4 gg = *(const float4*)(g + c), sh = *(const float4*)(md + c), scl = *(const float4*)(md + 2048 + c);
      const float o0 = v[i].x * rstd * gg.x * (1.f + scl.x) + sh.x, o1 = v[i].y * rstd * gg.y * (1.f + scl.y) + sh.y;
      const float o2 = v[i].z * rstd * gg.z * (1.f + scl.z) + sh.z, o3 = v[i].w * rstd * gg.w * (1.f + scl.w) + sh.w;
      u32x2_t w = {cvtpk2(o0, o1), cvtpk2(o2, o3)};
      *(u32x2_t*)(XN + (size_t)r * DM + c) = w;
    }
  }
}

__device__ void phase_final(const Params& p) {
  const int tid = tidx(), lane = tid & 63, wid = tid >> 6;
  const float* H = (const float*)(p.ws + WS_H);
  for (int t = bidx() * 8 + wid; t < TL; t += gridDim.x * 8) {
    const float* hr = H + (size_t)(TC + t) * DM;
    float4 v[8]; float ss = 0.f;
#pragma unroll
    for (int i = 0; i < 8; ++i) { v[i] = *(const float4*)(hr + i * 256 + lane * 4); ss += v[i].x * v[i].x + v[i].y * v[i].y + v[i].z * v[i].z + v[i].w * v[i].w; }
    ss = wave_sum(ss);
    const float rstd = rsqrtf(ss * (1.f / DM) + 1e-6f);
#pragma unroll
    for (int i = 0; i < 8; ++i) {
      const int c = i * 256 + lane * 4;
      const float4 gg = *(const float4*)(p.final_g + c);
      float4 o = {v[i].x * rstd * gg.x, v[i].y * rstd * gg.y, v[i].z * rstd * gg.z, v[i].w * rstd * gg.w};
      *(float4*)(p.out + (size_t)t * DM + c) = o;
    }
  }
}

__device__ void phase_qkprep(const Params& p, int l) {
  const int tid = tidx(), lane = tid & 63, wid = tid >> 6;
  const bf16_t* Z = (const bf16_t*)(p.ws + WS_Z);
  bf16_t* QB = (bf16_t*)(p.ws + WS_QB); bf16_t* KB = (bf16_t*)(p.ws + WS_KB); bf16_t* VB = (bf16_t*)(p.ws + WS_VB);
  const float gq1 = p.qn_c[l * 128 + lane], gq2 = p.qn_c[l * 128 + 64 + lane];
  const float gk1 = p.kn_c[l * 128 + lane], gk2 = p.kn_c[l * 128 + 64 + lane];
  const float inv_freq = exp2f(-(float)(lane & 31) * (13.287712379549449f / 32.f));
  for (int r = bidx() * 8 + wid; r < TA; r += gridDim.x * 8) {
    float cs = 1.f, sn = 0.f;
    if (r >= TC) {
      const int t = r - TC; const float pos = (float)(lane < 32 ? (t >> 6) : (t & 63));
      const float ang = pos * inv_freq;
      const float k = rintf(ang * 0.15915494309189535f);
      float rr = fmaf(-k, 6.2831854820251465f, ang); rr = fmaf(-k, -1.7484555e-7f, rr);
      cs = cosf(rr); sn = sinf(rr);
    }
    const bf16_t* zr = Z + (size_t)r * ZLD;
#pragma unroll
    for (int hh = 0; hh < 10; ++hh) {
      const int zc = hh < 8 ? ZC_QC + hh * 128 : ZC_KC + (hh - 8) * 128;
      const float x1 = bf2f(zr[zc + lane]), x2 = bf2f(zr[zc + 64 + lane]);
      const float ss = wave_sum(x1 * x1 + x2 * x2);
      const float rstd = rsqrtf(ss * (1.f / 128.f) + 1e-6f);
      const float y1 = x1 * rstd * (hh < 8 ? gq1 : gk1), y2 = x2 * rstd * (hh < 8 ? gq2 : gk2);
      const float o1 = y1 * cs - y2 * sn, o2 = y2 * cs + y1 * sn;
      bf16_t* dst = hh < 8 ? QB + (size_t)r * 1024 + hh * 128 : KB + (size_t)r * 256 + (hh - 8) * 128;
      dst[lane] = f2bf(o1); dst[64 + lane] = f2bf(o2);
    }
    *(u32x2_t*)(VB + (size_t)r * 256 + lane * 4) = *(const u32x2_t*)(zr + ZC_VC + lane * 4);
  }
}

__device__ __forceinline__ void lru_ab_item(const Params& p, int l, int it, unsigned char* smem) {
  const int tid = tidx(), lane = tid & 63, wid = tid >> 6, fr = lane & 15, fq = lane >> 4;
  const bf16_t* Z = (const bf16_t*)(p.ws + WS_Z);
  float* uS = (float*)smem;
  bf16_t* uB = (bf16_t*)(smem + 16640);
  float* aS = (float*)(smem + 16640 + 9216);
  float* bS = aS + 2 * 64 * 64;
  float* LA = (float*)(p.ws + WS_LA); float* LB = (float*)(p.ws + WS_LB);
  float* LSEG = (float*)(p.ws + WS_LSEG);
  const bf16_t* WG = (const bf16_t*)(p.ws + WS_WG) + (size_t)l * 2 * 2 * 8 * 4096;
  {
    const int rs = it >> 3, n = it & 7, r0 = rs * 64;
    const int seg_lo = r0 < TC ? 0 : TC, seg_hi = r0 < TC ? TC : TA;
    __syncthreads();
    {
      const int tk = tid >> 3, c8 = (tid & 7) * 8, ch0 = n * 64 + c8;
      float acc[8];
#pragma unroll
      for (int i = 0; i < 8; ++i) acc[i] = p.conv_a_b[l * 512 + ch0 + i];
#pragma unroll
      for (int kk = 0; kk < 4; ++kk) {
        const int rr = r0 + tk + kk - 2;
        if (rr >= seg_lo && rr < seg_hi) {
          const bf16x8_t xv = *(const bf16x8_t*)(Z + (size_t)rr * ZLD + ZC_XA + ch0);
          const float* cw = p.conv_a_w + ((size_t)l * 4 + kk) * 512 + ch0;
#pragma unroll
          for (int i = 0; i < 8; ++i) acc[i] += cw[i] * bf2f((bf16_t)xv[i]);
        }
      }
#pragma unroll
      for (int i = 0; i < 8; ++i) { uS[tk * 65 + c8 + i] = acc[i]; uB[tk * 72 + c8 + i] = f2bf(acc[i]); }
    }
    __syncthreads();
    {
      const int d = wid & 1, ct = wid >> 1;
      f32x4_t ar[4], ai[4];
#pragma unroll
      for (int m = 0; m < 4; ++m) { ar[m] = (f32x4_t){0.f, 0.f, 0.f, 0.f}; ai[m] = (f32x4_t){0.f, 0.f, 0.f, 0.f}; }
      const bf16_t* wr_ = WG + ((size_t)(d * 2 + 0) * 8 + n) * 4096 + (ct * 16 + fr) * 64;
      const bf16_t* wi_ = WG + ((size_t)(d * 2 + 1) * 8 + n) * 4096 + (ct * 16 + fr) * 64;
#pragma unroll
      for (int ks = 0; ks < 2; ++ks) {
        const bf16x8_t br = *(const bf16x8_t*)(wr_ + ks * 32 + fq * 8);
        const bf16x8_t bi = *(const bf16x8_t*)(wi_ + ks * 32 + fq * 8);
#pragma unroll
        for (int m = 0; m < 4; ++m) {
          const bf16x8_t a = *(const bf16x8_t*)(uB + (m * 16 + fr) * 72 + ks * 32 + fq * 8);
          ar[m] = __builtin_amdgcn_mfma_f32_16x16x32_bf16(a, br, ar[m], 0, 0, 0);
          ai[m] = __builtin_amdgcn_mfma_f32_16x16x32_bf16(a, bi, ai[m], 0, 0, 0);
        }
      }
      const int cl = ct * 16 + fr, ch = n * 64 + cl;
      const float bra = p.b_ra[(l * 2 + d) * 512 + ch], bia = p.b_ia[(l * 2 + d) * 512 + ch];
      const float spl = softplusf_(-p.lam_a[(l * 2 + d) * 512 + ch]);
#pragma unroll
      for (int m = 0; m < 4; ++m)
#pragma unroll
        for (int j = 0; j < 4; ++j) {
          const int tk = m * 16 + fq * 4 + j;
          const float gr = sigmoidf_(ar[m][j] + bra), gi = sigmoidf_(ai[m][j] + bia);
          const float la = -8.f * gr * spl, x2 = 2.f * la;
          const float om = x2 > -0.05f ? -x2 * (1.f + x2 * (0.5f + x2 * (0.16666667f + x2 * 0.041666668f))) : 1.f - fexp_(x2);
          const float a = fexp_(la), b = __builtin_amdgcn_sqrtf(om) * gi * uS[tk * 65 + cl];
          aS[(d * 64 + tk) * 64 + cl] = a; bS[(d * 64 + tk) * 64 + cl] = b;
          LA[((size_t)d * TA + r0 + tk) * 512 + ch] = a; LB[((size_t)d * TA + r0 + tk) * 512 + ch] = b;
        }
    }
    __syncthreads();
    if (tid < 128) {
      const int d = tid >> 6, cl = tid & 63;
      float A = 1.f, B = 0.f;
      for (int s = 0; s < 64; ++s) { const int tk = d ? 63 - s : s; const float a = aS[(d * 64 + tk) * 64 + cl], b = bS[(d * 64 + tk) * 64 + cl]; A *= a; B = a * B + b; }
      const int ps = d == 0 ? rs : (rs < 4 ? 3 - rs : 135 - rs);
      float* o = LSEG + (((size_t)d * NCH + ps) * 512 + n * 64 + cl) * 2;
      o[0] = A; o[1] = B;
    }
  }
}

__device__ void lru_carry(const Params& p, int blk  ) {
  const int d = blk, ch = tidx();
  const float* LSEG = (const float*)(p.ws + WS_LSEG) + (size_t)d * NCH * 512 * 2;
  float* LCAR = (float*)(p.ws + WS_LCAR) + (size_t)d * NCH * 512;
  float h = 0.f;
#pragma unroll 4
  for (int ps = 0; ps < NCH; ++ps) {
    const float2 ab = *(const float2*)(LSEG + ((size_t)ps * 512 + ch) * 2);
    LCAR[ps * 512 + ch] = h; h = ab.x * h + ab.y;
  }
}

__device__ __forceinline__ void lru_fin_item(const Params& p, int l, int rs) {
  const int ch = tidx();
  const float* LA = (const float*)(p.ws + WS_LA); const float* LB = (const float*)(p.ws + WS_LB);
  const float* LCAR = (const float*)(p.ws + WS_LCAR);
  const bf16_t* Z = (const bf16_t*)(p.ws + WS_Z); bf16_t* MIX = (bf16_t*)(p.ws + WS_MIX);
  {
    const int r0 = rs * 64, ps1 = rs < 4 ? 3 - rs : 135 - rs;
    float hb[64];
    float h = LCAR[((size_t)1 * NCH + ps1) * 512 + ch];
#pragma unroll
    for (int s = 0; s < 64; ++s) { const int tk = 63 - s; const size_t o = ((size_t)1 * TA + r0 + tk) * 512 + ch; h = LA[o] * h + LB[o]; hb[tk] = h; }
    h = LCAR[((size_t)0 * NCH + rs) * 512 + ch];
#pragma unroll
    for (int tk = 0; tk < 64; ++tk) {
      const size_t o = ((size_t)0 * TA + r0 + tk) * 512 + ch; h = LA[o] * h + LB[o];
      const float ga = bf2f(Z[(size_t)(r0 + tk) * ZLD + ZC_GA + ch]);
      MIX[(size_t)(r0 + tk) * DM + ch] = f2bf((h + hb[tk]) * siluf_(ga));
    }
  }
}

constexpr int GD_QN = 0, GD_KN = 17408, GD_KT = 34816, GD_VT = 53248, GD_KK = 71680, GD_QK = 88320, GD_MS = 104960, GD_SC = 141824;
__device__ __forceinline__ void gdn_local_item(const Params& p, int l, int it, unsigned char* smem) {
  const bf16_t* Z = (const bf16_t*)(p.ws + WS_Z);
  bf16_t* qN = (bf16_t*)(smem + GD_QN); bf16_t* kN = (bf16_t*)(smem + GD_KN);
  bf16_t* kT = (bf16_t*)(smem + GD_KT); bf16_t* vT = (bf16_t*)(smem + GD_VT);
  float* KKs = (float*)(smem + GD_KK); float* QKs = (float*)(smem + GD_QK);
  float* Ms = (float*)(smem + GD_MS);
  float* SC = (float*)(smem + GD_SC);
  unsigned char* GREC = p.ws + WS_GREC; float* GU = (float*)(p.ws + WS_GU); float* GGL = (float*)(p.ws + WS_GGL);
  {
    const int rc = it >> 2, h = it & 3, r0 = rc * 64;
    const int seg_lo = r0 < TC ? 0 : TC, seg_hi = r0 < TC ? TC : TA;
    __syncthreads();
    {
    const int tid = tidx(), lane = tid & 63, wid = tid >> 6;
#pragma unroll 1
    for (int i = 0; i < 6; ++i) {
      const int u = i * 512 + tid, tk = u / 48, part = (u % 48) >> 4, c8 = (u & 15) * 8;
      const int chq = part * 512 + h * 128 + c8;
      float acc[8];
#pragma unroll
      for (int e = 0; e < 8; ++e) acc[e] = 0.f;
#pragma unroll
      for (int kk = 0; kk < 4; ++kk) {
        const int rr = r0 + tk + kk - 2;
        if (rr >= seg_lo && rr < seg_hi) {
          const bf16x8_t xv = *(const bf16x8_t*)(Z + (size_t)rr * ZLD + ZC_QKVB + chq);
          const float* cw = p.conv_b_w + ((size_t)l * 4 + kk) * 1536 + chq;
#pragma unroll
          for (int e = 0; e < 8; ++e) acc[e] += cw[e] * bf2f((bf16_t)xv[e]);
        }
      }
      float ss = 0.f;
#pragma unroll
      for (int e = 0; e < 8; ++e) { acc[e] = siluf_(acc[e]); ss += acc[e] * acc[e]; }
      ss += __shfl_xor(ss, 1); ss += __shfl_xor(ss, 2); ss += __shfl_xor(ss, 4); ss += __shfl_xor(ss, 8);
      float scl = 1.f;
      if (part == 0) scl = rsqrtf(ss + 1e-6f) * 0.088388347648318440f;
      else if (part == 1) scl = rsqrtf(ss + 1e-6f);
#pragma unroll
      for (int e = 0; e < 8; ++e) {
        const bf16_t b = f2bf(acc[e] * scl);
        if (part == 0) qN[tk * 136 + c8 + e] = b;
        const int tsw = (((tk >> 3) ^ ((c8 >> 3) & 7)) << 3) | (tk & 7);
        if (part == 1) { kN[tk * 136 + c8 + e] = b; kT[(c8 + e) * 72 + tsw] = b; }
        else if (part == 2) vT[(c8 + e) * 72 + tsw] = b;
      }
    }
    if (wid < 2) {
      const int d = wid, tk = d ? 63 - lane : lane;
      const bf16_t* zr = Z + (size_t)(r0 + tk) * ZLD;
      const float beta = sigmoidf_(bf2f(zr[ZC_BETA + d * 4 + h]));
      const float g = -expf(p.a_log_b[(l * 2 + d) * 4 + h]) * softplusf_(bf2f(zr[ZC_ALPHA + d * 4 + h]) + p.dt_bias_b[(l * 2 + d) * 4 + h]);
      float gc = g;
#pragma unroll
      for (int o = 1; o < 64; o <<= 1) { const float t = __shfl_up(gc, o); if (lane >= o) gc += t; }
      const float gl = __shfl(gc, 63);
      float* s = SC + d * 256;
      s[lane] = beta; s[64 + lane] = gc; s[128 + lane] = expf(gc); s[192 + lane] = expf(gl - gc);
      if (lane == 0) { const int pc = d == 0 ? rc : (rc < 4 ? 3 - rc : 135 - rc); GGL[(size_t)(d * 4 + h) * NCH + pc] = expf(gl); }
    }
    }
    __syncthreads();
    {
      const int tid = tidx(), lane = tid & 63, wid = tid >> 6, fr = lane & 15, fq = lane >> 4;
      const int which = wid >> 2, mt = wid & 3;
      const bf16_t* Asrc = which ? qN : kN;
      f32x4_t acc[4];
#pragma unroll
      for (int ct = 0; ct < 4; ++ct) acc[ct] = (f32x4_t){0.f, 0.f, 0.f, 0.f};
#pragma unroll
      for (int ks = 0; ks < 4; ++ks) {
        const bf16x8_t a = *(const bf16x8_t*)(Asrc + (mt * 16 + fr) * 136 + ks * 32 + fq * 8);
#pragma unroll
        for (int ct = 0; ct < 4; ++ct) {
          const bf16x8_t b = *(const bf16x8_t*)(kN + (ct * 16 + fr) * 136 + ks * 32 + fq * 8);
          acc[ct] = __builtin_amdgcn_mfma_f32_16x16x32_bf16(a, b, acc[ct], 0, 0, 0);
        }
      }
      float* dst = which ? QKs : KKs;
#pragma unroll
      for (int ct = 0; ct < 4; ++ct)
#pragma unroll
        for (int j = 0; j < 4; ++j) dst[(mt * 16 + fq * 4 + j) * 65 + ct * 16 + fr] = acc[ct][j];
    }
    __syncthreads();
#pragma unroll 1
    for (int i = 0; i < 16; ++i) {
      const int e = i * 512 + tidx(), d = e >> 12, pi = (e >> 6) & 63, pj = e & 63;
      const int ti = d ? 63 - pi : pi, tj = d ? 63 - pj : pj;
      const float* s = SC + d * 256;
      const float dec = pi >= pj ? fexp_(s[64 + pi] - s[64 + pj]) : 0.f;
      Ms[(d * 64 + pi) * 72 + pj] = pi > pj ? s[pi] * KKs[ti * 65 + tj] * dec : 0.f;
      const int pc = d == 0 ? rc : (rc < 4 ? 3 - rc : 135 - rc);
      ((bf16_t*)(GREC + ((size_t)(d * 4 + h) * NCH + pc) * GREC_BYTES + 32768))[pi * 64 + pj] = f2bf(QKs[ti * 65 + tj] * dec);
    }
    __syncthreads();
    if ((tidx() >> 6) < 2) {
      const int d = tidx() >> 6, c = tidx() & 63;
      const float* Md = Ms + d * 64 * 72;
      float T[64];
#pragma unroll
      for (int i = 0; i < 64; ++i) T[i] = 0.f;
#pragma unroll
      for (int i = 0; i < 64; ++i) {
        float a0 = (i == c) ? 1.f : 0.f, a1 = 0.f, a2 = 0.f, a3 = 0.f;
#pragma unroll
        for (int jb = 0; jb < i; jb += 4) {
          const float4 m = *(const float4*)(Md + i * 72 + jb);
          a0 -= m.x * T[jb]; a1 -= m.y * T[jb + 1]; a2 -= m.z * T[jb + 2]; a3 -= m.w * T[jb + 3];
        }
        T[i] = (a0 + a1) + (a2 + a3);
      }
      const float* s = SC + d * 256;
      const float bc = s[c], bce = s[c] * s[128 + c];
      const int tc = d ? 63 - c : c;
      bf16_t* Tu = (bf16_t*)(Ms + d * 64 * 72); bf16_t* Tw = Tu + 64 * 72;
      asm volatile("s_waitcnt lgkmcnt(0)" ::: "memory");
#pragma unroll
      for (int i = 0; i < 64; ++i) { Tu[i * 72 + tc] = f2bf(T[i] * bc); Tw[i * 72 + tc] = f2bf(T[i] * bce); }
    } else {
#pragma unroll 1
      for (int e = tidx() - 128; e < 2048; e += 384) {
        const int d = e >> 10, pi = (e >> 4) & 63, c8 = (e & 15) * 8;
        const int ti = d ? 63 - pi : pi; const float sc = SC[d * 256 + 128 + pi];
        const int pc = d == 0 ? rc : (rc < 4 ? 3 - rc : 135 - rc);
        const bf16x8_t qv = *(const bf16x8_t*)(qN + ti * 136 + c8);
        float f[8];
#pragma unroll
        for (int k = 0; k < 8; ++k) f[k] = bf2f((bf16_t)qv[k]) * sc;
        u32x4_t w = {cvtpk2(f[0], f[1]), cvtpk2(f[2], f[3]), cvtpk2(f[4], f[5]), cvtpk2(f[6], f[7])};
        *(u32x4_t*)((bf16_t*)(GREC + ((size_t)(d * 4 + h) * NCH + pc) * GREC_BYTES + 16384) + pi * 128 + c8) = w;
      }
#pragma unroll 1
      for (int e = tidx() - 128; e < 2048; e += 384) {
        const int d = e >> 10, chn = (e >> 3) & 127, p8 = (e & 7) * 8;
        const int pc = d == 0 ? rc : (rc < 4 ? 3 - rc : 135 - rc);
        float f[8];
#pragma unroll
        for (int k = 0; k < 8; ++k) { const int pi = p8 + k, ti = d ? 63 - pi : pi; f[k] = bf2f(kT[chn * 72 + ((((ti >> 3) ^ ((chn >> 3) & 7)) << 3) | (ti & 7))]) * SC[d * 256 + 192 + pi]; }
        u32x4_t w = {cvtpk2(f[0], f[1]), cvtpk2(f[2], f[3]), cvtpk2(f[4], f[5]), cvtpk2(f[6], f[7])};
        *(u32x4_t*)((bf16_t*)(GREC + ((size_t)(d * 4 + h) * NCH + pc) * GREC_BYTES + 40960) + chn * 64 + p8) = w;
      }
    }
    __syncthreads();
    {
      const int tid = tidx(), lane = tid & 63, wid = tid >> 6, fr = lane & 15, fq = lane >> 4;
      const int d = wid >> 2, which = (wid >> 1) & 1, half = wid & 1;
      const int pc = d == 0 ? rc : (rc < 4 ? 3 - rc : 135 - rc);
      const size_t cbase = (size_t)(d * 4 + h) * NCH + pc;
      const bf16_t* Tm = (const bf16_t*)(Ms + d * 64 * 72) + which * 64 * 72;
      const bf16_t* Bs = which ? kT : vT;
#pragma unroll 1
      for (int cti = 0; cti < 4; ++cti) {
        const int ct = half * 4 + cti;
        f32x4_t acc[4];
#pragma unroll
        for (int m = 0; m < 4; ++m) acc[m] = (f32x4_t){0.f, 0.f, 0.f, 0.f};
#pragma unroll
        for (int ks = 0; ks < 2; ++ks) {
          const bf16x8_t b = *(const bf16x8_t*)(Bs + (ct * 16 + fr) * 72 + (((ks * 4 + fq) ^ ((2 * ct + (fr >> 3)) & 7)) << 3));
#pragma unroll
          for (int m = 0; m < 4; ++m) {
            const bf16x8_t a = *(const bf16x8_t*)(Tm + (m * 16 + fr) * 72 + ks * 32 + fq * 8);
            acc[m] = __builtin_amdgcn_mfma_f32_16x16x32_bf16(a, b, acc[m], 0, 0, 0);
          }
        }
#pragma unroll
        for (int m = 0; m < 4; ++m)
#pragma unroll
          for (int j = 0; j < 4; ++j) {
            const int pi = m * 16 + fq * 4 + j, chn = ct * 16 + fr;
            if (which) ((bf16_t*)(GREC + cbase * GREC_BYTES))[pi * 128 + chn] = f2bf(acc[m][j]);
            else GU[cbase * 8192 + pi * 128 + chn] = acc[m][j];
          }
      }
    }
  }
}

constexpr int GS_W = 0, GS_QH = 17408, GS_QK = 34816, GS_KT = 44032, GS_BUF = 62464, GS_GAM = 2 * GS_BUF, GS_OST = GS_GAM + 1024;
__device__ void gdn_scan(const Params& p, unsigned char* smem, int sq, int sg) {
  const int tid = tidx(), lane = tid & 63, wid = tid >> 6, fr = lane & 15, fq = lane >> 4;
  const int d = sq >> 2, h = sq & 3;
  const unsigned char* REC = p.ws + WS_GREC + (size_t)sq * NCH * GREC_BYTES;
  const float* GGL = (const float*)(p.ws + WS_GGL) + (size_t)sq * NCH;
  float* gamS = (float*)(smem + GS_GAM);
  __syncthreads();
  if (tid < NCH) gamS[tid] = GGL[tid];
  if (wid < 4) {
    const int slice = sg * 4 + wid, n0 = slice * 16;
    const float* up = (const float*)(p.ws + WS_GU) + (size_t)sq * NCH * 8192 + (fq * 4) * 128 + n0 + fr;
    float* GO = (float*)(p.ws + WS_GO) + (size_t)(sq * 8 + slice) * TA * 16;
    float* ost = (float*)(smem + GS_OST + wid * 4096);
    f32x4_t S[8], U[4];
#pragma unroll
    for (int t = 0; t < 8; ++t) S[t] = (f32x4_t){0.f, 0.f, 0.f, 0.f};
#pragma unroll
    for (int m = 0; m < 4; ++m)
#pragma unroll
      for (int j = 0; j < 4; ++j) U[m][j] = up[(m * 16 + j) * 128];
    __syncthreads();
#pragma unroll 1
    for (int pc = 0; pc < NCH; ++pc) {
      const unsigned char* B_ = smem + (pc & 1) * GS_BUF;
#define GS_AFRAG(base, stride, row, ks) ({ const unsigned char* a_ = B_ + (base) + (row) * (stride) + (ks) * 64 + fq * 8; \
      u32x2_t lo_ = *(const u32x2_t*)a_; u32x2_t hi_ = *(const u32x2_t*)(a_ + 32); u32x4_t w_ = {lo_.x, lo_.y, hi_.x, hi_.y}; *reinterpret_cast<bf16x8_t*>(&w_); })
      const float gam = gamS[pc];
      f32x4_t Un[4];
      { const int pn = pc + 1 < NCH ? pc + 1 : pc;
#pragma unroll
        for (int m = 0; m < 4; ++m)
#pragma unroll
          for (int j = 0; j < 4; ++j) Un[m][j] = up[(size_t)pn * 8192 + (m * 16 + j) * 128]; }
      bf16x8_t Sb[4];
#pragma unroll
      for (int ks = 0; ks < 4; ++ks) Sb[ks] = pack8(S[2 * ks], S[2 * ks + 1]);
      f32x4_t P[4], O[4];
#pragma unroll
      for (int m = 0; m < 4; ++m) { P[m] = (f32x4_t){0.f, 0.f, 0.f, 0.f}; O[m] = (f32x4_t){0.f, 0.f, 0.f, 0.f}; }
#pragma unroll
      for (int ks = 0; ks < 4; ++ks)
#pragma unroll
        for (int m = 0; m < 4; ++m) {
          const bf16x8_t aw = GS_AFRAG(GS_W, 272, m * 16 + fr, ks);
          const bf16x8_t aq = GS_AFRAG(GS_QH, 272, m * 16 + fr, ks);
          P[m] = __builtin_amdgcn_mfma_f32_16x16x32_bf16(aw, Sb[ks], P[m], 0, 0, 0);
          O[m] = __builtin_amdgcn_mfma_f32_16x16x32_bf16(aq, Sb[ks], O[m], 0, 0, 0);
        }
      f32x4_t Vn[4];
#pragma unroll
      for (int m = 0; m < 4; ++m) Vn[m] = U[m] - P[m];
      bf16x8_t Vb[2];
      Vb[0] = pack8(Vn[0], Vn[1]); Vb[1] = pack8(Vn[2], Vn[3]);
#pragma unroll
      for (int ks = 0; ks < 2; ++ks)
#pragma unroll
        for (int m = 0; m < 4; ++m) {
          const bf16x8_t a = GS_AFRAG(GS_QK, 144, m * 16 + fr, ks);
          O[m] = __builtin_amdgcn_mfma_f32_16x16x32_bf16(a, Vb[ks], O[m], 0, 0, 0);
        }
#pragma unroll
      for (int t = 0; t < 8; ++t) {
        S[t] = S[t] * gam;
#pragma unroll
        for (int ks = 0; ks < 2; ++ks) {
          const bf16x8_t a = GS_AFRAG(GS_KT, 144, t * 16 + fr, ks);
          S[t] = __builtin_amdgcn_mfma_f32_16x16x32_bf16(a, Vb[ks], S[t], 0, 0, 0);
        }
      }
#undef GS_AFRAG
#pragma unroll
      for (int m = 0; m < 4; ++m)
#pragma unroll
        for (int j = 0; j < 4; ++j) { const int pi = m * 16 + fq * 4 + j, tk = d ? 63 - pi : pi; ost[tk * 16 + fr] = O[m][j]; }
      const int rcn = d == 0 ? pc : (pc < 4 ? 3 - pc : 135 - pc);
      float* gop = GO + (size_t)rcn * 1024 + lane * 4;
#pragma unroll
      for (int i = 0; i < 4; ++i) *(f32x4_t*)(gop + i * 256) = *(const f32x4_t*)(ost + i * 256 + lane * 4);
#pragma unroll
      for (int m = 0; m < 4; ++m) U[m] = Un[m];
      __syncthreads();
    }
  } else {
    const int lt = tid - 256;
    int lo[14];
#pragma unroll
    for (int i = 0; i < 14; ++i) {
      const int q = lt + 256 * i;
      lo[i] = q < 1024 ? GS_W + (q >> 4) * 272 + (q & 15) * 16
            : q < 2048 ? GS_QH + ((q - 1024) >> 4) * 272 + (q & 15) * 16
            : q < 2560 ? GS_QK + ((q - 2048) >> 3) * 144 + (q & 7) * 16
                       : GS_KT + ((q - 2560) >> 3) * 144 + (q & 7) * 16;
    }
    u32x4_t R0[14], R1[14], R2[14];
#define GS_LOAD(R, pc) do { const int pc_ = (pc) < NCH ? (pc) : NCH - 1; const u32x4_t* s_ = (const u32x4_t*)(REC + (size_t)pc_ * GREC_BYTES) + lt; \
    _Pragma("unroll") for (int i = 0; i < 14; ++i) R[i] = s_[256 * i]; } while (0)
#define GS_WRITE(R, pc) do { unsigned char* B_ = smem + ((pc) & 1) * GS_BUF; \
    _Pragma("unroll") for (int i = 0; i < 14; ++i) *(u32x4_t*)(B_ + lo[i]) = R[i]; } while (0)
    GS_LOAD(R0, 0); GS_WRITE(R0, 0);
    GS_LOAD(R1, 1); GS_LOAD(R2, 2);
    __syncthreads();
#pragma unroll 1
    for (int pc = 0; pc < NCH; pc += 3) {
      GS_LOAD(R0, pc + 3); GS_WRITE(R1, pc + 1); __syncthreads();
      GS_LOAD(R1, pc + 4); GS_WRITE(R2, pc + 2); __syncthreads();
      GS_LOAD(R2, pc + 5); GS_WRITE(R0, pc + 3); __syncthreads();
    }
#undef GS_LOAD
#undef GS_WRITE
  }
}

__device__ __forceinline__ void phase_gdn_fin(const Params& p, int l, int rb, int re, int rstep) {
  const int tid = tidx(), lane = tid & 63, wid = tid >> 6;
  const float* GO = (const float*)(p.ws + WS_GO);
  const bf16_t* Z = (const bf16_t*)(p.ws + WS_Z); bf16_t* MIX = (bf16_t*)(p.ws + WS_MIX);
  const int c0 = lane * 8;
  float on[8];
#pragma unroll
  for (int e = 0; e < 8; ++e) on[e] = p.onorm_b[l * 128 + (c0 & 127) + e];
  for (int r = rb + wid; r < re; r += rstep) {
    if (l == NL - 1 && r < TC) continue;
    const int hh = lane >> 4, sl = (lane >> 1) & 7, off = (lane & 1) * 8;
    const float* g0 = GO + ((size_t)((0 * 4 + hh) * 8 + sl) * TA + r) * 16 + off;
    const float* g1 = GO + ((size_t)((1 * 4 + hh) * 8 + sl) * TA + r) * 16 + off;
    const float4 a0 = *(const float4*)g0, a1 = *(const float4*)(g0 + 4);
    const float4 b0 = *(const float4*)g1, b1 = *(const float4*)(g1 + 4);
    float v[8] = {a0.x + b0.x, a0.y + b0.y, a0.z + b0.z, a0.w + b0.w, a1.x + b1.x, a1.y + b1.y, a1.z + b1.z, a1.w + b1.w};
    float ss = 0.f;
#pragma unroll
    for (int e = 0; e < 8; ++e) ss += v[e] * v[e];
    ss += __shfl_xor(ss, 1); ss += __shfl_xor(ss, 2); ss += __shfl_xor(ss, 4); ss += __shfl_xor(ss, 8);
    const float rstd = rsqrtf(ss * (1.f / 128.f) + 1e-6f);
    const bf16x8_t gv = *(const bf16x8_t*)(Z + (size_t)r * ZLD + ZC_GB + c0);
    float f[8];
#pragma unroll
    for (int e = 0; e < 8; ++e) f[e] = v[e] * rstd * on[e] * siluf_(bf2f((bf16_t)gv[e]));
    u32x4_t w = {cvtpk2(f[0], f[1]), cvtpk2(f[2], f[3]), cvtpk2(f[4], f[5]), cvtpk2(f[6], f[7])};
    *(u32x4_t*)(MIX + (size_t)r * DM + 512 + c0) = w;
  }
}

constexpr int ATT_ITEMS = 512;
__device__ __forceinline__ void attn_item(const Params& p, int it, unsigned char* smem) {
  const bf16_t* QB = (const bf16_t*)(p.ws + WS_QB); const bf16_t* KB = (const bf16_t*)(p.ws + WS_KB); const bf16_t* VB = (const bf16_t*)(p.ws + WS_VB);
  int head, r0, seq, k0, split;
  if (it < ATT_ITEMS) { const int half = it >> 8, idx = it & 255; split = half * 3; head = idx >> 5; r0 = TC + (idx & 31) * 256; seq = half ? 52 * 64 : 80 * 64; k0 = half ? 80 * 64 : 0; }
  else { split = 0; head = it - ATT_ITEMS; r0 = 0; seq = TC; k0 = 0; }
  const int kvh = head >> 2;
  bf16_t* OUT = (bf16_t*)(p.ws + WS_PO) + ((size_t)split * TA + r0) * 1024 + head * 128;
  float* ML = (float*)(p.ws + WS_ML) + (((size_t)split * TA + r0) * 8 + head) * 2;
  __syncthreads();
  att::attn_dense_body(QB + (size_t)r0 * 1024 + head * 128, KB + (size_t)k0 * 256 + kvh * 128, VB + (size_t)k0 * 256 + kvh * 128, ML, OUT, seq, (char*)smem);
}
__device__ void attn_queue(const Params& p, int l, unsigned char* smem) {
  unsigned* ctr = (unsigned*)(p.ws + WS_CTR) + l;
  volatile int* slot = (volatile int*)(smem + 144000);
  for (;;) {
    __syncthreads();
    if (tidx() == 0) *slot = (int)atomicAdd(ctr, 1u);
    __syncthreads();
    const int it = *slot;
    if (it >= ATT_ITEMS) break;
    attn_item(p, it, smem);
  }
}

__device__ __forceinline__ void phase_attn_gate(const Params& p, int l, int rb, int re, int rstep) {
  const int tid = tidx(), lane = tid & 63, wid = tid >> 6;
  const bf16_t* Z = (const bf16_t*)(p.ws + WS_Z); bf16_t* MIX = (bf16_t*)(p.ws + WS_MIX); const bf16_t* PO = (const bf16_t*)(p.ws + WS_PO);
  const float* ML = (const float*)(p.ws + WS_ML);
  constexpr float C = 0.088388347648318440f * 1.4426950408889634f;
  for (int r = rb + wid; r < re; r += rstep) {
    if (l == NL - 1 && r < TC) continue;
#pragma unroll
    for (int hlf = 0; hlf < 2; ++hlf) {
      const int c0 = hlf * 512 + lane * 8, head = c0 >> 7;
      const bf16x8_t gv = *(const bf16x8_t*)(Z + (size_t)r * ZLD + ZC_GC + c0);
      float f[8];
      if (r >= TC) {
        float2 st[NSPLIT]; float mm = -3.0e38f;
#pragma unroll
        for (int k = 0; k < NSPLIT; ++k) { const bool use = k % 3 == 0;
          st[k] = use ? *(const float2*)(ML + (((size_t)k * TA + r) * 8 + head) * 2) : make_float2(-3.0e38f, 0.f); mm = fmaxf(mm, st[k].x); }
        float wsum = 0.f;
#pragma unroll
        for (int e = 0; e < 8; ++e) f[e] = 0.f;
#pragma unroll
        for (int k = 0; k < NSPLIT; ++k) {
          if (k % 3 == 0) {
            const float w = st[k].y * exp2f((st[k].x - mm) * C); wsum += w;
            const bf16x8_t ov = *(const bf16x8_t*)(PO + ((size_t)k * TA + r) * 1024 + c0);
#pragma unroll
            for (int e = 0; e < 8; ++e) f[e] += bf2f((bf16_t)ov[e]) * w;
          }
        }
        const float inv = 1.f / wsum;
#pragma unroll
        for (int e = 0; e < 8; ++e) f[e] *= inv * siluf_(bf2f((bf16_t)gv[e]));
      } else {
        const bf16x8_t ov = *(const bf16x8_t*)(PO + (size_t)r * 1024 + c0);
#pragma unroll
        for (int e = 0; e < 8; ++e) f[e] = bf2f((bf16_t)ov[e]) * siluf_(bf2f((bf16_t)gv[e]));
      }
      u32x4_t w = {cvtpk2(f[0], f[1]), cvtpk2(f[2], f[3]), cvtpk2(f[4], f[5]), cvtpk2(f[6], f[7])};
      *(u32x4_t*)(MIX + (size_t)r * DM + 1024 + c0) = w;
    }
  }
}

template <int S>
__device__ __forceinline__ void run_phase(const Params& p0, int l, unsigned char* smem) {
  Params p = p0;
  { unsigned long long w_ = (unsigned long long)p.ws; asm volatile("" : "+s"(w_)); p.ws = (unsigned char*)w_; }
  const int bid = bidx();
  if constexpr (S == 0) phase_prep0(p, smem);
  else if constexpr (S == 1) phase_norm(p, l);
  else if constexpr (S == 2) {
    pg8::Gemm g; g.A = (const bf16_t*)(p.ws + WS_XN); g.Bt = (const bf16_t*)(p.ws + WS_WIN) + (size_t)l * ZLD * DM; g.M = TA; g.N = ZLD; g.K = DM; g.ld = DM;
    pg8::StaticOrder So; So.init(g.M, g.N, (int)gridDim.x, bid);
    pg8::EpiZ E; E.O = (bf16_t*)(p.ws + WS_Z); E.ldc = ZLD;
    pg8::gemm_phase<pg8::EpiZ, pg8::StaticOrder, false>((PG8_LAS unsigned char*)smem, g, So, E, nullptr);
  } else if constexpr (S == 3) {
    phase_qkprep(p, l);
    {
      unsigned* ctr = (unsigned*)(p.ws + WS_CTR) + 16 + l;
      volatile int* slot = (volatile int*)(smem + 144000);
      for (;;) {
        __syncthreads();
        if (tidx() == 0) *slot = (int)atomicAdd(ctr, 1u);
        __syncthreads();
        const int it = *slot;
        if (it >= NCH * 4 + NCH * 8) break;
        if (it < NCH * 4) gdn_local_item(p, l, it, smem); else lru_ab_item(p, l, it - NCH * 4, smem);
      }
    }
  }
  else if constexpr (S == 4) {
    if (bid < 16) gdn_scan(p, smem, bid & 7, bid >> 3);
    else if (bid < 18) lru_carry(p, bid - 16);
    else if (bid < 26) { if (l != NL - 1) attn_item(p, ATT_ITEMS + bid - 18, smem); }
    attn_queue(p, l, smem);
    if (l + 1 < NL) convert_queue(p, l + 1, smem);
  }
  else if constexpr (S == 5) { }
  else if constexpr (S == 6) {
    unsigned* ctr = (unsigned*)(p.ws + WS_CTR) + 24 + l;
    volatile int* slot = (volatile int*)(smem + 144000);
    const int first = (l == NL - 1) ? 4 : 0;
    for (;;) {
      __syncthreads();
      if (tidx() == 0) *slot = (int)atomicAdd(ctr, 1u);
      __syncthreads();
      const int it = *slot + first;
      if (it >= NCH + TA / 32) break;
      if (it < NCH) lru_fin_item(p, l, it);
      else { const int r0 = (it - NCH) * 32; if (l == NL - 1 && r0 < TC) continue; phase_gdn_fin(p, l, r0, r0 + 32, 8); phase_attn_gate(p, l, r0, r0 + 32, 8); }
    }
  }
  else if constexpr (S == 7) {
    const bool last = (l == NL - 1);
    const float* mod = (const float*)(p.ws + WS_MOD) + (size_t)l * 2 * 6144;
    {
      pg8::Gemm g; g.A = (const bf16_t*)(p.ws + WS_MIX) + (size_t)TC * DM; g.Bt = (const bf16_t*)(p.ws + WS_WOUT) + (size_t)l * DM * DM;
      g.M = TL; g.N = DM; g.K = DM; g.ld = DM;
      pg8::StaticOrder So; So.init(g.M, g.N, (int)gridDim.x, bid);
      pg8::EpiRes E; E.H = (float*)(p.ws + WS_H); E.gate_lat = mod + 4096; E.gate_ctx = mod + 6144 + 4096; E.row_off = TC;
      pg8::gemm_phase<pg8::EpiRes, pg8::StaticOrder, false>((PG8_LAS unsigned char*)smem, g, So, E, nullptr);
    }
    if (!last) {
      const int G_ = (int)gridDim.x;
#pragma unroll 1
      for (int kq = 0; kq < 4; ++kq) {
        pg8::Gemm g; g.A = (const bf16_t*)(p.ws + WS_MIX) + kq * 512; g.Bt = (const bf16_t*)(p.ws + WS_WOUT) + (size_t)l * DM * DM + kq * 512;
        g.M = TC; g.N = DM; g.K = 512; g.ld = DM;
        pg8::StaticOrder So; So.init(g.M, g.N, G_, (bid - 8 * kq - 8 + 2 * G_) % G_);
        pg8::EpiResAtomic E; E.H = (float*)(p.ws + WS_H); E.gate = mod + 6144 + 4096;
        pg8::gemm_phase<pg8::EpiResAtomic, pg8::StaticOrder, false>((PG8_LAS unsigned char*)smem, g, So, E, nullptr);
      }
    }
  } else phase_final(p);
}

#ifdef MK_MULTI
template <int S>
__global__ __launch_bounds__(512, 2) void k_phase(Params p, int l) {
  extern __shared__ __attribute__((aligned(16))) unsigned char smem[];
  run_phase<S>(p, l, smem);
}
#else
__global__ __launch_bounds__(512, 2) void hybrid_fwd(Params p) {
  extern __shared__ __attribute__((aligned(16))) unsigned char smem[];
  cg::grid_group grid = cg::this_grid();
  volatile LAS unsigned* xst = (volatile LAS unsigned*)(smem + (LDS_BYTES - 16));
  if (threadIdx.x == 0) { xst[0] = 0u; xst[1] = 0u; }
  __syncthreads();
  const XcdBarrier xb = xcd_barrier_post((unsigned*)(p.ws + WS_BAR), xst);
#define GSYNC() xcd_barrier(xb)
  run_phase<0>(p, 0, smem); grid.sync();
#ifndef REP1
#define REP1 1
#endif
#ifndef REP2
#define REP2 1
#endif
#ifndef REP3
#define REP3 1
#endif
#ifndef REP4
#define REP4 1
#endif
#ifndef REP5
#define REP5 1
#endif
#ifndef REP6
#define REP6 1
#endif
#ifndef REPSYNC
#define REPSYNC 0
#endif
#pragma unroll 1
  for (int l = 0; l < NL; ++l) {
#pragma unroll 1
    for (int r = 0; r < REP1; ++r) { run_phase<1>(p, l, smem); GSYNC(); }
#pragma unroll 1
    for (int r = 0; r < REP2; ++r) { run_phase<2>(p, l, smem); GSYNC(); }
#pragma unroll 1
    for (int r = 0; r < REP3; ++r) { run_phase<3>(p, l, smem); GSYNC(); }
#pragma unroll 1
    for (int r = 0; r < REP4; ++r) { run_phase<4>(p, l, smem); GSYNC(); }
#pragma unroll 1
    for (int r = 0; r < REP6; ++r) { run_phase<6>(p, l, smem); GSYNC(); }
#pragma unroll 1
    for (int r = 0; r < REPSYNC; ++r) GSYNC();
    run_phase<7>(p, l, smem); GSYNC();
  }
  run_phase<8>(p, 0, smem);
}
#endif

template <class K> static bool set_lds(K k) { return hipFuncSetAttribute((const void*)k, hipFuncAttributeMaxDynamicSharedMemorySize, LDS_BYTES) == hipSuccess; }

extern "C" void kernel_launch(void* const* d_in, const int* in_sizes, int n_in, void* d_out, int out_size, void* d_ws, size_t ws_size, hipStream_t stream) {
  static int grid = 0;
  if (grid == 0) {
    if (n_in != 23 || out_size != TL * DM || ws_size < WS_END) { fprintf(stderr, "kernel_launch: unexpected shapes (n_in %d out %d ws %zu need %zu)\n", n_in, out_size, ws_size, (size_t)WS_END); grid = -1; return; }
    int dev = 0, cus = 0;
    (void)hipGetDevice(&dev); (void)hipDeviceGetAttribute(&cus, hipDeviceAttributeMultiprocessorCount, dev);
    bool ok = true;
#ifdef MK_MULTI
    ok = ok && set_lds(k_phase<0>) && set_lds(k_phase<1>) && set_lds(k_phase<2>) && set_lds(k_phase<3>) && set_lds(k_phase<4>) && set_lds(k_phase<5>) && set_lds(k_phase<6>) && set_lds(k_phase<7>) && set_lds(k_phase<8>);
#else
    ok = ok && set_lds(hybrid_fwd);
    int per_cu = 0; (void)hipOccupancyMaxActiveBlocksPerMultiprocessor(&per_cu, (const void*)hybrid_fwd, 512, LDS_BYTES); (void)hipGetLastError();
    if (per_cu < 1) fprintf(stderr, "kernel_launch: occupancy query says %d blocks per CU\n", per_cu);
#endif
    if (!ok) { fprintf(stderr, "kernel_launch: hipFuncSetAttribute failed\n"); grid = -1; return; }
    grid = cus > 0 ? cus : 256;
  }
  if (grid < 0) return;
  Params p{};
  const float** pp = (const float**)&p;
  for (int i = 0; i < 23; ++i) pp[i] = (const float*)d_in[i];
  p.out = (float*)d_out; p.ws = (unsigned char*)d_ws;
#ifdef MK_MULTI
#define LAUNCH(S, l) hipLaunchKernelGGL(k_phase<S>, dim3(grid), dim3(512), LDS_BYTES, stream, p, l)
  LAUNCH(0, 0);
  for (int l = 0; l < NL; ++l) { LAUNCH(1, l); LAUNCH(2, l); LAUNCH(3, l); LAUNCH(4, l); LAUNCH(6, l); LAUNCH(7, l); }
  LAUNCH(8, 0);
#else
  (void)hipMemsetAsync((unsigned char*)d_ws + WS_CTR, 0, 256 + 16384, stream);
  void* args[] = {&p};
  hipError_t e = hipLaunchCooperativeKernel((const void*)hybrid_fwd, dim3(grid), dim3(512), args, LDS_BYTES, stream);
  if (e != hipSuccess) fprintf(stderr, "cooperative launch failed: %s (grid %d)\n", hipGetErrorString(e), grid);
#endif
}
```

```cpp
#include <hip/hip_runtime.h>
#include <hip/hip_cooperative_groups.h>
#include <cstdio>
namespace cg = cooperative_groups;

typedef unsigned short bf16_t;
typedef short bf16x8_t __attribute__((ext_vector_type(8)));
typedef float f32x4_t __attribute__((ext_vector_type(4)));
typedef unsigned u32x4_t __attribute__((ext_vector_type(4)));
typedef unsigned u32x2_t __attribute__((ext_vector_type(2)));

constexpr int DM = 2048, TL = 8192, TC = 256, TA = 8448, NL = 4;
constexpr int DIN = 5648, ZLD = 5888, NCH = 132;
constexpr int ZC_XA = 0, ZC_GA = 512, ZC_QKVB = 1024, ZC_GB = 2560, ZC_QC = 3072, ZC_KC = 4096, ZC_VC = 4352, ZC_GC = 4608, ZC_BETA = 5632, ZC_ALPHA = 5640;
constexpr int LDS_BYTES = 147456;

constexpr size_t al256(size_t x) { return (x + 255) / 256 * 256; }
constexpr size_t WS_H    = 0;
constexpr size_t WS_XN   = WS_H    + al256((size_t)TA * DM * 4);
constexpr size_t WS_Z    = WS_XN   + al256((size_t)TA * DM * 2);
constexpr size_t WS_MIX  = WS_Z    + al256((size_t)TA * ZLD * 2);
constexpr size_t WS_QB   = WS_MIX  + al256((size_t)TA * DM * 2);
constexpr size_t WS_KB   = WS_QB   + al256((size_t)TA * 1024 * 2);
constexpr size_t WS_VB   = WS_KB   + al256((size_t)TA * 256 * 2);
constexpr size_t WS_WIN  = WS_VB   + al256((size_t)TA * 256 * 2);
constexpr size_t WS_WOUT = WS_WIN  + al256((size_t)NL * ZLD * DM * 2);
constexpr size_t WS_MOD  = WS_WOUT + al256((size_t)NL * DM * DM * 2);
constexpr size_t WS_WG   = WS_MOD  + al256((size_t)NL * 2 * 6144 * 4);
constexpr size_t WS_LA   = WS_WG   + al256((size_t)NL * 2 * 2 * 8 * 4096 * 2);
constexpr size_t WS_LB   = WS_LA   + al256((size_t)2 * TA * 512 * 4);
constexpr size_t WS_LSEG = WS_LB   + al256((size_t)2 * TA * 512 * 4);
constexpr size_t WS_LCAR = WS_LSEG + al256((size_t)2 * NCH * 512 * 2 * 4);
constexpr size_t GREC_BYTES = 57344;
constexpr size_t WS_GREC = WS_LCAR + al256((size_t)2 * NCH * 512 * 4);
constexpr size_t WS_GU   = WS_GREC + al256((size_t)8 * NCH * GREC_BYTES);
constexpr size_t WS_GGL  = WS_GU   + al256((size_t)8 * NCH * 8192 * 4);
constexpr size_t WS_GO   = WS_GGL  + al256((size_t)8 * NCH * 4);
constexpr int NSPLIT = 6, SPLIT_KEYS = TA / NSPLIT;
constexpr size_t WS_PO   = WS_GO   + al256((size_t)2 * TA * 512 * 4);
constexpr size_t WS_ML   = WS_PO   + al256((size_t)NSPLIT * TA * 1024 * 2);
constexpr size_t WS_CTR  = WS_ML   + al256((size_t)NSPLIT * TA * 16 * 4);
constexpr size_t WS_BAR  = WS_CTR  + 256;
constexpr size_t WS_END  = WS_BAR  + 16384;

struct Params {
  const float *x, *c, *ctx, *c_ctx, *norm_g, *w_mod, *b_mod, *w_in, *conv_a_w, *conv_a_b, *w_ra, *b_ra, *w_ia, *b_ia, *lam_a,
              *conv_b_w, *a_log_b, *dt_bias_b, *onorm_b, *qn_c, *kn_c, *w_out, *final_g;
  float* out; unsigned char* ws;
};

__device__ __forceinline__ unsigned cvtpk2(float lo, float hi) { unsigned r; asm volatile("v_cvt_pk_bf16_f32 %0, %1, %2" : "=v"(r) : "v"(lo), "v"(hi)); return r; }
__device__ __forceinline__ bf16_t f2bf(float x) { return (bf16_t)(cvtpk2(x, 0.f) & 0xffffu); }
__device__ __forceinline__ float bf2f(bf16_t b) { return __uint_as_float(((unsigned)b) << 16); }
__device__ __forceinline__ float fexp_(float x) { return __builtin_amdgcn_exp2f(x * 1.4426950408889634f); }
__device__ __forceinline__ float sigmoidf_(float x) { return __builtin_amdgcn_rcpf(1.f + fexp_(-x)); }
__device__ __forceinline__ float siluf_(float x) { return x * __builtin_amdgcn_rcpf(1.f + fexp_(-x)); }
__device__ __forceinline__ float softplusf_(float x) { return fmaxf(x, 0.f) + log1pf(expf(-fabsf(x))); }
__device__ __forceinline__ float wave_sum(float v) {
#pragma unroll
  for (int o = 32; o >= 1; o >>= 1) v += __shfl_xor(v, o);
  return v;
}
__device__ __forceinline__ bf16x8_t pack8(f32x4_t a, f32x4_t b) {
  u32x4_t w = {cvtpk2(a[0], a[1]), cvtpk2(a[2], a[3]), cvtpk2(b[0], b[1]), cvtpk2(b[2], b[3])};
  return *reinterpret_cast<bf16x8_t*>(&w);
}

__device__ __forceinline__ int tidx() { int t = (int)__builtin_amdgcn_workitem_id_x(); asm volatile("" : "+v"(t)); return t; }
__device__ __forceinline__ int bidx() { int b = (int)__builtin_amdgcn_workgroup_id_x(); asm volatile("" : "+s"(b)); return b; }
namespace pg8 {
#define PG8_LAS __attribute__((address_space(3)))
typedef unsigned short bf16_t;
typedef short bf16x8 __attribute__((ext_vector_type(8)));
typedef float f32x4 __attribute__((ext_vector_type(4)));
typedef unsigned u32x4 __attribute__((ext_vector_type(4)));
constexpr int BM = 256, BK = 64, HALF = 128, HTB = HALF * BK * 2  , STAGE_BYTES = 8 * HTB, NXCD = 8, WGM = 8;

__host__ __device__ __forceinline__ int lds_byte(int r, int c) { const int st = (r >> 4) * 2 + (c >> 5), rr = r & 15, cc = c & 31, ob = rr * 64 + cc * 2; return st * 1024 + (ob ^ (((ob >> 9) & 1) << 5)); }
__host__ __device__ __forceinline__ void stage_rc(int b, int& R, int& C) { const int st = b / 1024, sb = b % 1024, swz = sb ^ (((sb >> 9) & 1) << 5); R = (st >> 1) * 16 + swz / 64; C = (st & 1) * 32 + (swz % 64) / 2; }
__host__ __device__ __forceinline__ int perm32(int rho) { const int n = rho >> 4, i = rho & 15; return 8 * (i >> 2) + 4 * n + (i & 3); }

struct Unit { int pm, pn; };
struct Gemm { const bf16_t* A; const bf16_t* Bt; int M, N, K, ld; };

struct StaticOrder {
    int nM, nN, nwg, G, c;
    __host__ __device__ void init(int M, int N, int G_, int c_) { nM = M / BM; nN = N / BM; nwg = nM * nN; G = G_; c = c_; }
    __host__ __device__ bool next(int i, Unit& u) const {
        const long L = (long)i * G + c; if (L >= nwg) return false;
        int wgid = (int)L; { const int q = nwg / NXCD, r = nwg % NXCD, xcd = wgid % NXCD, off = wgid / NXCD; wgid = (xcd < r ? xcd * (q + 1) : r * (q + 1) + (xcd - r) * q) + off; }
        const int nig = WGM * nN, gid = wgid / nig, fm = gid * WGM, gsz = (nM - fm) < WGM ? (nM - fm) : WGM;
        u.pm = fm + ((wgid % nig) % gsz); u.pn = (wgid % nig) / gsz; return true;
    }
    __device__ __forceinline__ void a_ready(const Unit&) const {}
    __device__ __forceinline__ void done(const Unit&) const {}
};
__device__ __forceinline__ unsigned cvt_pk_bf16(float lo, float hi) { unsigned r; asm volatile("v_cvt_pk_bf16_f32 %0, %1, %2" : "=v"(r) : "v"(lo), "v"(hi)); return r; }
template <class Epi, class Sched, bool STAMP = false>
__device__ __forceinline__ void gemm_phase(PG8_LAS unsigned char* lds, const Gemm g, const Sched& S, const Epi& E, unsigned long long* stamps) {
    const int tid = tidx(), wid = __builtin_amdgcn_readfirstlane(tid >> 6), lane = tid & 63, wr = wid >> 2, wc = wid & 3, fr = lane & 15, fq = lane >> 4;
    const int K = g.K, nt = K / BK;
    int ts_lo = 0, ts_hi = 0, nts = 0; const unsigned long long rt_entry = STAMP ? (unsigned long long)wall_clock64() : 0ull;
#define PG8_STAMP() do { if (STAMP && wid == 0 && nts < 64) { const unsigned long long _c = (unsigned long long)clock64(); \
        ts_lo = (lane == nts) ? (int)(unsigned)_c : ts_lo; ts_hi = (lane == nts) ? (int)(unsigned)(_c >> 32) : ts_hi; ++nts; } } while (0)
    PG8_STAMP();
    unsigned voffA[2], voffB[2];
#pragma unroll
    for (int i = 0; i < 2; ++i) { int R, C; stage_rc(tid * 16 + i * 8192, R, C); const int Rb = Epi::PERM ? ((R & ~31) + perm32(R & 31)) : R;
        voffA[i] = (unsigned)(R * g.ld + C) * 2u; voffB[i] = (unsigned)(Rb * g.ld + C) * 2u; }
    const size_t kstep = (size_t)(BK * 2);
    const size_t hstep = (size_t)HALF * g.ld * 2;
    const size_t tstep = 2 * hstep;
    const unsigned ldsw = (unsigned)wid * 1024u;
    const int aoff = lds_byte(wr * 64 + fr, fq * 8), boff = lds_byte(wc * 32 + fr, fq * 8);
#define PG8_SA(b, h) (((b) * 2 + (h)) * HTB)
#define PG8_SB(b, h) ((4 + (b) * 2 + (h)) * HTB)
#define PG8_STAGE(bufoff, gbase, voff) do { _Pragma("unroll") for (int _i = 0; _i < 2; ++_i) \
        __builtin_amdgcn_global_load_lds((const unsigned*)((const char*)(gbase) + (voff)[_i]), (PG8_LAS unsigned*)(lds + (bufoff) + ldsw + _i * 8192), 16, 0, 0); } while (0)
#define PG8_LDA(dst, b, h) do { _Pragma("unroll") for (int m = 0; m < 4; ++m) _Pragma("unroll") for (int k = 0; k < 2; ++k) dst[m][k] = *(const PG8_LAS bf16x8*)(lds + PG8_SA(b, h) + aoff + m * 2048 + k * 1024); } while (0)
#define PG8_LDB(dst, b, h) do { _Pragma("unroll") for (int n = 0; n < 2; ++n) _Pragma("unroll") for (int k = 0; k < 2; ++k) dst[n][k] = *(const PG8_LAS bf16x8*)(lds + PG8_SB(b, h) + boff + n * 2048 + k * 1024); } while (0)
#define PG8_MMA(ai, bj, At, Bt) do { __builtin_amdgcn_s_setprio(1); _Pragma("unroll") for (int m = 0; m < 4; ++m) _Pragma("unroll") for (int n = 0; n < 2; ++n) _Pragma("unroll") for (int k = 0; k < 2; ++k) \
        acc[ai][bj][m][n] = __builtin_amdgcn_mfma_f32_16x16x32_bf16(Bt[n][k], At[m][k], acc[ai][bj][m][n], 0, 0, 0); __builtin_amdgcn_s_setprio(0); } while (0)
#define PG8_WAIT_V(n) asm volatile("s_waitcnt vmcnt(" #n ")" ::: "memory")
#define PG8_WAIT_L(n) asm volatile("s_waitcnt lgkmcnt(" #n ")" ::: "memory")
#define PG8_BAR __builtin_amdgcn_s_barrier()
#define PG8_SCHED __builtin_amdgcn_sched_barrier(0)
    Unit cur, nxt; int ui = 0;
    if (!S.next(0, cur)) return;
    f32x4 acc[2][2][4][2];
#pragma unroll
    for (int a = 0; a < 2; ++a)
#pragma unroll
        for (int b = 0; b < 2; ++b)
#pragma unroll
            for (int m = 0; m < 4; ++m)
#pragma unroll
                for (int n = 0; n < 2; ++n) acc[a][b][m][n] = (f32x4){0.f, 0.f, 0.f, 0.f};
    bf16x8 At[4][2], B0[2][2], B1[2][2];
    const char* cA = (const char*)g.A + (size_t)cur.pm * tstep; const char* cB = (const char*)g.Bt + (size_t)cur.pn * tstep;
    S.a_ready(cur);
    PG8_STAGE(PG8_SB(0, 0), cB, voffB); PG8_STAGE(PG8_SA(0, 0), cA, voffA); PG8_STAGE(PG8_SB(0, 1), cB + hstep, voffB); PG8_STAGE(PG8_SA(0, 1), cA + hstep, voffA);
    if (wr == 1) PG8_BAR;
    PG8_WAIT_V(4); PG8_BAR;
    PG8_STAGE(PG8_SB(1, 0), cB + kstep, voffB); PG8_STAGE(PG8_SA(1, 0), cA + kstep, voffA); PG8_STAGE(PG8_SB(1, 1), cB + hstep + kstep, voffB);
    PG8_WAIT_V(6); PG8_BAR;
    PG8_STAMP();
    for (;;) {
        const bool has_next = S.next(ui + 1, nxt);
        const char* nA = has_next ? (const char*)g.A + (size_t)nxt.pm * tstep : cA; const char* nB = has_next ? (const char*)g.Bt + (size_t)nxt.pn * tstep : cB;
        for (int t = 0; t < nt; t += 2) {
            const bool last = (t == nt - 2);
            const char* a1 = cA + (size_t)(t + 1) * kstep;
            const char* a2 = last ? nA : cA + (size_t)(t + 2) * kstep; const char* b2 = last ? nB : cB + (size_t)(t + 2) * kstep;
            const char* a3 = a2 + kstep; const char* b3 = b2 + kstep;
            if (last && has_next) S.a_ready(nxt);
            PG8_LDB(B0, 0, 0); PG8_SCHED; PG8_LDA(At, 0, 0); PG8_STAGE(PG8_SA(1, 1), a1 + hstep, voffA);
            PG8_WAIT_L(8); PG8_BAR; PG8_WAIT_L(0); PG8_MMA(0, 0, At, B0); PG8_BAR; PG8_SCHED;
            PG8_LDB(B1, 0, 1); PG8_STAGE(PG8_SB(0, 0), b2, voffB);
            PG8_BAR; PG8_WAIT_L(0); PG8_MMA(0, 1, At, B1); PG8_BAR;
            PG8_LDA(At, 0, 1); PG8_STAGE(PG8_SA(0, 0), a2, voffA);
            PG8_BAR; PG8_WAIT_L(0); PG8_MMA(1, 0, At, B0); PG8_BAR; PG8_SCHED;
            PG8_STAGE(PG8_SB(0, 1), b2 + hstep, voffB);
            PG8_WAIT_V(6); PG8_BAR; PG8_MMA(1, 1, At, B1); PG8_BAR;
            PG8_LDB(B0, 1, 0); PG8_SCHED; PG8_LDA(At, 1, 0); PG8_STAGE(PG8_SA(0, 1), a2 + hstep, voffA);
            PG8_WAIT_L(8); PG8_BAR; PG8_WAIT_L(0); PG8_MMA(0, 0, At, B0); PG8_BAR; PG8_SCHED;
            PG8_LDB(B1, 1, 1); PG8_STAGE(PG8_SB(1, 0), b3, voffB);
            PG8_BAR; PG8_WAIT_L(0); PG8_MMA(0, 1, At, B1); PG8_BAR;
            PG8_LDA(At, 1, 1); PG8_STAGE(PG8_SA(1, 0), a3, voffA);
            PG8_BAR; PG8_WAIT_L(0); PG8_MMA(1, 0, At, B0); PG8_BAR; PG8_SCHED;
            PG8_STAGE(PG8_SB(1, 1), b3 + hstep, voffB);
            PG8_WAIT_V(6); PG8_BAR; PG8_MMA(1, 1, At, B1); PG8_BAR;
        }
        PG8_STAMP();
        if constexpr (!Epi::AFTER_DRAIN) { E(acc, cur, wr, wc, fr, fq); S.done(cur); }
        PG8_STAMP();
        if (!has_next) break;
#pragma unroll
        for (int a = 0; a < 2; ++a)
#pragma unroll
            for (int b = 0; b < 2; ++b)
#pragma unroll
                for (int m = 0; m < 4; ++m)
#pragma unroll
                    for (int n = 0; n < 2; ++n) acc[a][b][m][n] = (f32x4){0.f, 0.f, 0.f, 0.f};
        cur = nxt; cA = nA; cB = nB; ++ui;
    }
    PG8_WAIT_V(0);
    if (wr == 0) PG8_BAR;
    PG8_BAR;
    if constexpr (Epi::AFTER_DRAIN) { E.fused(acc, cur, wr, wc, fr, fq, lds, wid, lane); S.done(cur); }
    PG8_STAMP();
    if (STAMP && wid == 0) { stamps[lane] = lane < nts ? (((unsigned long long)(unsigned)ts_hi << 32) | (unsigned)ts_lo) : 0ull;
        if (lane == 62) stamps[62] = rt_entry; if (lane == 63) stamps[63] = (unsigned long long)wall_clock64(); }
#undef PG8_STAMP
#undef PG8_SA
#undef PG8_SB
#undef PG8_STAGE
#undef PG8_LDA
#undef PG8_LDB
#undef PG8_MMA
#undef PG8_WAIT_V
#undef PG8_WAIT_L
#undef PG8_BAR
#undef PG8_SCHED
}
}
#define XB_TMO      128
#define XB_XCNT(j)  (256  + 64 * (j))
#define XB_XSUB(j)  (1280 + 64 * (j))
#define XB_XGEN(j)  (2304 + 64 * (j))
#define XB_TOP      3328
#define XB_TOPGEN   3392
#define XCD_BAR_WORDS 3456
#define XB_SPIN_CAP (1u << 18)
#define LAS __attribute__((address_space(3)))

__device__ __forceinline__ unsigned xb_ld(unsigned* p)              { return __hip_atomic_load(p, __ATOMIC_RELAXED, __HIP_MEMORY_SCOPE_AGENT); }
__device__ __forceinline__ unsigned xb_add(unsigned* p, unsigned v) { return __hip_atomic_fetch_add(p, v, __ATOMIC_RELAXED, __HIP_MEMORY_SCOPE_AGENT); }
__device__ __forceinline__ unsigned xb_xcc_id() { return (unsigned)__builtin_amdgcn_s_getreg((3 << 11) | 20) & 0xFu; }
#define XB_SPIN(cond, bar) do { unsigned _sp = 0; while (cond) { __builtin_amdgcn_s_sleep(1); \
    if ((++_sp & 255u) == 0u) { if (xb_ld(&(bar)[XB_TMO])) break; if (_sp > XB_SPIN_CAP) { atomicAdd(&(bar)[XB_TMO], 1u); break; } } } } while (0)

struct XcdBarrier {
    unsigned* bar; unsigned x;
    volatile LAS unsigned* st;
};

__device__ __forceinline__ XcdBarrier xcd_barrier_post(unsigned* bar, volatile LAS unsigned* st) {
    XcdBarrier b; b.bar = bar; b.x = xb_xcc_id(); b.st = st;
    if (threadIdx.x == 0) (void)xb_add(&bar[XB_XCNT(b.x)], 1u);
    return b;
}
__device__ __forceinline__ void xcd_barrier_complete(unsigned* bar, unsigned x, unsigned& nloc, unsigned& nx) {
    const unsigned G = gridDim.x * gridDim.y * gridDim.z;
    unsigned sum, cnt, mine, sp = 0u;
    for (;;) {
        sum = 0u; cnt = 0u; mine = 0u;
#pragma unroll
        for (unsigned j = 0; j < 16; ++j) { const unsigned c = xb_ld(&bar[XB_XCNT(j)]); sum += c; cnt += (c > 0u) ? 1u : 0u; mine = (j == x) ? c : mine; }
        if (sum == G) break;
        __builtin_amdgcn_s_sleep(1);
        if ((++sp & 255u) == 0u) { if (xb_ld(&bar[XB_TMO])) break; if (sp > XB_SPIN_CAP) { atomicAdd(&bar[XB_TMO], 1u); break; } }
    }
    nloc = mine > 0u ? mine : 1u; nx = cnt > 0u ? cnt : 1u;
}

__device__ __forceinline__ void xcd_barrier(const XcdBarrier& b) {
    asm volatile("s_waitcnt vmcnt(0)" ::: "memory");
    __syncthreads();
    if (threadIdx.x == 0) {
        unsigned* bar = b.bar;
        __builtin_amdgcn_s_waitcnt(0);
        unsigned nloc = b.st[0], nx = b.st[1];
        if (nloc == 0u) { xcd_barrier_complete(bar, b.x, nloc, nx); b.st[0] = nloc; b.st[1] = nx; }
        const unsigned old = xb_add(&bar[XB_XSUB(b.x)], 1u);
        const unsigned gen = old / nloc;
        if (old + 1u == (gen + 1u) * nloc) {
            __builtin_amdgcn_fence(__ATOMIC_RELEASE, "agent");
            asm volatile("s_waitcnt vmcnt(0)" ::: "memory");
            const unsigned og = xb_add(&bar[XB_TOP], 1u);
            const unsigned tg = og / nx;
            if (og + 1u == (tg + 1u) * nx) xb_add(&bar[XB_TOPGEN], 1u);
            else XB_SPIN(xb_ld(&bar[XB_TOPGEN]) == tg, bar);
            __builtin_amdgcn_fence(__ATOMIC_ACQUIRE, "agent");
            xb_add(&bar[XB_XGEN(b.x)], 1u);
            asm volatile("s_waitcnt vmcnt(0)" ::: "memory");
        } else {
            XB_SPIN(xb_ld(&bar[XB_XGEN(b.x)]) == gen, bar);
            __builtin_amdgcn_fence(__ATOMIC_ACQUIRE, "agent");
            asm volatile("s_waitcnt vmcnt(0)" ::: "memory");
        }
    }
    __syncthreads();
}
namespace pg8 {
struct EpiZ {
    static constexpr bool PERM = true, AFTER_DRAIN = false;
    bf16_t* O; int ldc;
    __device__ __forceinline__ void operator()(const f32x4 (&acc)[2][2][4][2], const Unit& u, int wr, int wc, int fr, int fq) const {
        const int row0 = u.pm * BM + wr * 64 + fr, col0 = u.pn * BM + wc * 32 + 8 * fq;
#pragma unroll
        for (int ai = 0; ai < 2; ++ai)
#pragma unroll
            for (int m = 0; m < 4; ++m) { bf16_t* rowp = O + (size_t)(row0 + ai * HALF + m * 16) * ldc + col0;
#pragma unroll
                for (int bj = 0; bj < 2; ++bj) { const f32x4 v0 = acc[ai][bj][m][0], v1 = acc[ai][bj][m][1];
                    u32x4 w; w.x = cvt_pk_bf16(v0[0], v0[1]); w.y = cvt_pk_bf16(v0[2], v0[3]); w.z = cvt_pk_bf16(v1[0], v1[1]); w.w = cvt_pk_bf16(v1[2], v1[3]);
                    *(u32x4*)(rowp + bj * HALF) = w; } }
    }
};
struct EpiRes {
    static constexpr bool PERM = false, AFTER_DRAIN = false;
    float* H; const float* gate_ctx; const float* gate_lat; int row_off;
    __device__ __forceinline__ void operator()(const f32x4 (&acc)[2][2][4][2], const Unit& u, int wr, int wc, int fr, int fq) const {
        const int row0 = row_off + u.pm * BM + wr * 64 + fr, col0 = u.pn * BM + wc * 32 + 4 * fq;
        const float* gt = (row_off + u.pm * BM) < 256 ? gate_ctx : gate_lat;
        f32x4 gv[2][2];
#pragma unroll
        for (int bj = 0; bj < 2; ++bj)
#pragma unroll
            for (int n = 0; n < 2; ++n) gv[bj][n] = *(const f32x4*)(gt + col0 + bj * HALF + n * 16);
#pragma unroll
        for (int ai = 0; ai < 2; ++ai) {
            f32x4 hv[4][2][2];
#pragma unroll
            for (int m = 0; m < 4; ++m)
#pragma unroll
                for (int bj = 0; bj < 2; ++bj)
#pragma unroll
                    for (int n = 0; n < 2; ++n) hv[m][bj][n] = *(const f32x4*)(H + (size_t)(row0 + ai * HALF + m * 16) * 2048 + col0 + bj * HALF + n * 16);
#pragma unroll
            for (int m = 0; m < 4; ++m)
#pragma unroll
                for (int bj = 0; bj < 2; ++bj)
#pragma unroll
                    for (int n = 0; n < 2; ++n) *(f32x4*)(H + (size_t)(row0 + ai * HALF + m * 16) * 2048 + col0 + bj * HALF + n * 16) = hv[m][bj][n] + gv[bj][n] * acc[ai][bj][m][n];
        }
    }
};
struct EpiResAtomic {
    static constexpr bool PERM = false, AFTER_DRAIN = false;
    float* H; const float* gate;
    __device__ __forceinline__ void operator()(const f32x4 (&acc)[2][2][4][2], const Unit& u, int wr, int wc, int fr, int fq) const {
        const int row0 = u.pm * BM + wr * 64 + fr, col0 = u.pn * BM + wc * 32 + 4 * fq;
#pragma unroll
        for (int bj = 0; bj < 2; ++bj)
#pragma unroll
            for (int n = 0; n < 2; ++n) { const f32x4 gv = *(const f32x4*)(gate + col0 + bj * HALF + n * 16);
#pragma unroll
                for (int ai = 0; ai < 2; ++ai)
#pragma unroll
                    for (int m = 0; m < 4; ++m) { float* q = H + (size_t)(row0 + ai * HALF + m * 16) * 2048 + col0 + bj * HALF + n * 16;
#pragma unroll
                        for (int j = 0; j < 4; ++j) atomicAdd(q + j, gv[j] * acc[ai][bj][m][n][j]); } }
    }
};
}

namespace att {
using bf16 = unsigned short;
constexpr int   D = 128, NW = 8, QBLK = 32, KVBLK = 64;
constexpr float SCALE = 0.088388347648318440f;
constexpr float THR = 8.f;
constexpr int SDEPTH = 2;
constexpr int LDQ = 1024, LDK = 256, LDV = 5888, LDG = 5888, LDO = 1024;
constexpr size_t SHM_V = KVBLK * D * 2, SHM_K = KVBLK * D * 2, SHM_ATTN = 2 * SHM_V + 2 * SHM_K + NW * 64 * 4;
using bf16x8 = __attribute__((ext_vector_type(8))) short;
using s16x4  = __attribute__((ext_vector_type(4))) short;
using f32x16 = __attribute__((ext_vector_type(16))) float;
using f32x8  = __attribute__((ext_vector_type(8))) float;
using u32x4  = __attribute__((ext_vector_type(4))) unsigned;
#define KSWZ(row, colB) ((row) * 256 + ((colB) ^ (((row) & 7) << 4)))
#define SBAR() __builtin_amdgcn_sched_barrier(0)
__device__ __forceinline__ int crow(int r, int hi) { return (r & 3) + 8 * (r >> 2) + 4 * hi; }
__device__ __forceinline__ unsigned cvtpk(float lo, float hi) {
  unsigned r; asm volatile("v_cvt_pk_bf16_f32 %0, %1, %2" : "=v"(r) : "v"(lo), "v"(hi)); return r;
}
template <typename TIn> struct Stage;
template <> struct Stage<bf16>  { using T = bf16x8;
  __device__ static __forceinline__ T ld8(const bf16* p) { return *reinterpret_cast<const bf16x8*>(p); }
  __device__ static __forceinline__ bf16x8 tobf(T x) { return x; } };
template <> struct Stage<float> { using T = f32x8;
  __device__ static __forceinline__ T ld8(const float* p) { return *reinterpret_cast<const f32x8*>(p); }
  __device__ static __forceinline__ bf16x8 tobf(T x) {
    u32x4 w = {cvtpk(x[0], x[1]), cvtpk(x[2], x[3]), cvtpk(x[4], x[5]), cvtpk(x[6], x[7])}; return *reinterpret_cast<bf16x8*>(&w); } };

__device__ __forceinline__ void partialSM(f32x16& p0, f32x16& p1, float& m_reg, float& mn, float& alpha) {
  constexpr float C = SCALE * 1.4426950408889634f;
  float pmax = p0[0]; for (int r = 1; r < 16; ++r) pmax = fmaxf(pmax, p0[r]); for (int r = 0; r < 16; ++r) pmax = fmaxf(pmax, p1[r]);
  { auto rr = __builtin_amdgcn_permlane32_swap(__float_as_uint(pmax), __float_as_uint(pmax), false, false);
    pmax = fmaxf(__uint_as_float(rr[0]), __uint_as_float(rr[1])); }
  if (__builtin_expect(__all(pmax - m_reg <= THR / SCALE), 1)) { mn = m_reg; alpha = 1.f; }
  else { mn = fmaxf(m_reg, pmax); alpha = __builtin_amdgcn_exp2f((m_reg - mn) * C); m_reg = mn; }
  float mnC = -mn * C;
  for (int r = 0; r < 16; ++r) p0[r] = fmaf(p0[r], C, mnC); for (int r = 0; r < 16; ++r) p1[r] = fmaf(p1[r], C, mnC);
  for (int r = 0; r < 16; ++r) p0[r] = __builtin_amdgcn_exp2f(p0[r]);
}
__device__ __forceinline__ void finishSM(f32x16& p0, f32x16& p1, float alpha, float& l_reg, bf16x8& pa0, bf16x8& pa1, bf16x8& pa2, bf16x8& pa3) {
  for (int r = 0; r < 16; ++r) p1[r] = __builtin_amdgcn_exp2f(p1[r]);
  float ps = 0; for (int r = 0; r < 16; ++r) ps += p0[r]; for (int r = 0; r < 16; ++r) ps += p1[r];
  { auto rr = __builtin_amdgcn_permlane32_swap(__float_as_uint(ps), __float_as_uint(ps), false, false);
    ps = __uint_as_float(rr[0]) + __uint_as_float(rr[1]); }
  l_reg = l_reg * alpha + ps;
#define PK4(P, BASE, OUT) do { unsigned a0 = cvtpk(P[BASE + 0], P[BASE + 1]), a1 = cvtpk(P[BASE + 2], P[BASE + 3]);   \
    unsigned b0 = cvtpk(P[BASE + 4], P[BASE + 5]), b1 = cvtpk(P[BASE + 6], P[BASE + 7]);                              \
    auto r0 = __builtin_amdgcn_permlane32_swap(a0, b0, false, false); auto r1 = __builtin_amdgcn_permlane32_swap(a1, b1, false, false); \
    u32x4 w = {r0[0], r1[0], r0[1], r1[1]}; OUT = *reinterpret_cast<bf16x8*>(&w); } while (0)
  PK4(p0, 0, pa0); PK4(p0, 8, pa1); PK4(p1, 0, pa2); PK4(p1, 8, pa3);
#undef PK4
}
__device__ __forceinline__ void qkt(f32x16& p0, f32x16& p1, const bf16* Ks, const bf16x8* qr, int r32, int hi) {
  p0 = f32x16{}; p1 = f32x16{};
  for (int d0 = 0; d0 < 8; ++d0) { int cb = (d0 * 16 + hi * 8) * 2;
    bf16x8 b0 = *reinterpret_cast<const bf16x8*>((const char*)Ks + KSWZ(r32, cb));
    bf16x8 b1 = *reinterpret_cast<const bf16x8*>((const char*)Ks + KSWZ(32 + r32, cb));
    p0 = __builtin_amdgcn_mfma_f32_32x32x16_bf16(b0, qr[d0], p0, 0, 0, 0);
    p1 = __builtin_amdgcn_mfma_f32_32x32x16_bf16(b1, qr[d0], p1, 0, 0, 0); }
}
__device__ __forceinline__ int v_st(int k, int c) { const int kk = (k & ~0xC) | ((k & 4) << 1) | ((k & 8) >> 1); return ((kk >> 3) * 4 + (c >> 5)) * 512 + ((kk & 7) * 32 + (c & 31)) * 2; }
__device__ __forceinline__ int v_rd_base(int lane) { return ((lane & 3) << 3) | (((lane >> 2) & 3) << 6) | (((lane >> 4) & 1) << 5) | (((lane >> 5) & 1) << 8); }
constexpr int v_rd_off(int d0, int ks, int half) { return d0 * 512 + ks * 4096 + half * 2048; }
template <int OFF> __device__ __forceinline__ s16x4 tr_read(int vb) {
  s16x4 r; asm volatile("ds_read_b64_tr_b16 %0, %1 offset:%2" : "=&v"(r) : "v"(vb), "i"(OFF) : "memory"); return r;
}
template <int D0> __device__ __forceinline__ void pv_one(f32x16& od, int vb, bf16x8 pa0, bf16x8 pa1, bf16x8 pa2, bf16x8 pa3) {
  const s16x4 l0 = tr_read<v_rd_off(D0, 0, 0)>(vb), h0 = tr_read<v_rd_off(D0, 0, 1)>(vb), l1 = tr_read<v_rd_off(D0, 1, 0)>(vb), h1 = tr_read<v_rd_off(D0, 1, 1)>(vb);
  const s16x4 l2 = tr_read<v_rd_off(D0, 2, 0)>(vb), h2 = tr_read<v_rd_off(D0, 2, 1)>(vb), l3 = tr_read<v_rd_off(D0, 3, 0)>(vb), h3 = tr_read<v_rd_off(D0, 3, 1)>(vb);
  asm volatile("s_waitcnt lgkmcnt(0)" ::: "memory"); SBAR();
#define PK(L, H) (bf16x8){L[0], L[1], L[2], L[3], H[0], H[1], H[2], H[3]}
  od = __builtin_amdgcn_mfma_f32_32x32x16_bf16(pa0, PK(l0, h0), od, 0, 0, 0);
  od = __builtin_amdgcn_mfma_f32_32x32x16_bf16(pa1, PK(l1, h1), od, 0, 0, 0);
  od = __builtin_amdgcn_mfma_f32_32x32x16_bf16(pa2, PK(l2, h2), od, 0, 0, 0);
  od = __builtin_amdgcn_mfma_f32_32x32x16_bf16(pa3, PK(l3, h3), od, 0, 0, 0);
#undef PK
}
__device__ __forceinline__ void pv_d0(f32x16* o, int vb, bf16x8 pa0, bf16x8 pa1, bf16x8 pa2, bf16x8 pa3) {
  pv_one<0>(o[0], vb, pa0, pa1, pa2, pa3); pv_one<1>(o[1], vb, pa0, pa1, pa2, pa3); pv_one<2>(o[2], vb, pa0, pa1, pa2, pa3); pv_one<3>(o[3], vb, pa0, pa1, pa2, pa3);
}
__device__ __forceinline__ void attn_dense_body(const bf16* __restrict__ Qb, const bf16* __restrict__ Kh, const bf16* __restrict__ Vh,
                                                float* __restrict__ ML, bf16* __restrict__ Mx, int seq, char* lds) {
  using TQ = bf16;
  using St = Stage<bf16>; using SQ = Stage<TQ>;
  const int tid = tidx(), wid = tid >> 6, lane = tid & 63, r32 = lane & 31, hi = lane >> 5;
  bf16* V_lds = (bf16*)lds; bf16* K_lds = (bf16*)(lds + 2 * SHM_V);
  float* ws = (float*)(lds + 2 * SHM_V + 2 * SHM_K) + wid * 64; float* li_l = ws; float* al_l = ws + 32;
  float m_reg = -1e30f, l_reg = 0; f32x16 o[4] = {}; bf16x8 qr[8];
  const TQ* Qw = Qb + (long)(wid * QBLK + r32) * LDQ + hi * 8;
#pragma unroll
  for (int d0 = 0; d0 < 8; ++d0) qr[d0] = SQ::tobf(SQ::ld8(Qw + d0 * 16));
  const int sr = tid >> 4, sc = (tid & 15) * 8, vst0 = v_st(sr, sc), vst1 = v_st(32 + sr, sc);
  const int vb0 = (int)(uintptr_t)V_lds + v_rd_base(lane);
  struct { typename St::T vs0, vs1, ks0, ks1; } sr_[SDEPTH];
#define SLOAD(i, k0) do { sr_[i].vs0 = St::ld8(&Vh[(long)((k0) + sr) * LDK + sc]); sr_[i].vs1 = St::ld8(&Vh[(long)((k0) + 32 + sr) * LDK + sc]); \
    sr_[i].ks0 = St::ld8(&Kh[(long)((k0) + sr) * LDK + sc]); sr_[i].ks1 = St::ld8(&Kh[(long)((k0) + 32 + sr) * LDK + sc]); } while (0)
#define SWRITE(b, i) do { *(bf16x8*)((char*)V_lds + (b) * SHM_V + vst0) = St::tobf(sr_[i].vs0);          \
    *(bf16x8*)((char*)V_lds + (b) * SHM_V + vst1) = St::tobf(sr_[i].vs1); int kc = sc * 2;               \
    *(bf16x8*)((char*)K_lds + (b) * SHM_K + KSWZ(sr, kc)) = St::tobf(sr_[i].ks0);                       \
    *(bf16x8*)((char*)K_lds + (b) * SHM_K + KSWZ(32 + sr, kc)) = St::tobf(sr_[i].ks1); } while (0)
#define SWAIT() do { if constexpr (SDEPTH == 2) asm volatile("s_waitcnt vmcnt(4)" ::: "memory"); else asm volatile("s_waitcnt vmcnt(0)" ::: "memory"); } while (0)
#define RESC(a) do { if (__any((a) < 1.f)) { if (hi == 0) al_l[r32] = (a); asm volatile("s_waitcnt lgkmcnt(0)" ::: "memory"); \
    for (int d = 0; d < 4; ++d) for (int r = 0; r < 16; ++r) o[d][r] *= al_l[crow(r, hi)]; } } while (0)
  f32x16 pA0, pA1, pB0, pB1; float mnA, mnB, alA, alB; bf16x8 pa0, pa1, pa2, pa3; const int NT = seq / KVBLK;
  constexpr int SE = 0, SO = SDEPTH - 1;
  SLOAD(SE, 0); asm volatile("s_waitcnt vmcnt(0)" ::: "memory"); SWRITE(0, SE); __syncthreads();
  qkt(pA0, pA1, K_lds, qr, r32, hi); partialSM(pA0, pA1, m_reg, mnA, alA);
  SLOAD(SO, KVBLK); if constexpr (SDEPTH == 2) { if (2 < NT) SLOAD(SE, 2 * KVBLK); }
  SWAIT(); SWRITE(1, SO); __syncthreads();
  for (int j = 1; j + 1 < NT; j += 2) {
    SBAR(); qkt(pB0, pB1, (bf16*)((char*)K_lds + SHM_K), qr, r32, hi);
    finishSM(pA0, pA1, alA, l_reg, pa0, pa1, pa2, pa3); SBAR();
    SLOAD(SO, (j + SDEPTH) * KVBLK); SBAR();
    pv_d0(o, vb0, pa0, pa1, pa2, pa3); partialSM(pB0, pB1, m_reg, mnB, alB);
    __syncthreads(); SWAIT(); SWRITE(0, SE);
    RESC(alB); __syncthreads();
    SBAR(); qkt(pA0, pA1, K_lds, qr, r32, hi);
    finishSM(pB0, pB1, alB, l_reg, pa0, pa1, pa2, pa3); SBAR();
    if (SDEPTH == 1 || j + 3 < NT) SLOAD(SE, (j + 1 + SDEPTH) * KVBLK); SBAR();
    pv_d0(o, vb0 + (int)SHM_V, pa0, pa1, pa2, pa3); partialSM(pA0, pA1, m_reg, mnA, alA);
    __syncthreads(); SWAIT(); SWRITE(1, SO);
    RESC(alA); __syncthreads();
  }
  SBAR(); qkt(pB0, pB1, (bf16*)((char*)K_lds + SHM_K), qr, r32, hi);
  finishSM(pA0, pA1, alA, l_reg, pa0, pa1, pa2, pa3); SBAR();
  pv_d0(o, vb0, pa0, pa1, pa2, pa3); partialSM(pB0, pB1, m_reg, mnB, alB);
  __syncthreads(); RESC(alB);
  finishSM(pB0, pB1, alB, l_reg, pa0, pa1, pa2, pa3); SBAR();
  pv_d0(o, vb0 + (int)SHM_V, pa0, pa1, pa2, pa3);
  if (hi == 0) { li_l[r32] = l_reg; if (ML != nullptr) { *(float2*)(ML + (long)(wid * QBLK + r32) * 16) = make_float2(m_reg, l_reg); } } asm volatile("s_waitcnt lgkmcnt(0)" ::: "memory");
  float rli[16];
#pragma unroll
  for (int r = 0; r < 16; ++r) rli[r] = __builtin_amdgcn_rcpf(li_l[crow(r, hi)]);
  bf16* Mw = Mx + (long)(wid * QBLK) * LDO;
#pragma unroll
  for (int r = 0; r < 16; ++r) { int orow = crow(r, hi);
#pragma unroll
    for (int d0 = 0; d0 < 4; ++d0) Mw[(long)orow * LDO + d0 * 32 + r32] = f2bf(o[d0][r] * rli[r]); }
#undef SLOAD
#undef SWRITE
#undef SWAIT
#undef RESC
}
}

constexpr int CV_NT_IN = 32 * 23, CV_NT_OUT = 32 * 8, CV_TILES = CV_NT_IN + CV_NT_OUT, CV_ITEMS = CV_TILES + 96;
__device__ __forceinline__ void convert_tile(const Params& p, int l, int r, unsigned char* smem) {
  const int tid = tidx();
  float* tile = (float*)smem;
  const bool isin = r < CV_NT_IN;
  const float* src; bf16_t* dst; int kt, nt, ldsrc;
  if (isin) { kt = r / 23; nt = r % 23; src = p.w_in + (size_t)l * DM * DIN; ldsrc = DIN; dst = (bf16_t*)(p.ws + WS_WIN) + (size_t)l * ZLD * DM; }
  else { r -= CV_NT_IN; kt = r / 8; nt = r % 8; src = p.w_out + (size_t)l * DM * DM; ldsrc = DM; dst = (bf16_t*)(p.ws + WS_WOUT) + (size_t)l * DM * DM; }
  __syncthreads();
  float4 v[8];
#pragma unroll
  for (int i = 0; i < 8; ++i) {
    const int e = tid + 512 * i, kk = e >> 6, n = nt * 256 + (e & 63) * 4;
    const int oc = isin ? (n < 3072 ? n : (n < 5632 ? n + 16 : (n < 5648 ? n - 2560 : -1))) : n;
    v[i] = oc >= 0 ? *(const float4*)(src + (size_t)(kt * 64 + kk) * ldsrc + oc) : make_float4(0.f, 0.f, 0.f, 0.f);
  }
#pragma unroll
  for (int i = 0; i < 8; ++i) { const int e = tid + 512 * i; *(float4*)(tile + (e >> 6) * 260 + (e & 63) * 4) = v[i]; }
  __syncthreads();
  {
    const int nn = tid >> 1, k0 = (tid & 1) * 32;
    bf16_t* d = dst + (size_t)(nt * 256 + nn) * DM + kt * 64 + k0;
#pragma unroll
    for (int q = 0; q < 4; ++q) {
      float f[8];
#pragma unroll
      for (int i = 0; i < 8; ++i) f[i] = tile[(k0 + q * 8 + i) * 260 + nn];
      u32x4_t w = {cvtpk2(f[0], f[1]), cvtpk2(f[2], f[3]), cvtpk2(f[4], f[5]), cvtpk2(f[6], f[7])};
      *(u32x4_t*)(d + q * 8) = w;
    }
  }
}
__device__ __forceinline__ void mod_item(const Params& p, int l, int jg, unsigned char* smem) {
  const int tid = tidx();
  float* sc = (float*)smem;
  float* red = (float*)smem + 4096;
  __syncthreads();
  for (int k = tid; k < 2048; k += 512) { sc[k] = siluf_(p.c[k]); sc[2048 + k] = siluf_(p.c_ctx[k]); }
  __syncthreads();
  float* mod = (float*)(p.ws + WS_MOD);
  const int cq = tid & 15, kg = tid >> 4, j0 = jg * 64;
  const float* wp = p.w_mod + ((size_t)l * DM + kg * 64) * 6144 + j0 + cq * 4;
  float4 a0 = {0.f, 0.f, 0.f, 0.f}, a1 = {0.f, 0.f, 0.f, 0.f};
#pragma unroll 16
  for (int k = 0; k < 64; ++k) {
    const float4 w = *(const float4*)(wp + (size_t)k * 6144);
    const float s0 = sc[kg * 64 + k], s1 = sc[2048 + kg * 64 + k];
    a0.x += s0 * w.x; a0.y += s0 * w.y; a0.z += s0 * w.z; a0.w += s0 * w.w;
    a1.x += s1 * w.x; a1.y += s1 * w.y; a1.z += s1 * w.z; a1.w += s1 * w.w;
  }
  *(float4*)(red + (kg * 2 + 0) * 64 + cq * 4) = a0;
  *(float4*)(red + (kg * 2 + 1) * 64 + cq * 4) = a1;
  __syncthreads();
  if (tid < 128) {
    const int s = tid >> 6, j = tid & 63; float acc = 0.f;
#pragma unroll 8
    for (int g = 0; g < 32; ++g) acc += red[(g * 2 + s) * 64 + j];
    mod[((size_t)l * 2 + s) * 6144 + j0 + j] = acc + p.b_mod[(size_t)l * 6144 + j0 + j];
  }
}
__device__ __forceinline__ void convert_item(const Params& p, int l, int it, unsigned char* smem) {
  if (it < CV_TILES) convert_tile(p, l, it, smem); else mod_item(p, l, it - CV_TILES, smem);
}
__device__ void convert_queue(const Params& p, int l, unsigned char* smem) {
  unsigned* ctr = (unsigned*)(p.ws + WS_CTR) + 8 + l;
  volatile int* slot = (volatile int*)(smem + 144000);
  for (;;) {
    __syncthreads();
    if (tidx() == 0) *slot = (int)atomicAdd(ctr, 1u);
    __syncthreads();
    const int it = *slot;
    if (it >= CV_ITEMS) break;
    convert_item(p, l, it, smem);
  }
  __syncthreads();
}
__device__ void phase_prep0(const Params& p, unsigned char* smem) {
  const int tid = tidx(), nb = gridDim.x, bid = bidx();
  {
    float4* h4 = (float4*)(p.ws + WS_H);
    const float4* c4 = (const float4*)p.ctx; const float4* x4 = (const float4*)p.x;
    const long nctx = (long)TC * DM / 4, ntot = (long)TA * DM / 4;
    for (long i = (long)bid * 512 + tid; i < ntot; i += (long)nb * 512) h4[i] = i < nctx ? c4[i] : x4[i - nctx];
  }
  for (int it = bid; it < CV_ITEMS; it += nb) convert_item(p, 0, it, smem);
  {
    bf16_t* wg = (bf16_t*)(p.ws + WS_WG);
    const int total = NL * 2 * 2 * 8 * 4096;
    for (int e = bid * 512 + tid; e < total; e += nb * 512) {
      const int i = e & 63, j = (e >> 6) & 63, n = (e >> 12) & 7, g = (e >> 15) & 1, d = (e >> 16) & 1, l = e >> 17;
      const float* src = g ? p.w_ia : p.w_ra;
      wg[e] = f2bf(src[((((size_t)l * 2 + d) * 8 + n) * 64 + i) * 64 + j]);
    }
  }
  __syncthreads();
}

__device__ void phase_norm(const Params& p, int l) {
  const int tid = tidx(), lane = tid & 63, wid = tid >> 6;
  const float* H = (const float*)(p.ws + WS_H);
  bf16_t* XN = (bf16_t*)(p.ws + WS_XN);
  const float* g = p.norm_g + (size_t)l * DM;
  const float* mod = (const float*)(p.ws + WS_MOD) + (size_t)l * 2 * 6144;
  for (int r = bidx() * 8 + wid; r < TA; r += gridDim.x * 8) {
    const float* hr = H + (size_t)r * DM;
    const float* md = mod + (r < TC ? 6144 : 0);
    float4 v[8]; float ss = 0.f;
#pragma unroll
    for (int i = 0; i < 8; ++i) { v[i] = *(const float4*)(hr + i * 256 + lane * 4); ss += v[i].x * v[i].x + v[i].y * v[i].y + v[i].z * v[i].z + v[i].w * v[i].w; }
    ss = wave_sum(ss);
    const float rstd = rsqrtf(ss * (1.f / DM) + 1e-6f);
#pragma unroll
    for (int i = 0; i < 8; ++i) {
      const int c = i * 256 + lane * 4;
      const float4 gg = *(const float4*)(g + c), sh = *(const float4*)(md + c), scl = *(const float4*)(md + 2048 + c);
      const float o0 = v[i].x * rstd * gg.x * (1.f + scl.x) + sh.x, o1 = v[i].y * rstd * gg.y * (1.f + scl.y) + sh.y;
      const float o2 = v[i].z * rstd * gg.z * (1.f + scl.z) + sh.z, o3 = v[i].w * rstd * gg.w * (1.f + scl.w) + sh.w;
      u32x2_t w = {cvtpk2(o0, o1), cvtpk2(o2, o3)};
      *(u32x2_t*)(XN + (size_t)r * DM + c) = w;
    }
  }
}

__device__ void phase_final(const Params& p) {
  const int tid = tidx(), lane = tid & 63, wid = tid >> 6;
  const float* H = (const float*)(p.ws + WS_H);
  for (int t = bidx() * 8 + wid; t < TL; t += gridDim.x * 8) {
    const float* hr = H + (size_t)(TC + t) * DM;
    float4 v[8]; float ss = 0.f;
#pragma unroll
    for (int i = 0; i < 8; ++i) { v[i] = *(const float4*)(hr + i * 256 + lane * 4); ss += v[i].x * v[i].x + v[i].y * v[i].y + v[i].z * v[i].z + v[i].w * v[i].w; }
    ss = wave_sum(ss);
    const float rstd = rsqrtf(ss * (1.f / DM) + 1e-6f);
#pragma unroll
    for (int i = 0; i < 8; ++i) {
      const int c = i * 256 + lane * 4;
      const float4 gg = *(const float4*)(p.final_g + c);
      float4 o = {v[i].x * rstd * gg.x, v[i].y * rstd * gg.y, v[i].z * rstd * gg.z, v[i].w * rstd * gg.w};
      *(float4*)(p.out + (size_t)t * DM + c) = o;
    }
  }
}

__device__ void phase_qkprep(const Params& p, int l) {
  const int tid = tidx(), lane = tid & 63, wid = tid >> 6;
  const bf16_t* Z = (const bf16_t*)(p.ws + WS_Z);
  bf16_t* QB = (bf16_t*)(p.ws + WS_QB); bf16_t* KB = (bf16_t*)(p.ws + WS_KB); bf16_t* VB = (bf16_t*)(p.ws + WS_VB);
  const float gq1 = p.qn_c[l * 128 + lane], gq2 = p.qn_c[l * 128 + 64 + lane];
  const float gk1 = p.kn_c[l * 128 + lane], gk2 = p.kn_c[l * 128 + 64 + lane];
  const float inv_freq = exp2f(-(float)(lane & 31) * (13.287712379549449f / 32.f));
  for (int r = bidx() * 8 + wid; r < TA; r += gridDim.x * 8) {
    float cs = 1.f, sn = 0.f;
    if (r >= TC) {
      const int t = r - TC; const float pos = (float)(lane < 32 ? (t >> 6) : (t & 63));
      const float ang = pos * inv_freq;
      const float k = rintf(ang * 0.15915494309189535f);
      float rr = fmaf(-k, 6.2831854820251465f, ang); rr = fmaf(-k, -1.7484555e-7f, rr);
      cs = cosf(rr); sn = sinf(rr);
    }
    const bf16_t* zr = Z + (size_t)r * ZLD;
#pragma unroll
    for (int hh = 0; hh < 10; ++hh) {
      const int zc = hh < 8 ? ZC_QC + hh * 128 : ZC_KC + (hh - 8) * 128;
      const float x1 = bf2f(zr[zc + lane]), x2 = bf2f(zr[zc + 64 + lane]);
      const float ss = wave_sum(x1 * x1 + x2 * x2);
      const float rstd = rsqrtf(ss * (1.f / 128.f) + 1e-6f);
      const float y1 = x1 * rstd * (hh < 8 ? gq1 : gk1), y2 = x2 * rstd * (hh < 8 ? gq2 : gk2);
      const float o1 = y1 * cs - y2 * sn, o2 = y2 * cs + y1 * sn;
      bf16_t* dst = hh < 8 ? QB + (size_t)r * 1024 + hh * 128 : KB + (size_t)r * 256 + (hh - 8) * 128;
      dst[lane] = f2bf(o1); dst[64 + lane] = f2bf(o2);
    }
    *(u32x2_t*)(VB + (size_t)r * 256 + lane * 4) = *(const u32x2_t*)(zr + ZC_VC + lane * 4);
  }
}

__device__ __forceinline__ void lru_ab_item(const Params& p, int l, int it, unsigned char* smem) {
  const int tid = tidx(), lane = tid & 63, wid = tid >> 6, fr = lane & 15, fq = lane >> 4;
  const bf16_t* Z = (const bf16_t*)(p.ws + WS_Z);
  float* uS = (float*)smem;
  bf16_t* uB = (bf16_t*)(smem + 16640);
  float* aS = (float*)(smem + 16640 + 9216);
  float* bS = aS + 2 * 64 * 64;
  float* LA = (float*)(p.ws + WS_LA); float* LB = (float*)(p.ws + WS_LB);
  float* LSEG = (float*)(p.ws + WS_LSEG);
  const bf16_t* WG = (const bf16_t*)(p.ws + WS_WG) + (size_t)l * 2 * 2 * 8 * 4096;
  {
    const int rs = it >> 3, n = it & 7, r0 = rs * 64;
    const int seg_lo = r0 < TC ? 0 : TC, seg_hi = r0 < TC ? TC : TA;
    __syncthreads();
    {
      const int tk = tid >> 3, c8 = (tid & 7) * 8, ch0 = n * 64 + c8;
      float acc[8];
#pragma unroll
      for (int i = 0; i < 8; ++i) acc[i] = p.conv_a_b[l * 512 + ch0 + i];
#pragma unroll
      for (int kk = 0; kk < 4; ++kk) {
        const int rr = r0 + tk + kk - 2;
        if (rr >= seg_lo && rr < seg_hi) {
          const bf16x8_t xv = *(const bf16x8_t*)(Z + (size_t)rr * ZLD + ZC_XA + ch0);
          const float* cw = p.conv_a_w + ((size_t)l * 4 + kk) * 512 + ch0;
#pragma unroll
          for (int i = 0; i < 8; ++i) acc[i] += cw[i] * bf2f((bf16_t)xv[i]);
        }
      }
#pragma unroll
      for (int i = 0; i < 8; ++i) { uS[tk * 65 + c8 + i] = acc[i]; uB[tk * 72 + c8 + i] = f2bf(acc[i]); }
    }
    __syncthreads();
    {
      const int d = wid & 1, ct = wid >> 1;
      f32x4_t ar[4], ai[4];
#pragma unroll
      for (int m = 0; m < 4; ++m) { ar[m] = (f32x4_t){0.f, 0.f, 0.f, 0.f}; ai[m] = (f32x4_t){0.f, 0.f, 0.f, 0.f}; }
      const bf16_t* wr_ = WG + ((size_t)(d * 2 + 0) * 8 + n) * 4096 + (ct * 16 + fr) * 64;
      const bf16_t* wi_ = WG + ((size_t)(d * 2 + 1) * 8 + n) * 4096 + (ct * 16 + fr) * 64;
#pragma unroll
      for (int ks = 0; ks < 2; ++ks) {
        const bf16x8_t br = *(const bf16x8_t*)(wr_ + ks * 32 + fq * 8);
        const bf16x8_t bi = *(const bf16x8_t*)(wi_ + ks * 32 + fq * 8);
#pragma unroll
        for (int m = 0; m < 4; ++m) {
          const bf16x8_t a = *(const bf16x8_t*)(uB + (m * 16 + fr) * 72 + ks * 32 + fq * 8);
          ar[m] = __builtin_amdgcn_mfma_f32_16x16x32_bf16(a, br, ar[m], 0, 0, 0);
          ai[m] = __builtin_amdgcn_mfma_f32_16x16x32_bf16(a, bi, ai[m], 0, 0, 0);
        }
      }
      const int cl = ct * 16 + fr, ch = n * 64 + cl;
      const float bra = p.b_ra[(l * 2 + d) * 512 + ch], bia = p.b_ia[(l * 2 + d) * 512 + ch];
      const float spl = softplusf_(-p.lam_a[(l * 2 + d) * 512 + ch]);
#pragma unroll
      for (int m = 0; m < 4; ++m)
#pragma unroll
        for (int j = 0; j < 4; ++j) {
          const int tk = m * 16 + fq * 4 + j;
          const float gr = sigmoidf_(ar[m][j] + bra), gi = sigmoidf_(ai[m][j] + bia);
          const float la = -8.f * gr * spl, x2 = 2.f * la;
          const float om = x2 > -0.05f ? -x2 * (1.f + x2 * (0.5f + x2 * (0.16666667f + x2 * 0.041666668f))) : 1.f - fexp_(x2);
          const float a = fexp_(la), b = __builtin_amdgcn_sqrtf(om) * gi * uS[tk * 65 + cl];
          aS[(d * 64 + tk) * 64 + cl] = a; bS[(d * 64 + tk) * 64 + cl] = b;
          LA[((size_t)d * TA + r0 + tk) * 512 + ch] = a; LB[((size_t)d * TA + r0 + tk) * 512 + ch] = b;
        }
    }
    __syncthreads();
    if (tid < 128) {
      const int d = tid >> 6, cl = tid & 63;
      float A = 1.f, B = 0.f;
      for (int s = 0; s < 64; ++s) { const int tk = d ? 63 - s : s; const float a = aS[(d * 64 + tk) * 64 + cl], b = bS[(d * 64 + tk) * 64 + cl]; A *= a; B = a * B + b; }
      const int ps = d == 0 ? rs : (rs < 4 ? 3 - rs : 135 - rs);
      float* o = LSEG + (((size_t)d * NCH + ps) * 512 + n * 64 + cl) * 2;
      o[0] = A; o[1] = B;
    }
  }
}

__device__ void lru_carry(const Params& p, int blk  ) {
  const int d = blk, ch = tidx();
  const float* LSEG = (const float*)(p.ws + WS_LSEG) + (size_t)d * NCH * 512 * 2;
  float* LCAR = (float*)(p.ws + WS_LCAR) + (size_t)d * NCH * 512;
  float h = 0.f;
#pragma unroll 4
  for (int ps = 0; ps < NCH; ++ps) {
    const float2 ab = *(const float2*)(LSEG + ((size_t)ps * 512 + ch) * 2);
    LCAR[ps * 512 + ch] = h; h = ab.x * h + ab.y;
  }
}

__device__ __forceinline__ void lru_fin_item(const Params& p, int l, int rs) {
  const int ch = tidx();
  const float* LA = (const float*)(p.ws + WS_LA); const float* LB = (const float*)(p.ws + WS_LB);
  const float* LCAR = (const float*)(p.ws + WS_LCAR);
  const bf16_t* Z = (const bf16_t*)(p.ws + WS_Z); bf16_t* MIX = (bf16_t*)(p.ws + WS_MIX);
  {
    const int r0 = rs * 64, ps1 = rs < 4 ? 3 - rs : 135 - rs;
    float hb[64];
    float h = LCAR[((size_t)1 * NCH + ps1) * 512 + ch];
#pragma unroll
    for (int s = 0; s < 64; ++s) { const int tk = 63 - s; const size_t o = ((size_t)1 * TA + r0 + tk) * 512 + ch; h = LA[o] * h + LB[o]; hb[tk] = h; }
    h = LCAR[((size_t)0 * NCH + rs) * 512 + ch];
#pragma unroll
    for (int tk = 0; tk < 64; ++tk) {
      const size_t o = ((size_t)0 * TA + r0 + tk) * 512 + ch; h = LA[o] * h + LB[o];
      const float ga = bf2f(Z[(size_t)(r0 + tk) * ZLD + ZC_GA + ch]);
      MIX[(size_t)(r0 + tk) * DM + ch] = f2bf((h + hb[tk]) * siluf_(ga));
    }
  }
}

constexpr int GD_QN = 0, GD_KN = 17408, GD_KT = 34816, GD_VT = 53248, GD_KK = 71680, GD_QK = 88320, GD_MS = 104960, GD_SC = 141824;
__device__ __forceinline__ void gdn_local_item(const Params& p, int l, int it, unsigned char* smem) {
  const bf16_t* Z = (const bf16_t*)(p.ws + WS_Z);
  bf16_t* qN = (bf16_t*)(smem + GD_QN); bf16_t* kN = (bf16_t*)(smem + GD_KN);
  bf16_t* kT = (bf16_t*)(smem + GD_KT); bf16_t* vT = (bf16_t*)(smem + GD_VT);
  float* KKs = (float*)(smem + GD_KK); float* QKs = (float*)(smem + GD_QK);
  float* Ms = (float*)(smem + GD_MS);
  float* SC = (float*)(smem + GD_SC);
  unsigned char* GREC = p.ws + WS_GREC; float* GU = (float*)(p.ws + WS_GU); float* GGL = (float*)(p.ws + WS_GGL);
  {
    const int rc = it >> 2, h = it & 3, r0 = rc * 64;
    const int seg_lo = r0 < TC ? 0 : TC, seg_hi = r0 < TC ? TC : TA;
    __syncthreads();
    {
    const int tid = tidx(), lane = tid & 63, wid = tid >> 6;
#pragma unroll 1
    for (int i = 0; i < 6; ++i) {
      const int u = i * 512 + tid, tk = u / 48, part = (u % 48) >> 4, c8 = (u & 15) * 8;
      const int chq = part * 512 + h * 128 + c8;
      float acc[8];
#pragma unroll
      for (int e = 0; e < 8; ++e) acc[e] = 0.f;
#pragma unroll
      for (int kk = 0; kk < 4; ++kk) {
        const int rr = r0 + tk + kk - 2;
        if (rr >= seg_lo && rr < seg_hi) {
          const bf16x8_t xv = *(const bf16x8_t*)(Z + (size_t)rr * ZLD + ZC_QKVB + chq);
          const float* cw = p.conv_b_w + ((size_t)l * 4 + kk) * 1536 + chq;
#pragma unroll
          for (int e = 0; e < 8; ++e) acc[e] += cw[e] * bf2f((bf16_t)xv[e]);
        }
      }
      float ss = 0.f;
#pragma unroll
      for (int e = 0; e < 8; ++e) { acc[e] = siluf_(acc[e]); ss += acc[e] * acc[e]; }
      ss += __shfl_xor(ss, 1); ss += __shfl_xor(ss, 2); ss += __shfl_xor(ss, 4); ss += __shfl_xor(ss, 8);
      float scl = 1.f;
      if (part == 0) scl = rsqrtf(ss + 1e-6f) * 0.088388347648318440f;
      else if (part == 1) scl = rsqrtf(ss + 1e-6f);
#pragma unroll
      for (int e = 0; e < 8; ++e) {
        const bf16_t b = f2bf(acc[e] * scl);
        if (part == 0) qN[tk * 136 + c8 + e] = b;
        const int tsw = (((tk >> 3) ^ ((c8 >> 3) & 7)) << 3) | (tk & 7);
        if (part == 1) { kN[tk * 136 + c8 + e] = b; kT[(c8 + e) * 72 + tsw] = b; }
        else if (part == 2) vT[(c8 + e) * 72 + tsw] = b;
      }
    }
    if (wid < 2) {
      const int d = wid, tk = d ? 63 - lane : lane;
      const bf16_t* zr = Z + (size_t)(r0 + tk) * ZLD;
      const float beta = sigmoidf_(bf2f(zr[ZC_BETA + d * 4 + h]));
      const float g = -expf(p.a_log_b[(l * 2 + d) * 4 + h]) * softplusf_(bf2f(zr[ZC_ALPHA + d * 4 + h]) + p.dt_bias_b[(l * 2 + d) * 4 + h]);
      float gc = g;
#pragma unroll
      for (int o = 1; o < 64; o <<= 1) { const float t = __shfl_up(gc, o); if (lane >= o) gc += t; }
      const float gl = __shfl(gc, 63);
      float* s = SC + d * 256;
      s[lane] = beta; s[64 + lane] = gc; s[128 + lane] = expf(gc); s[192 + lane] = expf(gl - gc);
      if (lane == 0) { const int pc = d == 0 ? rc : (rc < 4 ? 3 - rc : 135 - rc); GGL[(size_t)(d * 4 + h) * NCH + pc] = expf(gl); }
    }
    }
    __syncthreads();
    {
      const int tid = tidx(), lane = tid & 63, wid = tid >> 6, fr = lane & 15, fq = lane >> 4;
      const int which = wid >> 2, mt = wid & 3;
      const bf16_t* Asrc = which ? qN : kN;
      f32x4_t acc[4];
#pragma unroll
      for (int ct = 0; ct < 4; ++ct) acc[ct] = (f32x4_t){0.f, 0.f, 0.f, 0.f};
#pragma unroll
      for (int ks = 0; ks < 4; ++ks) {
        const bf16x8_t a = *(const bf16x8_t*)(Asrc + (mt * 16 + fr) * 136 + ks * 32 + fq * 8);
#pragma unroll
        for (int ct = 0; ct < 4; ++ct) {
          const bf16x8_t b = *(const bf16x8_t*)(kN + (ct * 16 + fr) * 136 + ks * 32 + fq * 8);
          acc[ct] = __builtin_amdgcn_mfma_f32_16x16x32_bf16(a, b, acc[ct], 0, 0, 0);
        }
      }
      float* dst = which ? QKs : KKs;
#pragma unroll
      for (int ct = 0; ct < 4; ++ct)
#pragma unroll
        for (int j = 0; j < 4; ++j) dst[(mt * 16 + fq * 4 + j) * 65 + ct * 16 + fr] = acc[ct][j];
    }
    __syncthreads();
#pragma unroll 1
    for (int i = 0; i < 16; ++i) {
      const int e = i * 512 + tidx(), d = e >> 12, pi = (e >> 6) & 63, pj = e & 63;
      const int ti = d ? 63 - pi : pi, tj = d ? 63 - pj : pj;
      const float* s = SC + d * 256;
      const float dec = pi >= pj ? fexp_(s[64 + pi] - s[64 + pj]) : 0.f;
      Ms[(d * 64 + pi) * 72 + pj] = pi > pj ? s[pi] * KKs[ti * 65 + tj] * dec : 0.f;
      const int pc = d == 0 ? rc : (rc < 4 ? 3 - rc : 135 - rc);
      ((bf16_t*)(GREC + ((size_t)(d * 4 + h) * NCH + pc) * GREC_BYTES + 32768))[pi * 64 + pj] = f2bf(QKs[ti * 65 + tj] * dec);
    }
    __syncthreads();
    if ((tidx() >> 6) < 2) {
      const int d = tidx() >> 6, c = tidx() & 63;
      const float* Md = Ms + d * 64 * 72;
      float T[64];
#pragma unroll
      for (int i = 0; i < 64; ++i) T[i] = 0.f;
#pragma unroll
      for (int i = 0; i < 64; ++i) {
        float a0 = (i == c) ? 1.f : 0.f, a1 = 0.f, a2 = 0.f, a3 = 0.f;
#pragma unroll
        for (int jb = 0; jb < i; jb += 4) {
          const float4 m = *(const float4*)(Md + i * 72 + jb);
          a0 -= m.x * T[jb]; a1 -= m.y * T[jb + 1]; a2 -= m.z * T[jb + 2]; a3 -= m.w * T[jb + 3];
        }
        T[i] = (a0 + a1) + (a2 + a3);
      }
      const float* s = SC + d * 256;
      const float bc = s[c], bce = s[c] * s[128 + c];
      const int tc = d ? 63 - c : c;
      bf16_t* Tu = (bf16_t*)(Ms + d * 64 * 72); bf16_t* Tw = Tu + 64 * 72;
      asm volatile("s_waitcnt lgkmcnt(0)" ::: "memory");
#pragma unroll
      for (int i = 0; i < 64; ++i) { Tu[i * 72 + tc] = f2bf(T[i] * bc); Tw[i * 72 + tc] = f2bf(T[i] * bce); }
    } else {
#pragma unroll 1
      for (int e = tidx() - 128; e < 2048; e += 384) {
        const int d = e >> 10, pi = (e >> 4) & 63, c8 = (e & 15) * 8;
        const int ti = d ? 63 - pi : pi; const float sc = SC[d * 256 + 128 + pi];
        const int pc = d == 0 ? rc : (rc < 4 ? 3 - rc : 135 - rc);
        const bf16x8_t qv = *(const bf16x8_t*)(qN + ti * 136 + c8);
        float f[8];
#pragma unroll
        for (int k = 0; k < 8; ++k) f[k] = bf2f((bf16_t)qv[k]) * sc;
        u32x4_t w = {cvtpk2(f[0], f[1]), cvtpk2(f[2], f[3]), cvtpk2(f[4], f[5]), cvtpk2(f[6], f[7])};
        *(u32x4_t*)((bf16_t*)(GREC + ((size_t)(d * 4 + h) * NCH + pc) * GREC_BYTES + 16384) + pi * 128 + c8) = w;
      }
#pragma unroll 1
      for (int e = tidx() - 128; e < 2048; e += 384) {
        const int d = e >> 10, chn = (e >> 3) & 127, p8 = (e & 7) * 8;
        const int pc = d == 0 ? rc : (rc < 4 ? 3 - rc : 135 - rc);
        float f[8];
#pragma unroll
        for (int k = 0; k < 8; ++k) { const int pi = p8 + k, ti = d ? 63 - pi : pi; f[k] = bf2f(kT[chn * 72 + ((((ti >> 3) ^ ((chn >> 3) & 7)) << 3) | (ti & 7))]) * SC[d * 256 + 192 + pi]; }
        u32x4_t w = {cvtpk2(f[0], f[1]), cvtpk2(f[2], f[3]), cvtpk2(f[4], f[5]), cvtpk2(f[6], f[7])};
        *(u32x4_t*)((bf16_t*)(GREC + ((size_t)(d * 4 + h) * NCH + pc) * GREC_BYTES + 40960) + chn * 64 + p8) = w;
      }
    }
    __syncthreads();
    {
      const int tid = tidx(), lane = tid & 63, wid = tid >> 6, fr = lane & 15, fq = lane >> 4;
      const int d = wid >> 2, which = (wid >> 1) & 1, half = wid & 1;
      const int pc = d == 0 ? rc : (rc < 4 ? 3 - rc : 135 - rc);
      const size_t cbase = (size_t)(d * 4 + h) * NCH + pc;
      const bf16_t* Tm = (const bf16_t*)(Ms + d * 64 * 72) + which * 64 * 72;
      const bf16_t* Bs = which ? kT : vT;
#pragma unroll 1
      for (int cti = 0; cti < 4; ++cti) {
        const int ct = half * 4 + cti;
        f32x4_t acc[4];
#pragma unroll
        for (int m = 0; m < 4; ++m) acc[m] = (f32x4_t){0.f, 0.f, 0.f, 0.f};
#pragma unroll
        for (int ks = 0; ks < 2; ++ks) {
          const bf16x8_t b = *(const bf16x8_t*)(Bs + (ct * 16 + fr) * 72 + (((ks * 4 + fq) ^ ((2 * ct + (fr >> 3)) & 7)) << 3));
#pragma unroll
          for (int m = 0; m < 4; ++m) {
            const bf16x8_t a = *(const bf16x8_t*)(Tm + (m * 16 + fr) * 72 + ks * 32 + fq * 8);
            acc[m] = __builtin_amdgcn_mfma_f32_16x16x32_bf16(a, b, acc[m], 0, 0, 0);
          }
        }
#pragma unroll
        for (int m = 0; m < 4; ++m)
#pragma unroll
          for (int j = 0; j < 4; ++j) {
            const int pi = m * 16 + fq * 4 + j, chn = ct * 16 + fr;
            if (which) ((bf16_t*)(GREC + cbase * GREC_BYTES))[pi * 128 + chn] = f2bf(acc[m][j]);
            else GU[cbase * 8192 + pi * 128 + chn] = acc[m][j];
          }
      }
    }
  }
}

constexpr int GS_W = 0, GS_QH = 17408, GS_QK = 34816, GS_KT = 44032, GS_BUF = 62464, GS_GAM = 2 * GS_BUF, GS_OST = GS_GAM + 1024;
__device__ void gdn_scan(const Params& p, unsigned char* smem, int sq, int sg) {
  const int tid = tidx(), lane = tid & 63, wid = tid >> 6, fr = lane & 15, fq = lane >> 4;
  const int d = sq >> 2, h = sq & 3;
  const unsigned char* REC = p.ws + WS_GREC + (size_t)sq * NCH * GREC_BYTES;
  const float* GGL = (const float*)(p.ws + WS_GGL) + (size_t)sq * NCH;
  float* gamS = (float*)(smem + GS_GAM);
  __syncthreads();
  if (tid < NCH) gamS[tid] = GGL[tid];
  if (wid < 4) {
    const int slice = sg * 4 + wid, n0 = slice * 16;
    const float* up = (const float*)(p.ws + WS_GU) + (size_t)sq * NCH * 8192 + (fq * 4) * 128 + n0 + fr;
    float* GO = (float*)(p.ws + WS_GO) + (size_t)(sq * 8 + slice) * TA * 16;
    float* ost = (float*)(smem + GS_OST + wid * 4096);
    f32x4_t S[8], U[4];
#pragma unroll
    for (int t = 0; t < 8; ++t) S[t] = (f32x4_t){0.f, 0.f, 0.f, 0.f};
#pragma unroll
    for (int m = 0; m < 4; ++m)
#pragma unroll
      for (int j = 0; j < 4; ++j) U[m][j] = up[(m * 16 + j) * 128];
    __syncthreads();
#pragma unroll 1
    for (int pc = 0; pc < NCH; ++pc) {
      const unsigned char* B_ = smem + (pc & 1) * GS_BUF;
#define GS_AFRAG(base, stride, row, ks) ({ const unsigned char* a_ = B_ + (base) + (row) * (stride) + (ks) * 64 + fq * 8; \
      u32x2_t lo_ = *(const u32x2_t*)a_; u32x2_t hi_ = *(const u32x2_t*)(a_ + 32); u32x4_t w_ = {lo_.x, lo_.y, hi_.x, hi_.y}; *reinterpret_cast<bf16x8_t*>(&w_); })
      const float gam = gamS[pc];
      f32x4_t Un[4];
      { const int pn = pc + 1 < NCH ? pc + 1 : pc;
#pragma unroll
        for (int m = 0; m < 4; ++m)
#pragma unroll
          for (int j = 0; j < 4; ++j) Un[m][j] = up[(size_t)pn * 8192 + (m * 16 + j) * 128]; }
      bf16x8_t Sb[4];
#pragma unroll
      for (int ks = 0; ks < 4; ++ks) Sb[ks] = pack8(S[2 * ks], S[2 * ks + 1]);
      f32x4_t P[4], O[4];
#pragma unroll
      for (int m = 0; m < 4; ++m) { P[m] = (f32x4_t){0.f, 0.f, 0.f, 0.f}; O[m] = (f32x4_t){0.f, 0.f, 0.f, 0.f}; }
#pragma unroll
      for (int ks = 0; ks < 4; ++ks)
#pragma unroll
        for (int m = 0; m < 4; ++m) {
          const bf16x8_t aw = GS_AFRAG(GS_W, 272, m * 16 + fr, ks);
          const bf16x8_t aq = GS_AFRAG(GS_QH, 272, m * 16 + fr, ks);
          P[m] = __builtin_amdgcn_mfma_f32_16x16x32_bf16(aw, Sb[ks], P[m], 0, 0, 0);
          O[m] = __builtin_amdgcn_mfma_f32_16x16x32_bf16(aq, Sb[ks], O[m], 0, 0, 0);
        }
      f32x4_t Vn[4];
#pragma unroll
      for (int m = 0; m < 4; ++m) Vn[m] = U[m] - P[m];
      bf16x8_t Vb[2];
      Vb[0] = pack8(Vn[0], Vn[1]); Vb[1] = pack8(Vn[2], Vn[3]);
#pragma unroll
      for (int ks = 0; ks < 2; ++ks)
#pragma unroll
        for (int m = 0; m < 4; ++m) {
          const bf16x8_t a = GS_AFRAG(GS_QK, 144, m * 16 + fr, ks);
          O[m] = __builtin_amdgcn_mfma_f32_16x16x32_bf16(a, Vb[ks], O[m], 0, 0, 0);
        }
#pragma unroll
      for (int t = 0; t < 8; ++t) {
        S[t] = S[t] * gam;
#pragma unroll
        for (int ks = 0; ks < 2; ++ks) {
          const bf16x8_t a = GS_AFRAG(GS_KT, 144, t * 16 + fr, ks);
          S[t] = __builtin_amdgcn_mfma_f32_16x16x32_bf16(a, Vb[ks], S[t], 0, 0, 0);
        }
      }
#undef GS_AFRAG
#pragma unroll
      for (int m = 0; m < 4; ++m)
#pragma unroll
        for (int j = 0; j < 4; ++j) { const int pi = m * 16 + fq * 4 + j, tk = d ? 63 - pi : pi; ost[tk * 16 + fr] = O[m][j]; }
      const int rcn = d == 0 ? pc : (pc < 4 ? 3 - pc : 135 - pc);
      float* gop = GO + (size_t)rcn * 1024 + lane * 4;
#pragma unroll
      for (int i = 0; i < 4; ++i) *(f32x4_t*)(gop + i * 256) = *(const f32x4_t*)(ost + i * 256 + lane * 4);
#pragma unroll
      for (int m = 0; m < 4; ++m) U[m] = Un[m];
      __syncthreads();
    }
  } else {
    const int lt = tid - 256;
    int lo[14];
#pragma unroll
    for (int i = 0; i < 14; ++i) {
      const int q = lt + 256 * i;
      lo[i] = q < 1024 ? GS_W + (q >> 4) * 272 + (q & 15) * 16
            : q < 2048 ? GS_QH + ((q - 1024) >> 4) * 272 + (q & 15) * 16
            : q < 2560 ? GS_QK + ((q - 2048) >> 3) * 144 + (q & 7) * 16
                       : GS_KT + ((q - 2560) >> 3) * 144 + (q & 7) * 16;
    }
    u32x4_t R0[14], R1[14], R2[14];
#define GS_LOAD(R, pc) do { const int pc_ = (pc) < NCH ? (pc) : NCH - 1; const u32x4_t* s_ = (const u32x4_t*)(REC + (size_t)pc_ * GREC_BYTES) + lt; \
    _Pragma("unroll") for (int i = 0; i < 14; ++i) R[i] = s_[256 * i]; } while (0)
#define GS_WRITE(R, pc) do { unsigned char* B_ = smem + ((pc) & 1) * GS_BUF; \
    _Pragma("unroll") for (int i = 0; i < 14; ++i) *(u32x4_t*)(B_ + lo[i]) = R[i]; } while (0)
    GS_LOAD(R0, 0); GS_WRITE(R0, 0);
    GS_LOAD(R1, 1); GS_LOAD(R2, 2);
    __syncthreads();
#pragma unroll 1
    for (int pc = 0; pc < NCH; pc += 3) {
      GS_LOAD(R0, pc + 3); GS_WRITE(R1, pc + 1); __syncthreads();
      GS_LOAD(R1, pc + 4); GS_WRITE(R2, pc + 2); __syncthreads();
      GS_LOAD(R2, pc + 5); GS_WRITE(R0, pc + 3); __syncthreads();
    }
#undef GS_LOAD
#undef GS_WRITE
  }
}

__device__ __forceinline__ void phase_gdn_fin(const Params& p, int l, int rb, int re, int rstep) {
  const int tid = tidx(), lane = tid & 63, wid = tid >> 6;
  const float* GO = (const float*)(p.ws + WS_GO);
  const bf16_t* Z = (const bf16_t*)(p.ws + WS_Z); bf16_t* MIX = (bf16_t*)(p.ws + WS_MIX);
  const int c0 = lane * 8;
  float on[8];
#pragma unroll
  for (int e = 0; e < 8; ++e) on[e] = p.onorm_b[l * 128 + (c0 & 127) + e];
  for (int r = rb + wid; r < re; r += rstep) {
    if (l == NL - 1 && r < TC) continue;
    const int hh = lane >> 4, sl = (lane >> 1) & 7, off = (lane & 1) * 8;
    const float* g0 = GO + ((size_t)((0 * 4 + hh) * 8 + sl) * TA + r) * 16 + off;
    const float* g1 = GO + ((size_t)((1 * 4 + hh) * 8 + sl) * TA + r) * 16 + off;
    const float4 a0 = *(const float4*)g0, a1 = *(const float4*)(g0 + 4);
    const float4 b0 = *(const float4*)g1, b1 = *(const float4*)(g1 + 4);
    float v[8] = {a0.x + b0.x, a0.y + b0.y, a0.z + b0.z, a0.w + b0.w, a1.x + b1.x, a1.y + b1.y, a1.z + b1.z, a1.w + b1.w};
    float ss = 0.f;
#pragma unroll
    for (int e = 0; e < 8; ++e) ss += v[e] * v[e];
    ss += __shfl_xor(ss, 1); ss += __shfl_xor(ss, 2); ss += __shfl_xor(ss, 4); ss += __shfl_xor(ss, 8);
    const float rstd = rsqrtf(ss * (1.f / 128.f) + 1e-6f);
    const bf16x8_t gv = *(const bf16x8_t*)(Z + (size_t)r * ZLD + ZC_GB + c0);
    float f[8];
#pragma unroll
    for (int e = 0; e < 8; ++e) f[e] = v[e] * rstd * on[e] * siluf_(bf2f((bf16_t)gv[e]));
    u32x4_t w = {cvtpk2(f[0], f[1]), cvtpk2(f[2], f[3]), cvtpk2(f[4], f[5]), cvtpk2(f[6], f[7])};
    *(u32x4_t*)(MIX + (size_t)r * DM + 512 + c0) = w;
  }
}

constexpr int ATT_ITEMS = 512;
__device__ __forceinline__ void attn_item(const Params& p, int it, unsigned char* smem) {
  const bf16_t* QB = (const bf16_t*)(p.ws + WS_QB); const bf16_t* KB = (const bf16_t*)(p.ws + WS_KB); const bf16_t* VB = (const bf16_t*)(p.ws + WS_VB);
  int head, r0, seq, k0, split;
  if (it < ATT_ITEMS) { const int half = it >> 8, idx = it & 255; split = half * 3; head = idx >> 5; r0 = TC + (idx & 31) * 256; seq = half ? 52 * 64 : 80 * 64; k0 = half ? 80 * 64 : 0; }
  else { split = 0; head = it - ATT_ITEMS; r0 = 0; seq = TC; k0 = 0; }
  const int kvh = head >> 2;
  bf16_t* OUT = (bf16_t*)(p.ws + WS_PO) + ((size_t)split * TA + r0) * 1024 + head * 128;
  float* ML = (float*)(p.ws + WS_ML) + (((size_t)split * TA + r0) * 8 + head) * 2;
  __syncthreads();
  att::attn_dense_body(QB + (size_t)r0 * 1024 + head * 128, KB + (size_t)k0 * 256 + kvh * 128, VB + (size_t)k0 * 256 + kvh * 128, ML, OUT, seq, (char*)smem);
}
__device__ void attn_queue(const Params& p, int l, unsigned char* smem) {
  unsigned* ctr = (unsigned*)(p.ws + WS_CTR) + l;
  volatile int* slot = (volatile int*)(smem + 144000);
  for (;;) {
    __syncthreads();
    if (tidx() == 0) *slot = (int)atomicAdd(ctr, 1u);
    __syncthreads();
    const int it = *slot;
    if (it >= ATT_ITEMS + (l != NL - 1 ? 8 : 0)) break;
    attn_item(p, it, smem);
  }
}

__device__ __forceinline__ void phase_attn_gate(const Params& p, int l, int rb, int re, int rstep) {
  const int tid = tidx(), lane = tid & 63, wid = tid >> 6;
  const bf16_t* Z = (const bf16_t*)(p.ws + WS_Z); bf16_t* MIX = (bf16_t*)(p.ws + WS_MIX); const bf16_t* PO = (const bf16_t*)(p.ws + WS_PO);
  const float* ML = (const float*)(p.ws + WS_ML);
  constexpr float C = 0.088388347648318440f * 1.4426950408889634f;
  for (int r = rb + wid; r < re; r += rstep) {
    if (l == NL - 1 && r < TC) continue;
#pragma unroll
    for (int hlf = 0; hlf < 2; ++hlf) {
      const int c0 = hlf * 512 + lane * 8, head = c0 >> 7;
      const bf16x8_t gv = *(const bf16x8_t*)(Z + (size_t)r * ZLD + ZC_GC + c0);
      float f[8];
      if (r >= TC) {
        float2 st[NSPLIT]; float mm = -3.0e38f;
#pragma unroll
        for (int k = 0; k < NSPLIT; ++k) { const bool use = k % 3 == 0;
          st[k] = use ? *(const float2*)(ML + (((size_t)k * TA + r) * 8 + head) * 2) : make_float2(-3.0e38f, 0.f); mm = fmaxf(mm, st[k].x); }
        float wsum = 0.f;
#pragma unroll
        for (int e = 0; e < 8; ++e) f[e] = 0.f;
#pragma unroll
        for (int k = 0; k < NSPLIT; ++k) {
          if (k % 3 == 0) {
            const float w = st[k].y * exp2f((st[k].x - mm) * C); wsum += w;
            const bf16x8_t ov = *(const bf16x8_t*)(PO + ((size_t)k * TA + r) * 1024 + c0);
#pragma unroll
            for (int e = 0; e < 8; ++e) f[e] += bf2f((bf16_t)ov[e]) * w;
          }
        }
        const float inv = 1.f / wsum;
#pragma unroll
        for (int e = 0; e < 8; ++e) f[e] *= inv * siluf_(bf2f((bf16_t)gv[e]));
      } else {
        const bf16x8_t ov = *(const bf16x8_t*)(PO + (size_t)r * 1024 + c0);
#pragma unroll
        for (int e = 0; e < 8; ++e) f[e] = bf2f((bf16_t)ov[e]) * siluf_(bf2f((bf16_t)gv[e]));
      }
      u32x4_t w = {cvtpk2(f[0], f[1]), cvtpk2(f[2], f[3]), cvtpk2(f[4], f[5]), cvtpk2(f[6], f[7])};
      *(u32x4_t*)(MIX + (size_t)r * DM + 1024 + c0) = w;
    }
  }
}

template <int S>
__device__ __forceinline__ void run_phase(const Params& p0, int l, unsigned char* smem) {
  Params p = p0;
  { unsigned long long w_ = (unsigned long long)p.ws; asm volatile("" : "+s"(w_)); p.ws = (unsigned char*)w_; }
  const int bid = bidx();
  if constexpr (S == 0) phase_prep0(p, smem);
  else if constexpr (S == 1) phase_norm(p, l);
  else if constexpr (S == 2) {
    pg8::Gemm g; g.A = (const bf16_t*)(p.ws + WS_XN); g.Bt = (const bf16_t*)(p.ws + WS_WIN) + (size_t)l * ZLD * DM; g.M = TA; g.N = ZLD; g.K = DM; g.ld = DM;
    pg8::StaticOrder So; So.init(g.M, g.N, (int)gridDim.x, bid);
    pg8::EpiZ E; E.O = (bf16_t*)(p.ws + WS_Z); E.ldc = ZLD;
    pg8::gemm_phase<pg8::EpiZ, pg8::StaticOrder, false>((PG8_LAS unsigned char*)smem, g, So, E, nullptr);
  } else if constexpr (S == 3) {
    phase_qkprep(p, l);
    {
      unsigned* ctr = (unsigned*)(p.ws + WS_CTR) + 16 + l;
      volatile int* slot = (volatile int*)(smem + 144000);
      for (;;) {
        __syncthreads();
        if (tidx() == 0) *slot = (int)atomicAdd(ctr, 1u);
        __syncthreads();
        const int it = *slot;
        if (it >= NCH * 4 + NCH * 8) break;
        if (it < NCH * 4) gdn_local_item(p, l, it, smem); else lru_ab_item(p, l, it - NCH * 4, smem);
      }
    }
  }
  else if constexpr (S == 4) {
    if (bid < 16) gdn_scan(p, smem, bid & 7, bid >> 3);
    else if (bid < 18) lru_carry(p, bid - 16);
    attn_queue(p, l, smem);
    if (l + 1 < NL) convert_queue(p, l + 1, smem);
  }
  else if constexpr (S == 5) { }
  else if constexpr (S == 6) {
    unsigned* ctr = (unsigned*)(p.ws + WS_CTR) + 24 + l;
    volatile int* slot = (volatile int*)(smem + 144000);
    const int first = (l == NL - 1) ? 4 : 0;
    for (;;) {
      __syncthreads();
      if (tidx() == 0) *slot = (int)atomicAdd(ctr, 1u);
      __syncthreads();
      const int it = *slot + first;
      if (it >= NCH + TA / 32) break;
      if (it < NCH) lru_fin_item(p, l, it);
      else { const int r0 = (it - NCH) * 32; if (l == NL - 1 && r0 < TC) continue; phase_gdn_fin(p, l, r0, r0 + 32, 8); phase_attn_gate(p, l, r0, r0 + 32, 8); }
    }
  }
  else if constexpr (S == 7) {
    const bool last = (l == NL - 1);
    const float* mod = (const float*)(p.ws + WS_MOD) + (size_t)l * 2 * 6144;
    {
      pg8::Gemm g; g.A = (const bf16_t*)(p.ws + WS_MIX) + (size_t)TC * DM; g.Bt = (const bf16_t*)(p.ws + WS_WOUT) + (size_t)l * DM * DM;
      g.M = TL; g.N = DM; g.K = DM; g.ld = DM;
      pg8::StaticOrder So; So.init(g.M, g.N, (int)gridDim.x, bid);
      pg8::EpiRes E; E.H = (float*)(p.ws + WS_H); E.gate_lat = mod + 4096; E.gate_ctx = mod + 6144 + 4096; E.row_off = TC;
      pg8::gemm_phase<pg8::EpiRes, pg8::StaticOrder, false>((PG8_LAS unsigned char*)smem, g, So, E, nullptr);
    }
    if (!last) {
      const int G_ = (int)gridDim.x;
#pragma unroll 1
      for (int kq = 0; kq < 4; ++kq) {
        pg8::Gemm g; g.A = (const bf16_t*)(p.ws + WS_MIX) + kq * 512; g.Bt = (const bf16_t*)(p.ws + WS_WOUT) + (size_t)l * DM * DM + kq * 512;
        g.M = TC; g.N = DM; g.K = 512; g.ld = DM;
        pg8::StaticOrder So; So.init(g.M, g.N, G_, (bid - 8 * kq - 8 + 2 * G_) % G_);
        pg8::EpiResAtomic E; E.H = (float*)(p.ws + WS_H); E.gate = mod + 6144 + 4096;
        pg8::gemm_phase<pg8::EpiResAtomic, pg8::StaticOrder, false>((PG8_LAS unsigned char*)smem, g, So, E, nullptr);
      }
    }
  } else phase_final(p);
}

#ifdef MK_MULTI
template <int S>
__global__ __launch_bounds__(512, 2) void k_phase(Params p, int l) {
  extern __shared__ __attribute__((aligned(16))) unsigned char smem[];
  run_phase<S>(p, l, smem);
}
#else
__global__ __launch_bounds__(512, 2) void hybrid_fwd(Params p) {
  extern __shared__ __attribute__((aligned(16))) unsigned char smem[];
  cg::grid_group grid = cg::this_grid();
  volatile LAS unsigned* xst = (volatile LAS unsigned*)(smem + (LDS_BYTES - 16));
  if (threadIdx.x == 0) { xst[0] = 0u; xst[1] = 0u; }
  __syncthreads();
  const XcdBarrier xb = xcd_barrier_post((unsigned*)(p.ws + WS_BAR), xst);
#define GSYNC() xcd_barrier(xb)
  run_phase<0>(p, 0, smem); grid.sync();
#ifndef REP1
#define REP1 1
#endif
#ifndef REP2
#define REP2 1
#endif
#ifndef REP3
#define REP3 1
#endif
#ifndef REP4
#define REP4 1
#endif
#ifndef REP5
#define REP5 1
#endif
#ifndef REP6
#define REP6 1
#endif
#ifndef REPSYNC
#define REPSYNC 0
#endif
#pragma unroll 1
  for (int l = 0; l < NL; ++l) {
#pragma unroll 1
    for (int r = 0; r < REP1; ++r) { run_phase<1>(p, l, smem); GSYNC(); }
#pragma unroll 1
    for (int r = 0; r < REP2; ++r) { run_phase<2>(p, l, smem); GSYNC(); }
#pragma unroll 1
    for (int r = 0; r < REP3; ++r) { run_phase<3>(p, l, smem); GSYNC(); }
#pragma unroll 1
    for (int r = 0; r < REP4; ++r) { run_phase<4>(p, l, smem); GSYNC(); }
#pragma unroll 1
    for (int r = 0; r < REP6; ++r) { run_phase<6>(p, l, smem); GSYNC(); }
#pragma unroll 1
    for (int r = 0; r < REPSYNC; ++r) GSYNC();
    run_phase<7>(p, l, smem); GSYNC();
  }
  run_phase<8>(p, 0, smem);
}
#endif

template <class K> static bool set_lds(K k) { return hipFuncSetAttribute((const void*)k, hipFuncAttributeMaxDynamicSharedMemorySize, LDS_BYTES) == hipSuccess; }

extern "C" void kernel_launch(void* const* d_in, const int* in_sizes, int n_in, void* d_out, int out_size, void* d_ws, size_t ws_size, hipStream_t stream) {
  static int grid = 0;
  if (grid == 0) {
    if (n_in != 23 || out_size != TL * DM || ws_size < WS_END) { fprintf(stderr, "kernel_launch: unexpected shapes (n_in %d out %d ws %zu need %zu)\n", n_in, out_size, ws_size, (size_t)WS_END); grid = -1; return; }
    int dev = 0, cus = 0;
    (void)hipGetDevice(&dev); (void)hipDeviceGetAttribute(&cus, hipDeviceAttributeMultiprocessorCount, dev);
    bool ok = true;
#ifdef MK_MULTI
    ok = ok && set_lds(k_phase<0>) && set_lds(k_phase<1>) && set_lds(k_phase<2>) && set_lds(k_phase<3>) && set_lds(k_phase<4>) && set_lds(k_phase<5>) && set_lds(k_phase<6>) && set_lds(k_phase<7>) && set_lds(k_phase<8>);
#else
    ok = ok && set_lds(hybrid_fwd);
    int per_cu = 0; (void)hipOccupancyMaxActiveBlocksPerMultiprocessor(&per_cu, (const void*)hybrid_fwd, 512, LDS_BYTES); (void)hipGetLastError();
    if (per_cu < 1) fprintf(stderr, "kernel_launch: occupancy query says %d blocks per CU\n", per_cu);
#endif
    if (!ok) { fprintf(stderr, "kernel_launch: hipFuncSetAttribute failed\n"); grid = -1; return; }
    grid = cus > 0 ? cus : 256;
  }
  if (grid < 0) return;
  Params p{};
  const float** pp = (const float**)&p;
  for (int i = 0; i < 23; ++i) pp[i] = (const float*)d_in[i];
  p.out = (float*)d_out; p.ws = (unsigned char*)d_ws;
#ifdef MK_MULTI
#define LAUNCH(S, l) hipLaunchKernelGGL(k_phase<S>, dim3(grid), dim3(512), LDS_BYTES, stream, p, l)
  LAUNCH(0, 0);
  for (int l = 0; l < NL; ++l) { LAUNCH(1, l); LAUNCH(2, l); LAUNCH(3, l); LAUNCH(4, l); LAUNCH(6, l); LAUNCH(7, l); }
  LAUNCH(8, 0);
#else
  (void)hipMemsetAsync((unsigned char*)d_ws + WS_CTR, 0, 256 + 16384, stream);
  void* args[] = {&p};
  hipError_t e = hipLaunchCooperativeKernel((const void*)hybrid_fwd, dim3(grid), dim3(512), args, LDS_BYTES, stream);
  if (e != hipSuccess) fprintf(stderr, "cooperative launch failed: %s (grid %d)\n", hipGetErrorString(e), grid);
#endif
}
```
